# Optimizing an MI355X kernel written in HIP

```python
import jax, jax.numpy as jnp
from jax import lax
import numpy as np

D_MODEL = 1024
BATCH = 32
SEQ = 2048
DEPTH = 4

CHUNK = 64
QBLOCK = 128
HG_HEADS = 4
HG_DK = 128
HG_DV = 128
HG_WIDTH = HG_HEADS * HG_DK
SA_HEADS = 8
SA_DH = 64
SA_WIDTH = SA_HEADS * SA_DH
SA_LATENT = 128
IDX_HEADS = 4
IDX_DIM = 64
TOPK_MAX = 256
SB_HEADS = 8
SB_DH = 64
SB_WIDTH = SB_HEADS * SB_DH
N_BRANCH = 3
BRANCH_WIDTH = 512
D_FF = 2816
N_EXPERTS = 8
TOP_K_EXPERTS = 2
D_FF_EXPERT = 2816
N_DENSE = (DEPTH + 1) // 2
N_MOE = DEPTH // 2
PLE_DIM = 256
EPS = 1e-6
IN_SPLITS = (HG_WIDTH, HG_WIDTH, HG_HEADS * HG_DV, HG_HEADS * HG_DV,
             SA_WIDTH, SA_LATENT, IDX_HEADS * IDX_DIM, IDX_DIM, IDX_HEADS,
             SB_WIDTH, SB_WIDTH, SB_WIDTH, N_BRANCH * D_MODEL)
IN_WIDTH = sum(IN_SPLITS)

kernel_name = "hybrid_hgrn2_dsa_stickbreak_moe_block"

F32 = jnp.float32


def rmsnorm(x, g):
    xf = x.astype(F32)
    y = xf * lax.rsqrt(jnp.mean(xf * xf, axis=-1, keepdims=True) + EPS)
    return (y * g.astype(F32)).astype(x.dtype)


def hgrn2_mixer(q_in, f_in, i_in, g_in, lb, onorm):
    B, S, _ = q_in.shape
    nC = S // CHUNK
    lbf = lb.astype(F32)
    fpre = f_in.astype(F32)
    q = jax.nn.silu(q_in.astype(F32))
    log_f = jnp.log(lbf + (1.0 - lbf) * jax.nn.sigmoid(fpre))
    k = (1.0 - lbf) * jax.nn.sigmoid(-fpre)
    v = i_in.astype(F32)

    def to_chunks(t, d):
        return t.reshape(B, nC, CHUNK, HG_HEADS, d).transpose(1, 0, 3, 2, 4)

    causal = jnp.tril(jnp.ones((CHUNK, CHUNK), dtype=bool))[None, None, :, :, None]

    def step(state, inp):
        qc, kc, vc, lfc = inp
        b = jnp.cumsum(lfc, axis=2)
        diff = b[:, :, :, None, :] - b[:, :, None, :, :]
        decay = jnp.exp(jnp.where(causal, diff, -jnp.inf))
        scores = jnp.einsum('bhtd,bhsd,bhtsd->bhts', qc, kc, decay)
        o = jnp.einsum('bhts,bhsv->bhtv', scores, vc) + \
            jnp.einsum('bhtd,bhdv->bhtv', qc * jnp.exp(b), state)
        b_last = b[:, :, -1:, :]
        state = jnp.exp(b_last[:, :, 0, :])[..., None] * state + \
            jnp.einsum('bhsd,bhsv->bhdv', kc * jnp.exp(b_last - b), vc)
        return state, o

    state0 = jnp.zeros((B, HG_HEADS, HG_DK, HG_DV), F32)
    _, o = lax.scan(step, state0, (to_chunks(q, HG_DK), to_chunks(k, HG_DK),
                                   to_chunks(v, HG_DV), to_chunks(log_f, HG_DK)))
    o = o.transpose(1, 0, 3, 2, 4).reshape(B, S, HG_HEADS, HG_DV)
    o = rmsnorm(o, onorm).reshape(B, S, HG_HEADS * HG_DV)
    o = o * jax.nn.silu(g_in.astype(F32))
    return o.astype(q_in.dtype)


def dsa_mixer(q_in, c_in, iq_in, ik_in, iw_in, cnorm, wk, wv):
    B, S, _ = q_in.shape
    nb = S // QBLOCK
    topk = min(TOPK_MAX, S // 4)
    c = rmsnorm(c_in, cnorm)
    k = c @ wk
    v = c @ wv
    q = q_in.reshape(B, S, SA_HEADS, SA_DH)
    iq = iq_in.reshape(B, S, IDX_HEADS, IDX_DIM)
    ik = ik_in.astype(F32)
    iw = iw_in * (IDX_HEADS ** -0.5)
    kchunk = jnp.arange(S) // CHUNK
    gather = jax.vmap(lambda t, idx: t[idx])

    def blocks(t):
        return t.reshape((B, nb, QBLOCK) + t.shape[2:]).swapaxes(0, 1)

    def attend(blk):
        qb, iqb, iwb, qchunk = blk
        isc = jnp.einsum('bthd,bsd->bths', iqb.astype(F32), ik)
        isc = jnp.einsum('bths,bth->bts', jax.nn.relu(isc), iwb.astype(F32))
        adm = kchunk[None, :] <= qchunk[:, None]
        isc = jnp.where(adm[None], isc, -jnp.inf)
        _, sel = lax.top_k(isc, topk)
        valid = kchunk[sel] <= qchunk[None, :, None]
        k_sel = gather(k, sel).astype(F32)
        v_sel = gather(v, sel).astype(F32)
        logits = jnp.einsum('bthd,btkd->bthk', qb.astype(F32), k_sel) * (SA_DH ** -0.5)
        logits = jnp.where(valid[:, :, None, :], logits, -jnp.inf)
        w = jax.nn.softmax(logits, axis=-1)
        return jnp.einsum('bthk,btkd->bthd', w, v_sel)

    qchunks = (jnp.arange(S) // CHUNK).reshape(nb, QBLOCK)
    o = lax.map(attend, (blocks(q), blocks(iq), blocks(iw), qchunks))
    o = o.swapaxes(0, 1).reshape(B, S, SA_WIDTH)
    return o.astype(q_in.dtype)


def stick_breaking_mixer(q_in, k_in, v_in):
    B, S, _ = q_in.shape
    q = q_in.reshape(B, S, SB_HEADS, SB_DH).astype(F32)
    k = k_in.reshape(B, S, SB_HEADS, SB_DH).astype(F32)
    v = v_in.reshape(B, S, SB_HEADS, SB_DH).astype(F32)
    scale = SB_DH ** -0.5
    outs = []
    for j in range(S // QBLOCK):
        start = j * QBLOCK
        end = start + QBLOCK
        z = jnp.einsum('bthd,bshd->bhts', q[:, start:end], k[:, :end]) * scale
        t_pos = start + jnp.arange(QBLOCK)
        s_pos = jnp.arange(end)
        strict = s_pos[None, :] < t_pos[:, None]
        log_keep = jnp.where(strict, jax.nn.log_sigmoid(-z), 0.0)
        after = lax.cumsum(log_keep, axis=3, reverse=True) - log_keep
        A = jnp.where(strict, jnp.exp(jax.nn.log_sigmoid(z) + after), 0.0)
        outs.append(jnp.einsum('bhts,bshd->bthd', A, v[:, :end]))
    o = jnp.concatenate(outs, axis=1).reshape(B, S, SB_WIDTH)
    return o.astype(q_in.dtype)


def swiglu(v, wg, wu, wd):
    return (jax.nn.silu(v @ wg) * (v @ wu)) @ wd


def moe_swiglu(v, router, wg, wu, wd):
    logits = (v @ router).astype(F32)
    top_val, top_idx = lax.top_k(logits, TOP_K_EXPERTS)
    top_w = jax.nn.softmax(top_val, axis=-1)
    combine = jnp.sum(jax.nn.one_hot(top_idx, N_EXPERTS, dtype=F32) * top_w[..., None], axis=-2)
    combine = combine.astype(v.dtype)
    y = jnp.zeros_like(v)
    for e in range(N_EXPERTS):
        y = y + combine[..., e:e + 1] * swiglu(v, wg[e], wu[e], wd[e])
    return y


def setup_inputs(seed: int = 0) -> dict:
    key = jax.random.key(seed)
    ks = jax.random.split(key, 24)
    D = D_MODEL

    def nrm(k, shape, fan_in):
        return jax.random.normal(k, shape, F32) * (fan_in ** -0.5)

    def gain(k, shape):
        return 1.0 + 0.02 * jax.random.normal(k, shape, F32)

    return {
        "x": jax.random.normal(ks[0], (BATCH, SEQ, D), F32),
        "p": jax.random.normal(ks[1], (DEPTH, BATCH, SEQ, PLE_DIM), F32),
        "lb_param": 0.1 * jax.random.normal(ks[2], (DEPTH, HG_WIDTH), F32),
        "norm_mix": gain(ks[3], (DEPTH, D)),
        "w_in": nrm(ks[4], (DEPTH, D, IN_WIDTH), D),
        "hg_onorm": gain(ks[5], (DEPTH, HG_DV)),
        "sa_cnorm": gain(ks[6], (DEPTH, SA_LATENT)),
        "sa_wk": nrm(ks[7], (DEPTH, SA_LATENT, SA_DH), SA_LATENT),
        "sa_wv": nrm(ks[8], (DEPTH, SA_LATENT, SA_DH), SA_LATENT),
        "w_branch": nrm(ks[9], (DEPTH, N_BRANCH, BRANCH_WIDTH, D), BRANCH_WIDTH),
        "w_out": nrm(ks[10], (DEPTH, D, D), D),
        "norm_ffn": gain(ks[11], (DEPTH, D)),
        "dense_wg": nrm(ks[12], (N_DENSE, D, D_FF), D),
        "dense_wu": nrm(ks[13], (N_DENSE, D, D_FF), D),
        "dense_wd": nrm(ks[14], (N_DENSE, D_FF, D), D_FF),
        "moe_router": nrm(ks[15], (N_MOE, D, N_EXPERTS), D),
        "moe_wg": nrm(ks[16], (N_MOE, N_EXPERTS, D, D_FF_EXPERT), D),
        "moe_wu": nrm(ks[17], (N_MOE, N_EXPERTS, D, D_FF_EXPERT), D),
        "moe_wd": nrm(ks[18], (N_MOE, N_EXPERTS, D_FF_EXPERT, D), D_FF_EXPERT),
        "norm_ple": gain(ks[19], (DEPTH, D)),
        "ple_gate": nrm(ks[20], (DEPTH, D, D), D),
        "ple_proj": nrm(ks[21], (DEPTH, PLE_DIM, D), PLE_DIM),
        "norm_final": gain(ks[22], (D,)),
    }


def reference(x, p, lb_param, norm_mix, w_in, hg_onorm, sa_cnorm, sa_wk, sa_wv, w_branch,
              w_out, norm_ffn, dense_wg, dense_wu, dense_wd, moe_router, moe_wg, moe_wu,
              moe_wd, norm_ple, ple_gate, ple_proj, norm_final):
    B, S, D = x.shape
    lb_sm = jax.nn.softmax(lb_param.astype(F32), axis=0)
    lb_all = jnp.cumsum(lb_sm, axis=0) - lb_sm[0:1]
    split_points = np.cumsum(np.array(IN_SPLITS))[:-1]
    h = x
    for i in range(DEPTH):
        u = rmsnorm(h, norm_mix[i])
        z = u @ w_in[i]
        (hq, hf, hi, hg, sq, sc, iq, ik, iw, bq, bk, bv, gz) = jnp.split(z, split_points, axis=-1)
        a = hgrn2_mixer(hq, hf, hi, hg, lb_all[i], hg_onorm[i])
        b = dsa_mixer(sq, sc, iq, ik, iw, sa_cnorm[i], sa_wk[i], sa_wv[i])
        c = stick_breaking_mixer(bq, bk, bv)
        branches = jnp.stack([a, b, c], axis=2)
        proj = jnp.einsum('bsnw,nwd->bsnd', branches, w_branch[i])
        gates = jax.nn.sigmoid(gz.astype(F32)).reshape(B, S, N_BRANCH, D).astype(proj.dtype)
        merged = jnp.sum(gates * proj, axis=2)
        h = h + merged @ w_out[i]
        v = rmsnorm(h, norm_ffn[i])
        if i % 2 == 0:
            j = i // 2
            h = h + swiglu(v, dense_wg[j], dense_wu[j], dense_wd[j])
        else:
            j = i // 2
            h = h + moe_swiglu(v, moe_router[j], moe_wg[j], moe_wu[j], moe_wd[j])
        ple_g = jax.nn.sigmoid((rmsnorm(h, norm_ple[i]) @ ple_gate[i]).astype(F32)).astype(h.dtype)
        h = h + ple_g * (p[i] @ ple_proj[i])
    return rmsnorm(h, norm_final)
```

```cpp
#include <hip/hip_runtime.h>
#include <cstdio>
#include <cstdint>

#define LAS __attribute__((address_space(3)))
#define GAS __attribute__((address_space(1)))
typedef unsigned short bf16_t;
typedef short bf16x8 __attribute__((ext_vector_type(8)));
typedef float f32x4 __attribute__((ext_vector_type(4)));
typedef unsigned u32x4 __attribute__((ext_vector_type(4)));
typedef unsigned u32x2 __attribute__((ext_vector_type(2)));

constexpr int D = 1024, SEQ = 2048, BATCH = 32, DEPTH = 4;
constexpr int ZP = 7680;
constexpr int C_HQ = 0, C_HF = 512, C_HI = 1024, C_HG = 1536, C_SQ = 2048, C_SC = 2560, C_IQ = 2688, C_IK = 2944, C_BQ = 3008, C_BK = 3520, C_BV = 4032, C_GZ = 4544, C_IW = 7616;
constexpr int IN_W = 7620, DFF = 2816, NE = 8, PLE = 256;
constexpr float EPS = 1e-6f;
constexpr int NWAVES = 8, NTHR = 512;

constexpr size_t MiB = 1u << 20;
constexpr size_t WS_CTL = 0, CTL_BYTES = 1 * MiB;
constexpr int CW_BAR = 4096;
constexpr int CW_WQ = 8192;
constexpr int CW_MOE = 16384;
constexpr size_t SZ_WIN = (size_t)ZP * D * 2, SZ_WBR = (size_t)3 * D * 512 * 2, SZ_WOUT = (size_t)D * D * 2, SZ_WGU = (size_t)2 * DFF * D * 2, SZ_WD = (size_t)D * DFF * 2,
                 SZ_WPP = (size_t)D * PLE * 2, SZ_WKV = (size_t)128 * 128 * 4;
constexpr size_t WS_WIN = 1 * MiB;
constexpr size_t WS_WBR = WS_WIN + 4 * SZ_WIN;
constexpr size_t WS_WOUT = WS_WBR + 4 * SZ_WBR;
constexpr size_t WS_WDGU = WS_WOUT + 4 * SZ_WOUT;
constexpr size_t WS_WDD = WS_WDGU + 2 * SZ_WGU;
constexpr size_t WS_WMGU = WS_WDD + 2 * SZ_WD;
constexpr size_t WS_WMD = WS_WMGU + 16 * SZ_WGU;
constexpr size_t WS_WPG = WS_WMD + 16 * SZ_WD;
constexpr size_t WS_WPP = WS_WPG + 4 * SZ_WOUT;
constexpr size_t WS_WKV = WS_WPP + 4 * SZ_WPP;
constexpr size_t WS_LB = WS_WKV + 4 * SZ_WKV;
constexpr size_t WS_ACT = ((WS_LB + 4 * 512 * 4 + 4095) / 4096) * 4096;
struct ActMap {
    size_t hb, ssq, ssq1, z, kv, mix, mg, pb, tok_e, tok_w, tok_rstd, rowtok, roww, rowrstd, end;
    __host__ __device__ void init(size_t Ts) {
        size_t o = WS_ACT;
        hb = o; o += Ts * D * 2;
        ssq = o; o += Ts * 16 * 4;
        ssq1 = o; o += Ts * 16 * 4;
        z = o; o += Ts * ZP * 2;
        kv = o; o += Ts * 128 * 2;
        mix = o; o += 3 * Ts * 512 * 2;
        mg = o; o += Ts * D * 2;
        pb = o; o += Ts * PLE * 2;
        tok_e = o; o += Ts * 2 * 4;
        tok_w = o; o += Ts * 2 * 4;
        tok_rstd = o; o += Ts * 4;
        rowtok = o; o += (2 * Ts + 4096) * 4;
        roww = o; o += (2 * Ts + 4096) * 4;
        rowrstd = o; o += (2 * Ts + 4096) * 4;
        end = o;
    }
};

__device__ __forceinline__ int lane_id() { return (int)__builtin_amdgcn_mbcnt_hi(~0u, __builtin_amdgcn_mbcnt_lo(~0u, 0u)); }
__device__ __forceinline__ unsigned f2bf(float f) { unsigned u = __builtin_bit_cast(unsigned, f); return (u + 0x7fffu + ((u >> 16) & 1u)) >> 16; }
__device__ __forceinline__ unsigned pk2(float lo, float hi) { return f2bf(lo) | (f2bf(hi) << 16); }
__device__ __forceinline__ float bflo(unsigned u) { return __builtin_bit_cast(float, u << 16); }
__device__ __forceinline__ float bfhi(unsigned u) { return __builtin_bit_cast(float, u & 0xffff0000u); }
__device__ __forceinline__ float bf2f(bf16_t b) { return __builtin_bit_cast(float, ((unsigned)b) << 16); }
__device__ __forceinline__ float wave_sum(float v) {
    int l = lane_id(); asm volatile("" : "+v"(l));
#pragma unroll
    for (int o = 1; o < 64; o <<= 1) v += __builtin_bit_cast(float, __builtin_amdgcn_ds_bpermute((l ^ o) << 2, __builtin_bit_cast(int, v)));
    return v;
}
__device__ __forceinline__ float wave_max(float v) {
    int l = lane_id(); asm volatile("" : "+v"(l));
#pragma unroll
    for (int o = 1; o < 64; o <<= 1) v = fmaxf(v, __builtin_bit_cast(float, __builtin_amdgcn_ds_bpermute((l ^ o) << 2, __builtin_bit_cast(int, v))));
    return v;
}
__device__ __forceinline__ float sigmoidf_(float x) { return 1.f / (1.f + __expf(-x)); }
__device__ __forceinline__ float siluf_(float x) { return x / (1.f + __expf(-x)); }
__device__ __forceinline__ void unpack8(const uint4 u, float* f) {
    f[0] = bflo(u.x); f[1] = bfhi(u.x); f[2] = bflo(u.y); f[3] = bfhi(u.y); f[4] = bflo(u.z); f[5] = bfhi(u.z); f[6] = bflo(u.w); f[7] = bfhi(u.w);
}

namespace pg8 {
constexpr int BM = 256, BK = 64, HALF = 128, HTB = HALF * BK * 2, STAGE_BYTES = 8 * HTB, NXCD = 8, WGM = 8;
__host__ __device__ __forceinline__ int lds_byte(int r, int c) { const int st = (r >> 4) * 2 + (c >> 5), rr = r & 15, cc = c & 31, ob = rr * 64 + cc * 2; return st * 1024 + (ob ^ (((ob >> 9) & 1) << 5)); }
__host__ __device__ __forceinline__ void stage_rc(int b, int& R, int& C) { const int st = b / 1024, sb = b % 1024, swz = sb ^ (((sb >> 9) & 1) << 5); R = (st >> 1) * 16 + swz / 64; C = (st & 1) * 32 + (swz % 64) / 2; }
__host__ __device__ __forceinline__ int perm32(int rho) { const int n = rho >> 4, i = rho & 15; return 8 * (i >> 2) + 4 * n + (i & 3); }

struct Unit { int pm, pn, ta, tb; };
struct Gemm { const bf16_t* A; const bf16_t* Bt; int K; };

__device__ __forceinline__ void tile_of(int L, int nM, int nN, int& pm, int& pn) {
    const int nwg = nM * nN; int wgid = L;
    { const int q = nwg / NXCD, r = nwg % NXCD, xcd = wgid % NXCD, off = wgid / NXCD; wgid = (xcd < r ? xcd * (q + 1) : r * (q + 1) + (xcd - r) * q) + off; }
    const int nig = WGM * nN, gid = wgid / nig, fm = gid * WGM, gsz = (nM - fm) < WGM ? (nM - fm) : WGM;
    pm = fm + ((wgid % nig) % gsz); pn = (wgid % nig) / gsz;
}
struct PlainOrder {
    int nM, nN, G, c;
    __device__ __forceinline__ bool next(int i, Unit& u) const {
        const long L = (long)i * G + c; if (L >= (long)nM * nN) return false;
        tile_of((int)L, nM, nN, u.pm, u.pn); u.ta = u.pm; u.tb = u.pn; return true;
    }
};

__device__ __forceinline__ unsigned cvt_pk_bf16(float lo, float hi) { unsigned r; asm volatile("v_cvt_pk_bf16_f32 %0, %1, %2" : "=v"(r) : "v"(lo), "v"(hi)); return r; }

template <class Epi, class Sched, bool ALIGN_EPI = true, bool SP2 = true>
__device__ __forceinline__ void gemm_phase(LAS unsigned char* lds, const Gemm g, const Sched& S, const Epi& E, int wave_) {
    int tid_ = wave_ * 64 + lane_id(); asm volatile("" : "+v"(tid_));
    const int tid = tid_, wid = __builtin_amdgcn_readfirstlane(tid >> 6), lane = tid & 63, wr = wid >> 2, wc = wid & 3, fr = lane & 15, fq = lane >> 4;
    int K_ = g.K; asm volatile("" : "+s"(K_));
    const int K = K_, nt = K / BK;
    unsigned voffA[2], voffB[2];
#pragma unroll
    for (int i = 0; i < 2; ++i) { int R, C; stage_rc(tid * 16 + i * 8192, R, C); const int Rb = Epi::PERM ? ((R & ~31) + perm32(R & 31)) : R;
        voffA[i] = (unsigned)(R * K + C) * 2u; voffB[i] = (unsigned)(Rb * K + C) * 2u; }
    const size_t kstep = (size_t)(BK * 2);
    const size_t hstep = (size_t)HALF * K * 2;
    const size_t tstep = 2 * hstep;
    const unsigned ldsw = (unsigned)wid * 1024u;
    const int aoff = lds_byte(wr * 64 + fr, fq * 8), boff = lds_byte(wc * 32 + fr, fq * 8);
#define PG8_SA(b, h) (((b) * 2 + (h)) * HTB)
#define PG8_SB(b, h) ((4 + (b) * 2 + (h)) * HTB)
#define PG8_STAGE(bufoff, gbase, voff) do { _Pragma("unroll") for (int _i = 0; _i < 2; ++_i) \
        __builtin_amdgcn_global_load_lds((const unsigned*)((const char*)(gbase) + (voff)[_i]), (LAS unsigned*)(lds + (bufoff) + ldsw + _i * 8192), 16, 0, 0); } while (0)
#define PG8_LDA(dst, b, h) do { _Pragma("unroll") for (int m = 0; m < 4; ++m) _Pragma("unroll") for (int k = 0; k < 2; ++k) dst[m][k] = *(const LAS bf16x8*)(lds + PG8_SA(b, h) + aoff + m * 2048 + k * 1024); } while (0)
#define PG8_LDB(dst, b, h) do { _Pragma("unroll") for (int n = 0; n < 2; ++n) _Pragma("unroll") for (int k = 0; k < 2; ++k) dst[n][k] = *(const LAS bf16x8*)(lds + PG8_SB(b, h) + boff + n * 2048 + k * 1024); } while (0)
#define PG8_MMA(ai, bj, At, Bt) do { __builtin_amdgcn_s_setprio(1); _Pragma("unroll") for (int m = 0; m < 4; ++m) _Pragma("unroll") for (int n = 0; n < 2; ++n) _Pragma("unroll") for (int k = 0; k < 2; ++k) \
        acc[ai][bj][m][n] = __builtin_amdgcn_mfma_f32_16x16x32_bf16(Bt[n][k], At[m][k], acc[ai][bj][m][n], 0, 0, 0); __builtin_amdgcn_s_setprio(0); } while (0)
#define PG8_WAIT_V(n) asm volatile("s_waitcnt vmcnt(" #n ")" ::: "memory")
#define PG8_WAIT_L(n) asm volatile("s_waitcnt lgkmcnt(" #n ")" ::: "memory")
#define PG8_BAR __builtin_amdgcn_s_barrier()
#define PG8_SCHED __builtin_amdgcn_sched_barrier(0)
    Unit cur, nxt; int ui = 0;
    if (!S.next(0, cur)) return;
    f32x4 acc[2][2][4][2];
#pragma unroll
    for (int a = 0; a < 2; ++a)
#pragma unroll
        for (int b = 0; b < 2; ++b)
#pragma unroll
            for (int m = 0; m < 4; ++m)
#pragma unroll
                for (int n = 0; n < 2; ++n) acc[a][b][m][n] = (f32x4){0.f, 0.f, 0.f, 0.f};
    bf16x8 At[4][2], B0[2][2], B1[2][2];
    const char* cA = (const char*)g.A + (size_t)cur.ta * tstep; const char* cB = (const char*)g.Bt + (size_t)cur.tb * tstep;
    if constexpr (SP2) {
        PG8_STAGE(PG8_SB(0, 0), cB, voffB); PG8_STAGE(PG8_SB(0, 1), cB + hstep, voffB); PG8_STAGE(PG8_SA(0, 0), cA, voffA); PG8_STAGE(PG8_SA(0, 1), cA + hstep, voffA);
        if (wr == 1) PG8_BAR;
        PG8_WAIT_V(2); PG8_BAR;
        PG8_STAGE(PG8_SB(1, 0), cB + kstep, voffB); PG8_STAGE(PG8_SA(1, 0), cA + kstep, voffA); PG8_STAGE(PG8_SB(1, 1), cB + hstep + kstep, voffB);
        PG8_WAIT_V(6); PG8_BAR;
    } else {
        PG8_STAGE(PG8_SB(0, 0), cB, voffB); PG8_STAGE(PG8_SA(0, 0), cA, voffA); PG8_STAGE(PG8_SB(0, 1), cB + hstep, voffB); PG8_STAGE(PG8_SA(0, 1), cA + hstep, voffA);
        if (wr == 1) PG8_BAR;
        PG8_WAIT_V(4); PG8_BAR;
        PG8_STAGE(PG8_SB(1, 0), cB + kstep, voffB); PG8_STAGE(PG8_SA(1, 0), cA + kstep, voffA); PG8_STAGE(PG8_SB(1, 1), cB + hstep + kstep, voffB);
        PG8_WAIT_V(6); PG8_BAR;
    }
    for (;;) {
        const bool has_next = S.next(ui + 1, nxt);
        const char* nA = has_next ? (const char*)g.A + (size_t)nxt.ta * tstep : cA; const char* nB = has_next ? (const char*)g.Bt + (size_t)nxt.tb * tstep : cB;
        for (int t = 0; t < nt; t += 2) {
            const bool last = (t == nt - 2);
            const char* a1 = cA + (size_t)(t + 1) * kstep;
            const char* a2 = last ? nA : cA + (size_t)(t + 2) * kstep; const char* b2 = last ? nB : cB + (size_t)(t + 2) * kstep;
            const char* a3 = a2 + kstep; const char* b3 = b2 + kstep;
            if constexpr (SP2) {
            PG8_LDB(B0, 0, 0); PG8_LDB(B1, 0, 1); PG8_SCHED; PG8_LDA(At, 0, 0); PG8_STAGE(PG8_SA(1, 1), a1 + hstep, voffA);
            PG8_WAIT_V(8); PG8_WAIT_L(0); PG8_BAR; PG8_MMA(0, 0, At, B0); PG8_MMA(0, 1, At, B1); PG8_BAR; PG8_SCHED;
            PG8_LDA(At, 0, 1); PG8_STAGE(PG8_SB(0, 0), b2, voffB); PG8_STAGE(PG8_SB(0, 1), b2 + hstep, voffB); PG8_STAGE(PG8_SA(0, 0), a2, voffA);
            PG8_WAIT_V(8); PG8_WAIT_L(0); PG8_BAR; PG8_MMA(1, 0, At, B0); PG8_MMA(1, 1, At, B1); PG8_BAR; PG8_SCHED;
            PG8_LDB(B0, 1, 0); PG8_LDB(B1, 1, 1); PG8_SCHED; PG8_LDA(At, 1, 0); PG8_STAGE(PG8_SA(0, 1), a2 + hstep, voffA);
            PG8_WAIT_V(8); PG8_WAIT_L(0); PG8_BAR; PG8_MMA(0, 0, At, B0); PG8_MMA(0, 1, At, B1); PG8_BAR; PG8_SCHED;
            PG8_LDA(At, 1, 1); PG8_STAGE(PG8_SB(1, 0), b3, voffB); PG8_STAGE(PG8_SB(1, 1), b3 + hstep, voffB); PG8_STAGE(PG8_SA(1, 0), a3, voffA);
            PG8_WAIT_V(8); PG8_WAIT_L(0); PG8_BAR; PG8_MMA(1, 0, At, B0); PG8_MMA(1, 1, At, B1); PG8_BAR; PG8_SCHED;
            } else {
            PG8_LDB(B0, 0, 0); PG8_SCHED; PG8_LDA(At, 0, 0); PG8_STAGE(PG8_SA(1, 1), a1 + hstep, voffA);
            PG8_WAIT_L(8); PG8_BAR; PG8_WAIT_L(0); PG8_MMA(0, 0, At, B0); PG8_BAR; PG8_SCHED;
            PG8_LDB(B1, 0, 1); PG8_STAGE(PG8_SB(0, 0), b2, voffB);
            PG8_BAR; PG8_WAIT_L(0); PG8_MMA(0, 1, At, B1); PG8_BAR;
            PG8_LDA(At, 0, 1); PG8_STAGE(PG8_SA(0, 0), a2, voffA);
            PG8_BAR; PG8_WAIT_L(0); PG8_MMA(1, 0, At, B0); PG8_BAR; PG8_SCHED;
            PG8_STAGE(PG8_SB(0, 1), b2 + hstep, voffB);
            PG8_WAIT_V(6); PG8_BAR; PG8_MMA(1, 1, At, B1); PG8_BAR;
            PG8_LDB(B0, 1, 0); PG8_SCHED; PG8_LDA(At, 1, 0); PG8_STAGE(PG8_SA(0, 1), a2 + hstep, voffA);
            PG8_WAIT_L(8); PG8_BAR; PG8_WAIT_L(0); PG8_MMA(0, 0, At, B0); PG8_BAR; PG8_SCHED;
            PG8_LDB(B1, 1, 1); PG8_STAGE(PG8_SB(1, 0), b3, voffB);
            PG8_BAR; PG8_WAIT_L(0); PG8_MMA(0, 1, At, B1); PG8_BAR;
            PG8_LDA(At, 1, 1); PG8_STAGE(PG8_SA(1, 0), a3, voffA);
            PG8_BAR; PG8_WAIT_L(0); PG8_MMA(1, 0, At, B0); PG8_BAR; PG8_SCHED;
            PG8_STAGE(PG8_SB(1, 1), b3 + hstep, voffB);
            PG8_WAIT_V(6); PG8_BAR; PG8_MMA(1, 1, At, B1); PG8_BAR;
            }
        }
        if constexpr (ALIGN_EPI) { if (wr == 0) PG8_BAR; }
        E(acc, cur, wr, wc, fr, fq);
        if (!has_next) break;
#pragma unroll
        for (int a = 0; a < 2; ++a)
#pragma unroll
            for (int b = 0; b < 2; ++b)
#pragma unroll
                for (int m = 0; m < 4; ++m)
#pragma unroll
                    for (int n = 0; n < 2; ++n) acc[a][b][m][n] = (f32x4){0.f, 0.f, 0.f, 0.f};
        cur = nxt; cA = nA; cB = nB; ++ui;
        if constexpr (ALIGN_EPI) { if (wr == 1) PG8_BAR; }
    }
    PG8_WAIT_V(0);
    if constexpr (!ALIGN_EPI) { if (wr == 0) PG8_BAR; }
    PG8_BAR;
#undef PG8_SA
#undef PG8_SB
#undef PG8_STAGE
#undef PG8_LDA
#undef PG8_LDB
#undef PG8_MMA
#undef PG8_WAIT_V
#undef PG8_WAIT_L
#undef PG8_BAR
#undef PG8_SCHED
}
}

using pg8::Unit; using pg8::cvt_pk_bf16;
__device__ __forceinline__ float rstd_from_ssq(const float* p) {
    const f32x4 a = *(const f32x4*)p, b = *(const f32x4*)(p + 4), c = *(const f32x4*)(p + 8), d = *(const f32x4*)(p + 12);
    const float s = ((a[0] + a[1]) + (a[2] + a[3])) + ((b[0] + b[1]) + (b[2] + b[3])) + ((c[0] + c[1]) + (c[2] + c[3])) + ((d[0] + d[1]) + (d[2] + d[3]));
    return rsqrtf(s * (1.0f / 1024.0f) + EPS);
}
__device__ __forceinline__ u32x4 pack8(const f32x4 v0, const f32x4 v1) { u32x4 w; w.x = cvt_pk_bf16(v0[0], v0[1]); w.y = cvt_pk_bf16(v0[2], v0[3]); w.z = cvt_pk_bf16(v1[0], v1[1]); w.w = cvt_pk_bf16(v1[2], v1[3]); return w; }
__device__ __forceinline__ void unpack8v(const u32x4 w, f32x4& v0, f32x4& v1) { v0 = (f32x4){bflo(w.x), bfhi(w.x), bflo(w.y), bfhi(w.y)}; v1 = (f32x4){bflo(w.z), bfhi(w.z), bflo(w.w), bfhi(w.w)}; }
__device__ __forceinline__ f32x4 sig4(const f32x4 x) { return (f32x4){sigmoidf_(x[0]), sigmoidf_(x[1]), sigmoidf_(x[2]), sigmoidf_(x[3])}; }

struct EpiZ {
    static constexpr bool PERM = true;
    bf16_t* Z; const float* ssq;
    __device__ __forceinline__ void operator()(const f32x4 (&acc)[2][2][4][2], const Unit& u, int wr, int wc, int fr, int fq) const {
        const int row0 = u.pm * 256 + wr * 64 + fr, col0 = u.pn * 256 + wc * 32 + 8 * fq;
#pragma unroll
        for (int ai = 0; ai < 2; ++ai)
#pragma unroll
            for (int m = 0; m < 4; ++m) { const int row = row0 + ai * 128 + m * 16; const float rs = rstd_from_ssq(ssq + (size_t)row * 16); bf16_t* rowp = Z + (size_t)row * ZP + col0;
#pragma unroll
                for (int bj = 0; bj < 2; ++bj) *(u32x4*)(rowp + bj * 128) = pack8(acc[ai][bj][m][0] * rs, acc[ai][bj][m][1] * rs); }
    }
};
struct EpiRes {
    static constexpr bool PERM = true;
    float* H; bf16_t* HB; float* ssq;
    __device__ __forceinline__ void operator()(const f32x4 (&acc)[2][2][4][2], const Unit& u, int wr, int wc, int fr, int fq) const {
        const int row0 = u.pm * 256 + wr * 64 + fr, col0 = u.pn * 256 + wc * 32 + 8 * fq;
#pragma unroll
        for (int ai = 0; ai < 2; ++ai)
#pragma unroll
            for (int m = 0; m < 4; ++m) { const int row = row0 + ai * 128 + m * 16; float* hp = H + (size_t)row * D + col0; bf16_t* bp = HB + (size_t)row * D + col0; float ss = 0.f;
#pragma unroll
                for (int bj = 0; bj < 2; ++bj) { f32x4 v0 = *(const f32x4*)(hp + bj * 128) + acc[ai][bj][m][0], v1 = *(const f32x4*)(hp + bj * 128 + 4) + acc[ai][bj][m][1];
                    *(f32x4*)(hp + bj * 128) = v0; *(f32x4*)(hp + bj * 128 + 4) = v1; *(u32x4*)(bp + bj * 128) = pack8(v0, v1);
                    ss += (v0[0] * v0[0] + v0[1] * v0[1]) + (v0[2] * v0[2] + v0[3] * v0[3]) + (v1[0] * v1[0] + v1[1] * v1[1]) + (v1[2] * v1[2] + v1[3] * v1[3]); }
                ss += __shfl_xor(ss, 16); ss += __shfl_xor(ss, 32);
                if (fq == 0) ssq[(size_t)row * 16 + u.pn * 4 + wc] = ss; }
    }
};
struct EpiGU {
    static constexpr bool PERM = true;
    bf16_t* HM; const float* ssq; const float* rowrstd;
    __device__ __forceinline__ void operator()(const f32x4 (&acc)[2][2][4][2], const Unit& u, int wr, int wc, int fr, int fq) const {
        const int row0 = u.pm * 256 + wr * 64 + fr, col0 = u.pn * 128 + wc * 32 + 8 * fq;
#pragma unroll
        for (int ai = 0; ai < 2; ++ai)
#pragma unroll
            for (int m = 0; m < 4; ++m) { const int row = row0 + ai * 128 + m * 16; const float rs = rowrstd ? rowrstd[row] : rstd_from_ssq(ssq + (size_t)row * 16);
                f32x4 o0, o1;
#pragma unroll
                for (int j = 0; j < 4; ++j) { const float g0 = acc[ai][0][m][0][j] * rs, g1 = acc[ai][0][m][1][j] * rs; o0[j] = siluf_(g0) * (acc[ai][1][m][0][j] * rs); o1[j] = siluf_(g1) * (acc[ai][1][m][1][j] * rs); }
                *(u32x4*)(HM + (size_t)row * DFF + col0) = pack8(o0, o1); }
    }
};
struct EpiMerge {
    static constexpr bool PERM = true;
    bf16_t* MG; const bf16_t* Z;
    __device__ __forceinline__ void operator()(const f32x4 (&acc)[2][2][4][2], const Unit& u, int wr, int wc, int fr, int fq) const {
        const int br = u.pn >> 2, pn = u.pn & 3;
        const int row0 = u.pm * 256 + wr * 64 + fr, col0 = pn * 256 + wc * 32 + 8 * fq;
#pragma unroll
        for (int ai = 0; ai < 2; ++ai)
#pragma unroll
            for (int m = 0; m < 4; ++m) { const int row = row0 + ai * 128 + m * 16; bf16_t* mp = MG + (size_t)row * D + col0; const bf16_t* gp = Z + (size_t)row * ZP + C_GZ + br * D + col0;
#pragma unroll
                for (int bj = 0; bj < 2; ++bj) { f32x4 g0, g1; unpack8v(*(const u32x4*)(gp + bj * 128), g0, g1);
                    f32x4 v0 = sig4(g0) * acc[ai][bj][m][0], v1 = sig4(g1) * acc[ai][bj][m][1];
                    if (br > 0) { f32x4 p0, p1; unpack8v(*(const u32x4*)(mp + bj * 128), p0, p1); v0 += p0; v1 += p1; }
                    *(u32x4*)(mp + bj * 128) = pack8(v0, v1); } }
    }
};
struct EpiBf {
    static constexpr bool PERM = true;
    bf16_t* O;
    __device__ __forceinline__ void operator()(const f32x4 (&acc)[2][2][4][2], const Unit& u, int wr, int wc, int fr, int fq) const {
        const int row0 = u.pm * 256 + wr * 64 + fr, col0 = u.pn * 256 + wc * 32 + 8 * fq;
#pragma unroll
        for (int ai = 0; ai < 2; ++ai)
#pragma unroll
            for (int m = 0; m < 4; ++m) { const int row = row0 + ai * 128 + m * 16; bf16_t* op = O + (size_t)row * D + col0;
#pragma unroll
                for (int bj = 0; bj < 2; ++bj) *(u32x4*)(op + bj * 128) = pack8(acc[ai][bj][m][0], acc[ai][bj][m][1]); }
    }
};
struct EpiPle {
    static constexpr bool PERM = true;
    float* H; bf16_t* HB; float* ssq_out; const float* ssq_in; const bf16_t* PP;
    __device__ __forceinline__ void operator()(const f32x4 (&acc)[2][2][4][2], const Unit& u, int wr, int wc, int fr, int fq) const {
        const int row0 = u.pm * 256 + wr * 64 + fr, col0 = u.pn * 256 + wc * 32 + 8 * fq;
#pragma unroll
        for (int ai = 0; ai < 2; ++ai)
#pragma unroll
            for (int m = 0; m < 4; ++m) { const int row = row0 + ai * 128 + m * 16; const float rs = rstd_from_ssq(ssq_in + (size_t)row * 16);
                float* hp = H + (size_t)row * D + col0; bf16_t* bp = HB + (size_t)row * D + col0; const bf16_t* pp = PP + (size_t)row * D + col0; float ss = 0.f;
#pragma unroll
                for (int bj = 0; bj < 2; ++bj) { f32x4 p0, p1; unpack8v(*(const u32x4*)(pp + bj * 128), p0, p1);
                    const f32x4 v0 = *(const f32x4*)(hp + bj * 128) + sig4(acc[ai][bj][m][0] * rs) * p0, v1 = *(const f32x4*)(hp + bj * 128 + 4) + sig4(acc[ai][bj][m][1] * rs) * p1;
                    *(f32x4*)(hp + bj * 128) = v0; *(f32x4*)(hp + bj * 128 + 4) = v1; *(u32x4*)(bp + bj * 128) = pack8(v0, v1);
                    ss += (v0[0] * v0[0] + v0[1] * v0[1]) + (v0[2] * v0[2] + v0[3] * v0[3]) + (v1[0] * v1[0] + v1[1] * v1[1]) + (v1[2] * v1[2] + v1[3] * v1[3]); }
                ss += __shfl_xor(ss, 16); ss += __shfl_xor(ss, 32);
                if (fq == 0) ssq_out[(size_t)row * 16 + u.pn * 4 + wc] = ss;
                asm volatile("" ::: "memory"); }
    }
};
template <int RANK> struct EpiMoeDown {
    static constexpr bool PERM = true;
    float* H; bf16_t* HB; float* ssq; const int* rowtok; const float* roww;
    __device__ __forceinline__ void operator()(const f32x4 (&acc)[2][2][4][2], const Unit& u, int wr, int wc, int fr, int fq) const {
        const int row0 = u.pm * 256 + wr * 64 + fr, col0 = u.pn * 256 + wc * 32 + 8 * fq;
#pragma unroll
        for (int ai = 0; ai < 2; ++ai)
#pragma unroll
            for (int m = 0; m < 4; ++m) { const int pos = row0 + ai * 128 + m * 16; const int tok = rowtok[pos]; const float w = roww[pos];
                float ss = 0.f;
                if (tok >= 0) { float* hp = H + (size_t)tok * D + col0; bf16_t* bp = HB + (size_t)tok * D + col0;
#pragma unroll
                    for (int bj = 0; bj < 2; ++bj) { f32x4 v0 = *(const f32x4*)(hp + bj * 128) + acc[ai][bj][m][0] * w, v1 = *(const f32x4*)(hp + bj * 128 + 4) + acc[ai][bj][m][1] * w;
                        *(f32x4*)(hp + bj * 128) = v0; *(f32x4*)(hp + bj * 128 + 4) = v1;
                        if (RANK == 1) { *(u32x4*)(bp + bj * 128) = pack8(v0, v1);
                            ss += (v0[0] * v0[0] + v0[1] * v0[1]) + (v0[2] * v0[2] + v0[3] * v0[3]) + (v1[0] * v1[0] + v1[1] * v1[1]) + (v1[2] * v1[2] + v1[3] * v1[3]); } } }
                if (RANK == 1) { ss += __shfl_xor(ss, 16); ss += __shfl_xor(ss, 32); if (fq == 0 && tok >= 0) ssq[(size_t)tok * 16 + u.pn * 4 + wc] = ss; } }
    }
};

#define XB_TMO      128
#define XB_XCNT(j)  (256  + 64 * (j))
#define XB_XSUB(j)  (1280 + 64 * (j))
#define XB_XGEN(j)  (2304 + 64 * (j))
#define XB_TOP      3328
#define XB_TOPGEN   3392
#define XCD_BAR_WORDS 3456
#define XB_SPIN_CAP (1u << 20)

__device__ __forceinline__ unsigned xb_ld(unsigned* p)              { return __hip_atomic_load(p, __ATOMIC_RELAXED, __HIP_MEMORY_SCOPE_AGENT); }
__device__ __forceinline__ unsigned xb_add(unsigned* p, unsigned v) { return __hip_atomic_fetch_add(p, v, __ATOMIC_RELAXED, __HIP_MEMORY_SCOPE_AGENT); }
__device__ __forceinline__ unsigned xb_xcc_id() { return (unsigned)__builtin_amdgcn_s_getreg((3 << 11) | 20) & 0xFu; }
#define XB_SPIN(cond, bar) do { unsigned _sp = 0; while (cond) { __builtin_amdgcn_s_sleep(1); \
    if ((++_sp & 255u) == 0u) { if (xb_ld(&(bar)[XB_TMO])) break; if (_sp > XB_SPIN_CAP) { atomicAdd(&(bar)[XB_TMO], 1u); break; } } } } while (0)

struct XcdBarrier { unsigned* bar; unsigned x; volatile LAS unsigned* st; };

__device__ __forceinline__ XcdBarrier xcd_barrier_post(unsigned* bar, volatile LAS unsigned* st) {
    XcdBarrier b; b.bar = bar; b.x = xb_xcc_id(); b.st = st;
    if (threadIdx.x == 0) (void)xb_add(&bar[XB_XCNT(b.x)], 1u);
    return b;
}
__device__ __forceinline__ void xcd_barrier_complete(unsigned* bar, unsigned x, unsigned& nloc, unsigned& nx) {
    const unsigned G = gridDim.x * gridDim.y * gridDim.z;
    unsigned sum, cnt, mine, sp = 0u;
    for (;;) {
        sum = 0u; cnt = 0u; mine = 0u;
#pragma unroll
        for (unsigned j = 0; j < 16; ++j) { const unsigned c = xb_ld(&bar[XB_XCNT(j)]); sum += c; cnt += (c > 0u) ? 1u : 0u; mine = (j == x) ? c : mine; }
        if (sum == G) break;
        __builtin_amdgcn_s_sleep(1);
        if ((++sp & 255u) == 0u) { if (xb_ld(&bar[XB_TMO])) break; if (sp > XB_SPIN_CAP) { atomicAdd(&bar[XB_TMO], 1u); break; } }
    }
    nloc = mine > 0u ? mine : 1u; nx = cnt > 0u ? cnt : 1u;
}
__device__ __forceinline__ void xcd_barrier(const XcdBarrier& b, int wave_) {
    asm volatile("s_waitcnt vmcnt(0)" ::: "memory");
    __syncthreads();
    if (wave_ == 0 && lane_id() == 0) {
        unsigned* bar = b.bar;
        __builtin_amdgcn_s_waitcnt(0);
        unsigned nloc = b.st[0], nx = b.st[1];
        if (nloc == 0u) { xcd_barrier_complete(bar, b.x, nloc, nx); b.st[0] = nloc; b.st[1] = nx; }
        const unsigned old = xb_add(&bar[XB_XSUB(b.x)], 1u);
        const unsigned gen = old / nloc;
        if (old + 1u == (gen + 1u) * nloc) {
            __builtin_amdgcn_fence(__ATOMIC_RELEASE, "agent");
            asm volatile("s_waitcnt vmcnt(0)" ::: "memory");
            const unsigned og = xb_add(&bar[XB_TOP], 1u);
            const unsigned tg = og / nx;
            if (og + 1u == (tg + 1u) * nx) xb_add(&bar[XB_TOPGEN], 1u);
            else XB_SPIN(xb_ld(&bar[XB_TOPGEN]) == tg, bar);
            __builtin_amdgcn_fence(__ATOMIC_ACQUIRE, "agent");
            xb_add(&bar[XB_XGEN(b.x)], 1u);
            asm volatile("s_waitcnt vmcnt(0)" ::: "memory");
        } else {
            XB_SPIN(xb_ld(&bar[XB_XGEN(b.x)]) == gen, bar);
            __builtin_amdgcn_fence(__ATOMIC_ACQUIRE, "agent");
            asm volatile("s_waitcnt vmcnt(0)" ::: "memory");
        }
    }
    __syncthreads();
}

constexpr int RING_BYTES = 131072;
constexpr int LDSCTL_OFF = RING_BYTES;
constexpr int LDS_BYTES = 147456;

struct Frame {
    unsigned char* lds; LAS unsigned char* lds3; volatile LAS unsigned* lctl;
    unsigned* ctl; unsigned char* ws;
    int tid, lane, wave, G, bid, wave0;
    __device__ __forceinline__ void retid() { int t = wave0 * 64 + lane_id(); asm volatile("" : "+v"(t)); tid = t; lane = t & 63; wave = __builtin_amdgcn_readfirstlane(t >> 6); }
};
#define LDS_WAIT() asm volatile("s_waitcnt lgkmcnt(0)" ::: "memory")

__device__ __forceinline__ int conv_rowmap(int mode, int n) {
    if (mode == 1) return n < 3008 ? n : (n < 3012 ? 7616 + (n - 3008) : n - 4);
    if (mode == 2) return 256 * (n >> 7) + (n & 127);
    if (mode == 3) return 256 * (n >> 7) + 128 + (n & 127);
    return n;
}
__device__ __forceinline__ void conv_item(const float* W, int K, int N, const float* ksc, bf16_t* WT, int mode, float* scr, int item, int lane) {
    const int nblk = (N + 31) / 32, kb = item / nblk, nb = item % nblk, k0 = 64 * kb, n0 = 32 * nb;
    const int nl = n0 + (lane & 31);
#pragma unroll 8
    for (int i = 0; i < 32; ++i) { const int kk = 2 * i + (lane >> 5); float v = 0.f; if (nl < N) { v = W[(size_t)(k0 + kk) * N + nl]; if (ksc) v *= ksc[k0 + kk]; } scr[kk * 33 + (lane & 31)] = v; }
    LDS_WAIT(); __builtin_amdgcn_wave_barrier();
    const int c = lane & 7;
#pragma unroll
    for (int j = 0; j < 4; ++j) { const int n = (lane >> 3) + 8 * j; const int ng = n0 + n;
        if (ng < N) { const float* s = scr + (8 * c) * 33 + n; uint4 o; o.x = pk2(s[0 * 33], s[1 * 33]); o.y = pk2(s[2 * 33], s[3 * 33]); o.z = pk2(s[4 * 33], s[5 * 33]); o.w = pk2(s[6 * 33], s[7 * 33]);
            *(uint4*)(WT + (size_t)conv_rowmap(mode, ng) * K + k0 + 8 * c) = o; } }
    LDS_WAIT(); __builtin_amdgcn_wave_barrier();
}
template <class IN> __device__ __forceinline__ void phase_prologue(Frame& F, const IN in) {
    F.retid();
    float* scr = (float*)(F.lds + F.wave * 16384);
    const int gw = F.bid * NWAVES + F.wave, NGW = F.G * NWAVES;
    constexpr int NT = 11;
    const int tcount[NT] = {4, 12, 4, 2, 2, 2, 16, 16, 16, 4, 4};
    const int titems[NT] = {16 * 239, 8 * 32, 16 * 32, 16 * 88, 16 * 88, 44 * 32, 16 * 88, 16 * 88, 44 * 32, 16 * 32, 4 * 32};
    int total = 0;
#pragma unroll
    for (int t = 0; t < NT; ++t) total += tcount[t] * titems[t];
    for (int it = gw; it < total; it += NGW) {
        int r = it, t = 0;
#pragma unroll
        for (int q = 0; q < NT - 1; ++q) { if (t == q && r >= tcount[q] * titems[q]) { r -= tcount[q] * titems[q]; t = q + 1; } }
        const int mi = r / titems[t], item = r % titems[t];
        const float* W; int K, N, mode = 0; const float* ksc = nullptr; bf16_t* WT;
        switch (t) {
        case 0: W = in[4] + (size_t)mi * D * IN_W; K = D; N = IN_W; ksc = in[3] + mi * D; WT = (bf16_t*)(F.ws + WS_WIN + mi * SZ_WIN); mode = 1; break;
        case 1: W = in[9] + (size_t)mi * 512 * D; K = 512; N = D; WT = (bf16_t*)(F.ws + WS_WBR + (size_t)mi * D * 512 * 2); break;
        case 2: W = in[10] + (size_t)mi * D * D; K = D; N = D; WT = (bf16_t*)(F.ws + WS_WOUT + mi * SZ_WOUT); break;
        case 3: W = in[12] + (size_t)mi * D * DFF; K = D; N = DFF; ksc = in[11] + (2 * mi) * D; WT = (bf16_t*)(F.ws + WS_WDGU + mi * SZ_WGU); mode = 2; break;
        case 4: W = in[13] + (size_t)mi * D * DFF; K = D; N = DFF; ksc = in[11] + (2 * mi) * D; WT = (bf16_t*)(F.ws + WS_WDGU + mi * SZ_WGU); mode = 3; break;
        case 5: W = in[14] + (size_t)mi * DFF * D; K = DFF; N = D; WT = (bf16_t*)(F.ws + WS_WDD + mi * SZ_WD); break;
        case 6: W = in[16] + (size_t)mi * D * DFF; K = D; N = DFF; ksc = in[11] + (2 * (mi >> 3) + 1) * D; WT = (bf16_t*)(F.ws + WS_WMGU + mi * SZ_WGU); mode = 2; break;
        case 7: W = in[17] + (size_t)mi * D * DFF; K = D; N = DFF; ksc = in[11] + (2 * (mi >> 3) + 1) * D; WT = (bf16_t*)(F.ws + WS_WMGU + mi * SZ_WGU); mode = 3; break;
        case 8: W = in[18] + (size_t)mi * DFF * D; K = DFF; N = D; WT = (bf16_t*)(F.ws + WS_WMD + mi * SZ_WD); break;
        case 9: W = in[20] + (size_t)mi * D * D; K = D; N = D; ksc = in[19] + mi * D; WT = (bf16_t*)(F.ws + WS_WPG + mi * SZ_WOUT); break;
        default: W = in[21] + (size_t)mi * PLE * D; K = PLE; N = D; WT = (bf16_t*)(F.ws + WS_WPP + mi * SZ_WPP); break;
        }
        conv_item(W, K, N, ksc, WT, mode, scr, item, F.lane);
    }
    const int gt = F.bid * NTHR + F.tid, NGT = F.G * NTHR;
    float* wkv = (float*)(F.ws + WS_WKV);
    for (int i = gt; i < 4 * 128 * 128; i += NGT) { const int l = i >> 14, j = (i >> 7) & 127, n = i & 127;
        const float w = n < 64 ? in[7][((size_t)l * 128 + j) * 64 + n] : in[8][((size_t)l * 128 + j) * 64 + (n - 64)];
        wkv[i] = in[6][l * 128 + j] * w; }
    float* lb = (float*)(F.ws + WS_LB);
    for (int ch = gt; ch < 512; ch += NGT) { float v[4], mx = -1e30f;
#pragma unroll
        for (int l = 0; l < 4; ++l) { v[l] = in[2][l * 512 + ch]; mx = fmaxf(mx, v[l]); }
        float s = 0.f;
#pragma unroll
        for (int l = 0; l < 4; ++l) { v[l] = __expf(v[l] - mx); s += v[l]; }
        float c = 0.f; lb[ch] = 0.f;
#pragma unroll
        for (int l = 1; l < 4; ++l) { c += v[l] / s; lb[l * 512 + ch] = c; } }
}

__device__ __forceinline__ void phase_init(Frame& F, const float* x, float* H, bf16_t* HBN, float* ssq1, int Ts) {
    F.retid();
    const int gw = F.bid * NWAVES + F.wave, NGW = F.G * NWAVES;
    for (int r = gw; r < Ts; r += NGW) {
        const f32x4* xr = (const f32x4*)(x + (size_t)r * D) + F.lane; f32x4* hr = (f32x4*)(H + (size_t)r * D) + F.lane; u32x2* br = (u32x2*)(HBN + (size_t)r * D) + F.lane;
        float ss = 0.f;
#pragma unroll
        for (int j = 0; j < 4; ++j) { const f32x4 v = xr[64 * j]; hr[64 * j] = v; u32x2 w; w.x = pk2(v[0], v[1]); w.y = pk2(v[2], v[3]); br[64 * j] = w; ss += (v[0] * v[0] + v[1] * v[1]) + (v[2] * v[2] + v[3] * v[3]); }
        ss = wave_sum(ss);
        if (F.lane < 16) ssq1[(size_t)r * 16 + F.lane] = F.lane == 0 ? ss : 0.f;
    }
}
__device__ __forceinline__ void phase_final(Frame& F, float* H, const float* g, int Ts) {
    F.retid();
    const int gw = F.bid * NWAVES + F.wave, NGW = F.G * NWAVES;
    for (int r = gw; r < Ts; r += NGW) {
        f32x4* hr = (f32x4*)(H + (size_t)r * D) + F.lane; const f32x4* gr = (const f32x4*)g + F.lane; f32x4 v[4]; float ss = 0.f;
#pragma unroll
        for (int j = 0; j < 4; ++j) { v[j] = hr[64 * j]; ss += (v[j][0] * v[j][0] + v[j][1] * v[j][1]) + (v[j][2] * v[j][2] + v[j][3] * v[j][3]); }
        const float rs = rsqrtf(wave_sum(ss) * (1.f / D) + EPS);
#pragma unroll
        for (int j = 0; j < 4; ++j) hr[64 * j] = v[j] * rs * gr[64 * j];
    }
}
__device__ __forceinline__ void phase_prep(Frame& F, const bf16_t* Z, bf16_t* KV, const float* wkv, const float* p, bf16_t* PB, int Ts) {
    F.retid();
    float* wl = (float*)F.lds;
    for (int i = F.tid; i < 128 * 128; i += NTHR) wl[i] = wkv[i];
    __syncthreads();
    const int gw = F.bid * NWAVES + F.wave, NGW = F.G * NWAVES;
    for (int r = gw; r < Ts; r += NGW) {
        const bf16_t* zr = Z + (size_t)r * ZP + C_SC;
        float c0 = bf2f(zr[F.lane]), c1 = bf2f(zr[64 + F.lane]);
        const float rs = rsqrtf(wave_sum(c0 * c0 + c1 * c1) * (1.f / 128.f) + EPS);
        c0 *= rs; c1 *= rs;
        float a0 = 0.f, a1 = 0.f;
        for (int j = 0; j < 64; ++j) { const float cj = __shfl(c0, j); a0 += cj * wl[j * 128 + F.lane]; a1 += cj * wl[j * 128 + 64 + F.lane]; }
        for (int j = 0; j < 64; ++j) { const float cj = __shfl(c1, j); a0 += cj * wl[(64 + j) * 128 + F.lane]; a1 += cj * wl[(64 + j) * 128 + 64 + F.lane]; }
        KV[(size_t)r * 128 + F.lane] = (bf16_t)f2bf(a0); KV[(size_t)r * 128 + 64 + F.lane] = (bf16_t)f2bf(a1);
    }
    const int gt = F.bid * NTHR + F.tid, NGT = F.G * NTHR;
    for (int i = gt; i < Ts * (PLE / 8); i += NGT) { const f32x4 a = *(const f32x4*)(p + (size_t)i * 8), b = *(const f32x4*)(p + (size_t)i * 8 + 4);
        uint4 o; o.x = pk2(a[0], a[1]); o.y = pk2(a[2], a[3]); o.z = pk2(b[0], b[1]); o.w = pk2(b[2], b[3]); *(uint4*)(PB + (size_t)i * 8) = o; }
    __syncthreads();
}

__device__ __forceinline__ void hgrn_naive_unit(Frame& F, const bf16_t* Z, bf16_t* OA, const float* lbl, const float* onorm, int b, int h) {
    float* Qs = (float*)F.lds; float* Fs = Qs + 16 * 128; float* Vs = Fs + 16 * 128; float* OP = Vs + 16 * 128;
    const int dv = F.tid & 127, dkg = F.tid >> 7;
    float S[32];
#pragma unroll
    for (int i = 0; i < 32; ++i) S[i] = 0.f;
    const size_t row0 = (size_t)b * SEQ;
    for (int t0 = 0; t0 < SEQ; t0 += 16) {
        __syncthreads();
        for (int i = F.tid; i < 16 * 128; i += NTHR) { const int tt = i >> 7, ch = i & 127; const bf16_t* zr = Z + (row0 + t0 + tt) * ZP + h * 128 + ch;
            const float q = bf2f(zr[C_HQ]), fp = bf2f(zr[C_HF]), v = bf2f(zr[C_HI]); const float lb = lbl[h * 128 + ch];
            Qs[i] = siluf_(q); Fs[i] = lb + (1.f - lb) * sigmoidf_(fp); Vs[i] = v; }
        __syncthreads();
        for (int tt = 0; tt < 16; ++tt) {
            const float vv = Vs[tt * 128 + dv]; float po = 0.f;
            const float* fr_ = Fs + tt * 128 + dkg * 32; const float* qr_ = Qs + tt * 128 + dkg * 32;
#pragma unroll
            for (int i = 0; i < 32; ++i) { const float fi = fr_[i]; S[i] = fi * S[i] + (1.f - fi) * vv; po += S[i] * qr_[i]; }
            OP[(tt * 4 + dkg) * 128 + dv] = po;
        }
        __syncthreads();
#pragma unroll
        for (int k = 0; k < 2; ++k) { const int tt = 2 * F.wave + k;
            float o0 = 0.f, o1 = 0.f;
#pragma unroll
            for (int g = 0; g < 4; ++g) { o0 += OP[(tt * 4 + g) * 128 + F.lane]; o1 += OP[(tt * 4 + g) * 128 + 64 + F.lane]; }
            const float rs = rsqrtf(wave_sum(o0 * o0 + o1 * o1) * (1.f / 128.f) + EPS);
            const bf16_t* zg = Z + (row0 + t0 + tt) * ZP + C_HG + h * 128;
            bf16_t* oa = OA + (row0 + t0 + tt) * 512 + h * 128;
            oa[F.lane] = (bf16_t)f2bf(o0 * rs * onorm[F.lane] * siluf_(bf2f(zg[F.lane])));
            oa[64 + F.lane] = (bf16_t)f2bf(o1 * rs * onorm[64 + F.lane] * siluf_(bf2f(zg[64 + F.lane]))); }
    }
    __syncthreads();
}
__device__ __forceinline__ void sb_naive_unit(Frame& F, const bf16_t* Z, bf16_t* OC, int b, int h, int qblk) {
    const int t = qblk * NTHR + F.tid; const size_t row0 = (size_t)b * SEQ;
    float q[64], o[64];
    { const uint4* qp = (const uint4*)(Z + (row0 + t) * ZP + C_BQ + h * 64);
#pragma unroll
      for (int c = 0; c < 8; ++c) { float f[8]; unpack8(qp[c], f);
#pragma unroll
          for (int e = 0; e < 8; ++e) { q[c * 8 + e] = f[e] * 0.125f; o[c * 8 + e] = 0.f; } } }
    float P = 1.f;
    for (int s = t - 1; s >= 0; --s) {
        if (P < 1e-30f) break;
        const uint4* kp = (const uint4*)(Z + (row0 + s) * ZP + C_BK + h * 64); const uint4* vp = (const uint4*)(Z + (row0 + s) * ZP + C_BV + h * 64);
        float dot = 0.f;
#pragma unroll
        for (int c = 0; c < 8; ++c) { float f[8]; unpack8(kp[c], f);
#pragma unroll
            for (int e = 0; e < 8; ++e) dot += q[c * 8 + e] * f[e]; }
        const float zc = fmaxf(dot, -80.f), ex = __expf(-zc), beta = 1.f / (1.f + ex), A = beta * P;
        P *= ex * beta;
#pragma unroll
        for (int c = 0; c < 8; ++c) { float f[8]; unpack8(vp[c], f);
#pragma unroll
            for (int e = 0; e < 8; ++e) o[c * 8 + e] += A * f[e]; }
    }
    uint4* op = (uint4*)(OC + (row0 + t) * 512 + h * 64);
#pragma unroll
    for (int c = 0; c < 8; ++c) { uint4 w; w.x = pk2(o[c * 8], o[c * 8 + 1]); w.y = pk2(o[c * 8 + 2], o[c * 8 + 3]); w.z = pk2(o[c * 8 + 4], o[c * 8 + 5]); w.w = pk2(o[c * 8 + 6], o[c * 8 + 7]); op[c] = w; }
}
__device__ __forceinline__ void dsa_naive_query(const bf16_t* Z, const bf16_t* KV, bf16_t* OB, int tokl, float* wl, int lane) {
    const int b = tokl / SEQ, t = tokl % SEQ, c = t >> 6, nj = c + 1; const size_t row0 = (size_t)b * SEQ;
    float* iq_s = wl; float* q_s = wl + 256; int* list = (int*)(wl + 768); float* Pm = wl + 1024;
    const bf16_t* zr = Z + (size_t)tokl * ZP;
    LDS_WAIT(); __builtin_amdgcn_wave_barrier();
#pragma unroll
    for (int i = 0; i < 4; ++i) iq_s[lane + 64 * i] = bf2f(zr[C_IQ + lane + 64 * i]);
#pragma unroll
    for (int i = 0; i < 8; ++i) q_s[lane + 64 * i] = bf2f(zr[C_SQ + lane + 64 * i]) * 0.125f;
    const float w0 = bf2f(zr[C_IW + 0]) * 0.5f, w1 = bf2f(zr[C_IW + 1]) * 0.5f, w2 = bf2f(zr[C_IW + 2]) * 0.5f, w3 = bf2f(zr[C_IW + 3]) * 0.5f;
    LDS_WAIT(); __builtin_amdgcn_wave_barrier();
    unsigned* keyl = (unsigned*)Pm;
    for (int j = 0; j < nj; ++j) {
        const uint4* kp = (const uint4*)(Z + (row0 + j * 64 + lane) * ZP + C_IK);
        float d0 = 0.f, d1 = 0.f, d2 = 0.f, d3 = 0.f;
#pragma unroll 1
        for (int ch = 0; ch < 8; ++ch) { float f[8]; unpack8(kp[ch], f);
#pragma unroll
            for (int e = 0; e < 8; ++e) { const int dd = ch * 8 + e; d0 += iq_s[dd] * f[e]; d1 += iq_s[64 + dd] * f[e]; d2 += iq_s[128 + dd] * f[e]; d3 += iq_s[192 + dd] * f[e]; } }
        float isc = fmaxf(d0, 0.f) * w0 + fmaxf(d1, 0.f) * w1 + fmaxf(d2, 0.f) * w2 + fmaxf(d3, 0.f) * w3; isc += 0.0f;
        unsigned u = __builtin_bit_cast(unsigned, isc); u ^= (u >> 31) ? 0xffffffffu : 0x80000000u; keyl[j * 64 + lane] = u;
    }
    LDS_WAIT(); __builtin_amdgcn_wave_barrier();
    const unsigned long long lt = (1ull << lane) - 1ull;
    int nsel = 0;
    if (nj <= 4) {
        for (int j = 0; j < nj; ++j) list[j * 64 + lane] = j * 64 + lane;
        nsel = nj * 64;
    } else {
        unsigned thr = 0u;
        for (int bit = 31; bit >= 0; --bit) { const unsigned cand = thr | (1u << bit); int cnt = 0;
            for (int j = 0; j < nj; ++j) cnt += __popcll(__ballot(keyl[j * 64 + lane] >= cand));
            if (cnt >= 256) thr = cand; }
        int cgt = 0;
        for (int j = 0; j < nj; ++j) cgt += __popcll(__ballot(keyl[j * 64 + lane] > thr));
        const int need = 256 - cgt; int beq = 0;
        for (int j = 0; j < nj; ++j) {
            const unsigned kj = keyl[j * 64 + lane];
            const bool gt = kj > thr, eq = kj == thr;
            const unsigned long long meq = __ballot(eq); const int rank = beq + __popcll(meq & lt); beq += __popcll(meq);
            const bool sel = gt || (eq && rank < need);
            const unsigned long long ms = __ballot(sel); if (sel) list[nsel + __popcll(ms & lt)] = j * 64 + lane; nsel += __popcll(ms);
        }
    }
    LDS_WAIT(); __builtin_amdgcn_wave_barrier();
#pragma unroll 1
    for (int i = 0; i < 4; ++i) { const int e = lane + 64 * i; const bool valid = e < nsel; const int s = valid ? list[e] : 0;
        const uint4* kp = (const uint4*)(KV + (row0 + s) * 128);
        float kf[64];
#pragma unroll
        for (int ch = 0; ch < 8; ++ch) unpack8(kp[ch], kf + ch * 8);
#pragma unroll 1
        for (int hh = 0; hh < 8; ++hh) { float d = 0.f;
#pragma unroll
            for (int dd = 0; dd < 64; ++dd) d += q_s[hh * 64 + dd] * kf[dd];
            Pm[e * 8 + hh] = valid ? d : -INFINITY; } }
    LDS_WAIT(); __builtin_amdgcn_wave_barrier();
#pragma unroll 1
    for (int hh = 0; hh < 8; ++hh) { float p[4]; float m = -INFINITY;
#pragma unroll
        for (int i = 0; i < 4; ++i) { p[i] = Pm[(lane + 64 * i) * 8 + hh]; m = fmaxf(m, p[i]); }
        m = wave_max(m); float sm = 0.f;
#pragma unroll
        for (int i = 0; i < 4; ++i) { p[i] = __expf(p[i] - m); sm += p[i]; }
        sm = wave_sum(sm); const float inv = 1.f / sm;
#pragma unroll
        for (int i = 0; i < 4; ++i) Pm[(lane + 64 * i) * 8 + hh] = p[i] * inv; }
    LDS_WAIT(); __builtin_amdgcn_wave_barrier();
    const int hh = lane >> 3, db = (lane & 7) * 8; float o[8];
#pragma unroll
    for (int e = 0; e < 8; ++e) o[e] = 0.f;
    for (int e = 0; e < nsel; ++e) { const int s = list[e]; const float p = Pm[e * 8 + hh]; float f[8]; unpack8(*(const uint4*)(KV + (row0 + s) * 128 + 64 + db), f);
#pragma unroll
        for (int k = 0; k < 8; ++k) o[k] += p * f[k]; }
    uint4 w; w.x = pk2(o[0], o[1]); w.y = pk2(o[2], o[3]); w.z = pk2(o[4], o[5]); w.w = pk2(o[6], o[7]);
    *(uint4*)(OB + (size_t)tokl * 512 + hh * 64 + db) = w;
}
__device__ __forceinline__ void phase_mixers(Frame& F, const bf16_t* Z, const bf16_t* KV, bf16_t* MIX, const float* lbl, const float* onorm, unsigned* wq, int Ts) {
    F.retid();
    const int NBq = Ts / SEQ; const int NH = NBq * 4, NDSA = Ts / 64, NSBU = NBq * 8 * 4, NU = NH + NDSA + NSBU;
    bf16_t* OA = MIX; bf16_t* OB = MIX + (size_t)Ts * 512; bf16_t* OC = MIX + (size_t)2 * Ts * 512;
    for (;;) {
        __syncthreads();
        if (F.tid == 0) F.lctl[4] = atomicAdd(wq, 1u);
        __syncthreads();
        const int u = (int)F.lctl[4];
        if (u >= NU) break;
        if (u < NH) { hgrn_naive_unit(F, Z, OA, lbl, onorm, u >> 2, u & 3); }
        else if (u < NH + NDSA) { const int q0 = (NDSA - 1 - (u - NH)) * 64; float* wl = (float*)(F.lds + F.wave * 12288);
            for (int i = 0; i < 8; ++i) dsa_naive_query(Z, KV, OB, q0 + F.wave * 8 + i, wl, F.lane); }
        else { const int idx = u - NH - NDSA; const int qblk = 3 - (idx / (NBq * 8)), bh = idx % (NBq * 8); sb_naive_unit(F, Z, OC, bh >> 3, bh & 7, qblk); }
    }
}

struct MoeTab { int start[17]; };
__device__ __forceinline__ void moe_tab(MoeTab& T, const unsigned* cnt) {
    int s = 0;
#pragma unroll
    for (int g = 0; g < 16; ++g) { T.start[g] = s; s += ((int)__hip_atomic_load(cnt + g, __ATOMIC_RELAXED, __HIP_MEMORY_SCOPE_AGENT) + 255) >> 8; }
    T.start[16] = s;
}
__device__ __forceinline__ int moe_group_of(const MoeTab& T, int r) { int g = 0;
#pragma unroll
    for (int j = 1; j < 16; ++j) g += (r >= T.start[j]) ? 1 : 0;
    return g; }
struct MoeGuOrder { MoeTab T; int G, c;
    __device__ __forceinline__ bool next(int i, Unit& u) const { const int R = T.start[16]; const long L = (long)i * G + c; if (L >= (long)R * 22) return false;
        const int r = (int)(L % R), pn = (int)(L / R), e = moe_group_of(T, r) & 7; u.pm = r; u.pn = pn; u.ta = r; u.tb = e * 22 + pn; return true; } };
struct MoeDownOrder { MoeTab T; int G, c, rank;
    __device__ __forceinline__ bool next(int i, Unit& u) const { const int r0 = T.start[rank * 8], nr = T.start[rank * 8 + 8] - r0; const long L = (long)i * G + c; if (L >= (long)nr * 4) return false;
        const int r = r0 + (int)(L % nr), pn = (int)(L / nr), e = moe_group_of(T, r) & 7; u.pm = r; u.pn = pn; u.ta = r; u.tb = e * 4 + pn; return true; } };
struct MergeOrder { int nM, G, c;
    __device__ __forceinline__ bool next(int i, Unit& u) const { const int ib = i / 3, br = i % 3; const long L = (long)ib * G + c; if (L >= (long)nM * 4) return false;
        int pm, pn; pg8::tile_of((int)L, nM, 4, pm, pn); u.pm = pm; u.pn = br * 4 + pn; u.ta = br * nM + pm; u.tb = br * 4 + pn; return true; } };

__device__ __forceinline__ void phase_route(Frame& F, const float* H, const float* gffn, const float* router, int* tok_e, float* tok_w, float* tok_rstd, int* rowtok, unsigned* cnt, int Ts) {
    F.retid();
    const int gt = F.bid * NTHR + F.tid, NGT = F.G * NTHR;
    for (int i = gt; i < 2 * Ts + 4096; i += NGT) rowtok[i] = -1;
    volatile LAS unsigned* lc = F.lctl + 16;
    if (F.tid < 16) lc[F.tid] = 0u;
    __syncthreads();
    const int lo = (int)((long)Ts * F.bid / F.G), hi = (int)((long)Ts * (F.bid + 1) / F.G);
    for (int tok = lo + F.wave; tok < hi; tok += NWAVES) {
        const f32x4* hr = (const f32x4*)(H + (size_t)tok * D) + F.lane; f32x4 v[4]; float ss = 0.f;
#pragma unroll
        for (int j = 0; j < 4; ++j) { v[j] = hr[64 * j]; ss += (v[j][0] * v[j][0] + v[j][1] * v[j][1]) + (v[j][2] * v[j][2] + v[j][3] * v[j][3]); }
        const float rs = rsqrtf(wave_sum(ss) * (1.f / D) + EPS);
        float lgt[8];
#pragma unroll
        for (int e = 0; e < 8; ++e) lgt[e] = 0.f;
#pragma unroll
        for (int j = 0; j < 4; ++j)
#pragma unroll
            for (int q = 0; q < 4; ++q) { const int k = 256 * j + 4 * F.lane + q; const float x = v[j][q] * rs * gffn[k]; const f32x4 r0 = *(const f32x4*)(router + (size_t)k * 8), r1 = *(const f32x4*)(router + (size_t)k * 8 + 4);
                lgt[0] += x * r0[0]; lgt[1] += x * r0[1]; lgt[2] += x * r0[2]; lgt[3] += x * r0[3]; lgt[4] += x * r1[0]; lgt[5] += x * r1[1]; lgt[6] += x * r1[2]; lgt[7] += x * r1[3]; }
#pragma unroll
        for (int e = 0; e < 8; ++e) lgt[e] = wave_sum(lgt[e]);
        int e0 = 0; float l0 = lgt[0];
#pragma unroll
        for (int e = 1; e < 8; ++e) if (lgt[e] > l0) { l0 = lgt[e]; e0 = e; }
        int e1 = -1; float l1 = -INFINITY;
#pragma unroll
        for (int e = 0; e < 8; ++e) if (e != e0 && lgt[e] > l1) { l1 = lgt[e]; e1 = e; }
        const float wa = 1.f / (1.f + __expf(l1 - l0));
        if (F.lane == 0) { tok_e[tok * 2] = e0; tok_e[tok * 2 + 1] = e1; tok_w[tok * 2] = wa; tok_w[tok * 2 + 1] = 1.f - wa; tok_rstd[tok] = rs;
            __hip_atomic_fetch_add((LAS unsigned*)(lc + e0), 1u, __ATOMIC_RELAXED, __HIP_MEMORY_SCOPE_WORKGROUP); __hip_atomic_fetch_add((LAS unsigned*)(lc + 8 + e1), 1u, __ATOMIC_RELAXED, __HIP_MEMORY_SCOPE_WORKGROUP); }
    }
    __syncthreads();
    if (F.tid < 16) { const unsigned n = lc[F.tid]; if (n) atomicAdd(cnt + F.tid, n); }
    __syncthreads();
}
__device__ __forceinline__ void phase_scatter(Frame& F, const bf16_t* HB, bf16_t* VP, const int* tok_e, const float* tok_w, const float* tok_rstd, int* rowtok, float* roww, float* rowrstd, unsigned* cnt, int Ts) {
    F.retid();
    MoeTab T; moe_tab(T, cnt);
    volatile LAS unsigned* lc = F.lctl + 16; volatile LAS unsigned* lb = F.lctl + 32;
    int* posl = (int*)F.lds;
    if (F.tid < 16) lc[F.tid] = 0u;
    __syncthreads();
    const int lo = (int)((long)Ts * F.bid / F.G), hi = (int)((long)Ts * (F.bid + 1) / F.G), n = hi - lo;
    int e0 = 0, e1 = 0, li0 = 0, li1 = 0;
    if (F.tid < n) { const int tok = lo + F.tid; e0 = tok_e[tok * 2]; e1 = tok_e[tok * 2 + 1];
        li0 = (int)__hip_atomic_fetch_add((LAS unsigned*)(lc + e0), 1u, __ATOMIC_RELAXED, __HIP_MEMORY_SCOPE_WORKGROUP); li1 = (int)__hip_atomic_fetch_add((LAS unsigned*)(lc + 8 + e1), 1u, __ATOMIC_RELAXED, __HIP_MEMORY_SCOPE_WORKGROUP); }
    __syncthreads();
    if (F.tid < 16) { const unsigned c = lc[F.tid]; int st = 0;
#pragma unroll
        for (int g = 0; g < 16; ++g) st = (F.tid == g) ? T.start[g] : st;
        lb[F.tid] = (unsigned)st * 256u + (c ? atomicAdd(cnt + 64 + F.tid, c) : 0u); }
    __syncthreads();
    if (F.tid < n) { const int tok = lo + F.tid; const int p0 = (int)lb[e0] + li0, p1 = (int)lb[8 + e1] + li1; const float rs = tok_rstd[tok];
        rowtok[p0] = tok; roww[p0] = tok_w[tok * 2]; rowrstd[p0] = rs; rowtok[p1] = tok; roww[p1] = tok_w[tok * 2 + 1]; rowrstd[p1] = rs; posl[F.tid * 2] = p0; posl[F.tid * 2 + 1] = p1; }
    __syncthreads();
    for (int cidx = F.wave; cidx < 2 * n; cidx += NWAVES) { const int tok = lo + (cidx >> 1), pos = posl[cidx];
        const uint4* src = (const uint4*)(HB + (size_t)tok * D) + F.lane * 2; uint4* dst = (uint4*)(VP + (size_t)pos * D) + F.lane * 2;
        const uint4 a = src[0], b = src[1]; dst[0] = a; dst[1] = b; }
    __syncthreads();
}

constexpr int NPHL = 13;
__host__ __device__ inline bool phase_active(int k, int l) {
    if (k == 0) return l == 0;
    if (k >= 8 && k <= 10) return (l & 1) == 1;
    if (k == 12) return l == DEPTH - 1;
    return true;
}
struct Args { const float* in[23]; float* out; unsigned char* ws; int ph_lo, ph_hi, single, Ts; };

typedef const __attribute__((address_space(4))) Args* KArgs;
struct Ctx { unsigned char* ws; float* out; int Ts, nM; ActMap M; KArgs ap;
    __device__ __forceinline__ const float* in(int i) const { return ap->in[i]; } };
#define CTX() Ctx C; { KArgs ap_ = (KArgs)__builtin_amdgcn_kernarg_segment_ptr(); asm volatile("" : "+s"(ap_)); C.ap = ap_; C.ws = ap_->ws; C.out = ap_->out; C.Ts = ap_->Ts; C.nM = C.Ts / 256; C.M.init((size_t)C.Ts); }
#define WSP(T, off) ((T*)(C.ws + (off)))

__global__ void __launch_bounds__(NTHR, 2) fwd(Args a) {
    extern __shared__ __attribute__((aligned(16))) unsigned char lds_raw[];
    Frame F;
    F.lds = lds_raw; F.lds3 = (LAS unsigned char*)lds_raw; F.lctl = (volatile LAS unsigned*)(F.lds3 + LDSCTL_OFF);
    F.tid = threadIdx.x; F.lane = F.tid & 63; F.wave = __builtin_amdgcn_readfirstlane(F.tid >> 6); F.wave0 = F.wave; F.G = gridDim.x; F.bid = blockIdx.x;
    F.ws = a.ws; F.ctl = (unsigned*)(a.ws + WS_CTL);
    for (int u = F.tid; u < (LDS_BYTES - LDSCTL_OFF) / 4; u += NTHR) F.lctl[u] = 0u;
    __syncthreads();
    XcdBarrier bar; bar.bar = F.ctl + CW_BAR; bar.x = 0; bar.st = nullptr;
    if (a.single) bar = xcd_barrier_post(F.ctl + CW_BAR, F.lctl);
    const int lo = a.ph_lo, hi = a.ph_hi, single = a.single;
#define RUN(p) (lo <= (p) && (p) < hi)
#define SEAM(p) do { if (single && (p) + 1 < hi) xcd_barrier(bar, F.wave0); } while (0)
    const int NSB = BATCH * SEQ / a.Ts;

    if (RUN(0)) { phase_prologue(F, a.in); SEAM(0); }

    for (int sb = 0; sb < NSB; ++sb) {
        for (int l = 0; l < DEPTH; ++l) {
            const int pbase = 1 + (sb * DEPTH + l) * NPHL; const int sl = sb * DEPTH + l;
            if (pbase + NPHL <= lo || pbase >= hi) continue;
#define HPTR (C.out + (size_t)sb * C.Ts * D)
            if (l == 0 && RUN(pbase + 0)) { CTX(); phase_init(F, C.in(0) + (size_t)sb * C.Ts * D, HPTR, WSP(bf16_t, C.M.mg), WSP(float, C.M.ssq1), C.Ts); SEAM(pbase + 0); }
            if (RUN(pbase + 1)) { CTX();
                pg8::Gemm g{WSP(bf16_t, C.M.mg), WSP(const bf16_t, WS_WIN + l * SZ_WIN), D}; pg8::PlainOrder S{C.nM, ZP / 256, F.G, F.bid}; EpiZ E{WSP(bf16_t, C.M.z), WSP(float, C.M.ssq1)};
                pg8::gemm_phase(F.lds3, g, S, E, F.wave0); SEAM(pbase + 1); }
            if (RUN(pbase + 2)) { CTX(); phase_prep(F, WSP(bf16_t, C.M.z), WSP(bf16_t, C.M.kv), WSP(float, WS_WKV + l * SZ_WKV), C.in(1) + ((size_t)l * BATCH * SEQ + (size_t)sb * C.Ts) * PLE, WSP(bf16_t, C.M.pb), C.Ts); SEAM(pbase + 2); }
            if (RUN(pbase + 3)) { CTX(); phase_mixers(F, WSP(bf16_t, C.M.z), WSP(bf16_t, C.M.kv), WSP(bf16_t, C.M.mix), WSP(float, WS_LB) + l * 512, C.in(5) + l * 128, WSP(unsigned, WS_CTL) + CW_WQ + 64 * sl, C.Ts); SEAM(pbase + 3); }
            if (RUN(pbase + 4)) { CTX();
                pg8::Gemm g{WSP(bf16_t, C.M.mix), WSP(const bf16_t, WS_WBR + l * SZ_WBR), 512}; MergeOrder S{C.nM, F.G, F.bid}; EpiMerge E{WSP(bf16_t, C.M.mg), WSP(bf16_t, C.M.z)};
                pg8::gemm_phase(F.lds3, g, S, E, F.wave0); SEAM(pbase + 4); }
            if (RUN(pbase + 5)) { CTX();
                pg8::Gemm g{WSP(bf16_t, C.M.mg), WSP(const bf16_t, WS_WOUT + l * SZ_WOUT), D}; pg8::PlainOrder S{C.nM, 4, F.G, F.bid}; EpiRes E{HPTR, WSP(bf16_t, C.M.hb), WSP(float, C.M.ssq)};
                pg8::gemm_phase(F.lds3, g, S, E, F.wave0); SEAM(pbase + 5); }
            if ((l & 1) == 0) {
                if (RUN(pbase + 6)) { CTX();
                    pg8::Gemm g{WSP(bf16_t, C.M.hb), WSP(const bf16_t, WS_WDGU + (l >> 1) * SZ_WGU), D}; pg8::PlainOrder S{C.nM, 22, F.G, F.bid}; EpiGU E{WSP(bf16_t, C.M.z), WSP(float, C.M.ssq), nullptr};
                    pg8::gemm_phase(F.lds3, g, S, E, F.wave0); SEAM(pbase + 6); }
                if (RUN(pbase + 7)) { CTX();
                    pg8::Gemm g{WSP(bf16_t, C.M.z), WSP(const bf16_t, WS_WDD + (l >> 1) * SZ_WD), DFF}; pg8::PlainOrder S{C.nM, 4, F.G, F.bid}; EpiRes E{HPTR, WSP(bf16_t, C.M.hb), WSP(float, C.M.ssq)};
                    pg8::gemm_phase(F.lds3, g, S, E, F.wave0); SEAM(pbase + 7); }
            } else {
#define MCNT (WSP(unsigned, WS_CTL) + CW_MOE + 256 * sl)
                if (RUN(pbase + 6)) { CTX(); phase_route(F, HPTR, C.in(11) + l * D, C.in(15) + (size_t)(l >> 1) * D * NE, WSP(int, C.M.tok_e), WSP(float, C.M.tok_w), WSP(float, C.M.tok_rstd), WSP(int, C.M.rowtok), MCNT, C.Ts); SEAM(pbase + 6); }
                if (RUN(pbase + 7)) { CTX(); phase_scatter(F, WSP(bf16_t, C.M.hb), WSP(bf16_t, C.M.mix), WSP(int, C.M.tok_e), WSP(float, C.M.tok_w), WSP(float, C.M.tok_rstd), WSP(int, C.M.rowtok), WSP(float, C.M.roww), WSP(float, C.M.rowrstd), MCNT, C.Ts); SEAM(pbase + 7); }
                if (RUN(pbase + 8)) { CTX();
                    pg8::Gemm g{WSP(bf16_t, C.M.mix), WSP(const bf16_t, WS_WMGU + (size_t)(l >> 1) * 8 * SZ_WGU), D}; MoeGuOrder S; moe_tab(S.T, MCNT); S.G = F.G; S.c = F.bid; EpiGU E{WSP(bf16_t, C.M.z), nullptr, WSP(float, C.M.rowrstd)};
                    pg8::gemm_phase(F.lds3, g, S, E, F.wave0); SEAM(pbase + 8); }
                if (RUN(pbase + 9)) { CTX();
                    pg8::Gemm g{WSP(bf16_t, C.M.z), WSP(const bf16_t, WS_WMD + (size_t)(l >> 1) * 8 * SZ_WD), DFF}; MoeDownOrder S; moe_tab(S.T, MCNT); S.G = F.G; S.c = F.bid; S.rank = 0;
                    EpiMoeDown<0> E{HPTR, WSP(bf16_t, C.M.hb), WSP(float, C.M.ssq), WSP(int, C.M.rowtok), WSP(float, C.M.roww)};
                    pg8::gemm_phase(F.lds3, g, S, E, F.wave0); SEAM(pbase + 9); }
                if (RUN(pbase + 10)) { CTX();
                    pg8::Gemm g{WSP(bf16_t, C.M.z), WSP(const bf16_t, WS_WMD + (size_t)(l >> 1) * 8 * SZ_WD), DFF}; MoeDownOrder S; moe_tab(S.T, MCNT); S.G = F.G; S.c = F.bid; S.rank = 1;
                    EpiMoeDown<1> E{HPTR, WSP(bf16_t, C.M.hb), WSP(float, C.M.ssq), WSP(int, C.M.rowtok), WSP(float, C.M.roww)};
                    pg8::gemm_phase(F.lds3, g, S, E, F.wave0); SEAM(pbase + 10); }
            }
            if (RUN(pbase + 11)) {
                { CTX(); pg8::Gemm g{WSP(bf16_t, C.M.pb), WSP(const bf16_t, WS_WPP + l * SZ_WPP), PLE}; pg8::PlainOrder S{C.nM, 4, F.G, F.bid}; EpiBf E{WSP(bf16_t, C.M.mix)}; pg8::gemm_phase(F.lds3, g, S, E, F.wave0); }
                { CTX(); pg8::Gemm g{WSP(bf16_t, C.M.hb), WSP(const bf16_t, WS_WPG + l * SZ_WOUT), D}; pg8::PlainOrder S{C.nM, 4, F.G, F.bid};
                  EpiPle E{HPTR, WSP(bf16_t, C.M.mg), WSP(float, C.M.ssq1), WSP(float, C.M.ssq), WSP(bf16_t, C.M.mix)}; pg8::gemm_phase(F.lds3, g, S, E, F.wave0); }
                SEAM(pbase + 11); }
            if (l == DEPTH - 1 && RUN(pbase + 12)) { CTX(); phase_final(F, HPTR, C.in(22), C.Ts); SEAM(pbase + 12); }
        }
    }
#undef RUN
#undef SEAM
}

#ifndef MK_SINGLE
#define MK_SINGLE 0
#endif
extern "C" void kernel_launch(void* const* d_in, const int* in_sizes, int n_in, void* d_out, int out_size, void* d_ws, size_t ws_size, hipStream_t stream) {
    static int grid = 0, Ts = 0;
    if (grid == 0) {
        int dev = 0, cus = 0;
        if (hipGetDevice(&dev) != hipSuccess || hipDeviceGetAttribute(&cus, hipDeviceAttributeMultiprocessorCount, dev) != hipSuccess) { fprintf(stderr, "kernel_launch: device query failed\n"); grid = -1; return; }
        if (hipFuncSetAttribute((const void*)fwd, hipFuncAttributeMaxDynamicSharedMemorySize, LDS_BYTES) != hipSuccess) { fprintf(stderr, "kernel_launch: hipFuncSetAttribute failed\n"); grid = -1; return; }
        int per_cu = 0; (void)hipOccupancyMaxActiveBlocksPerMultiprocessor(&per_cu, (const void*)fwd, NTHR, LDS_BYTES); (void)hipGetLastError();
        const int nbs[3] = {16, 8, 4};
        for (int i = 0; i < 3 && !Ts; ++i) { ActMap M; M.init((size_t)nbs[i] * SEQ); if (M.end <= ws_size) Ts = nbs[i] * SEQ; }
        if (!Ts || n_in != 23 || per_cu < 1) { fprintf(stderr, "kernel_launch: unsupported (ws %zu, n_in %d, occupancy %d)\n", ws_size, n_in, per_cu); grid = -1; return; }
        grid = cus;
    }
    if (grid < 0) return;
    (void)hipMemsetAsync((char*)d_ws + WS_CTL, 0, CTL_BYTES, stream);
    Args a{};
    for (int i = 0; i < 23; ++i) a.in[i] = (const float*)d_in[i];
    a.out = (float*)d_out; a.ws = (unsigned char*)d_ws; a.Ts = Ts;
    const int NSB = BATCH * SEQ / Ts, NPH = 1 + NSB * DEPTH * NPHL;
#if MK_SINGLE
    a.ph_lo = 0; a.ph_hi = NPH; a.single = 1;
    hipLaunchKernelGGL(fwd, dim3(grid), dim3(NTHR), LDS_BYTES, stream, a);
#else
    a.single = 0;
    for (int ph = 0; ph < NPH; ++ph) {
        if (ph > 0) { const int r = (ph - 1) % (DEPTH * NPHL); if (!phase_active(r % NPHL, r / NPHL)) continue; }
        a.ph_lo = ph; a.ph_hi = ph + 1;
        hipLaunchKernelGGL(fwd, dim3(grid), dim3(NTHR), LDS_BYTES, stream, a);
    }
#endif
}
```

```cpp
#include <hip/hip_runtime.h>
#include <cstdio>
#include <cstdint>

#define LAS __attribute__((address_space(3)))
#define GAS __attribute__((address_space(1)))
typedef unsigned short bf16_t;
typedef short bf16x8 __attribute__((ext_vector_type(8)));
typedef float f32x4 __attribute__((ext_vector_type(4)));
typedef unsigned u32x4 __attribute__((ext_vector_type(4)));
typedef unsigned u32x2 __attribute__((ext_vector_type(2)));

constexpr int D = 1024, SEQ = 2048, BATCH = 32, DEPTH = 4;
constexpr int ZW = 7680, ZP = 4608;
constexpr int C_HQ = 0, C_HF = 512, C_HI = 1024, C_HG = 1536, C_SQ = 2048, C_SC = 2560, C_IQ = 2688, C_IK = 2944, C_BQ = 3008, C_BK = 3520, C_BV = 4032, C_IW = 4544, C_GZ = 4608;
constexpr int GZ_PN0 = C_GZ / 256;
constexpr int IN_W = 7620, DFF = 2816, NE = 8, PLE = 256;
constexpr float EPS = 1e-6f;
constexpr int NWAVES = 8, NTHR = 512;

constexpr size_t MiB = 1u << 20;
constexpr size_t WS_CTL = 0, CTL_BYTES = 1 * MiB;
constexpr int CW_BAR = 4096;
constexpr int CW_WQ = 8192;
constexpr int CW_MOE = 16384;
constexpr size_t SZ_WIN = (size_t)ZW * D * 2, SZ_WBR = (size_t)3 * D * 512 * 2, SZ_WOUT = (size_t)D * D * 2, SZ_WGU = (size_t)2 * DFF * D * 2, SZ_WD = (size_t)D * DFF * 2,
                 SZ_WPP = (size_t)D * PLE * 2, SZ_WKV = (size_t)128 * 128 * 2;
constexpr size_t WS_WIN = 1 * MiB;
constexpr size_t WS_WBR = WS_WIN + 4 * SZ_WIN;
constexpr size_t WS_WOUT = WS_WBR + 4 * SZ_WBR;
constexpr size_t WS_WDGU = WS_WOUT + 4 * SZ_WOUT;
constexpr size_t WS_WDD = WS_WDGU + 2 * SZ_WGU;
constexpr size_t WS_WMGU = WS_WDD + 2 * SZ_WD;
constexpr size_t WS_WMD = WS_WMGU + 16 * SZ_WGU;
constexpr size_t WS_WPG = WS_WMD + 16 * SZ_WD;
constexpr size_t WS_WPP = WS_WPG + 4 * SZ_WOUT;
constexpr size_t WS_WKV = WS_WPP + 4 * SZ_WPP;
constexpr size_t WS_LB = WS_WKV + 4 * SZ_WKV;
constexpr size_t WS_ACT = ((WS_LB + 4 * 512 * 4 + 4095) / 4096) * 4096;
struct ActMap {
    size_t hb, hbn, ssq, ssq1, z, kv, mix, mg, pb, tok_e, tok_w, tok_rstd, rowtok, roww, rowrstd, end;
    __host__ __device__ void init(size_t Ts) {
        size_t o = WS_ACT;
        hb = o; o += Ts * D * 2;
        hbn = o; o += Ts * D * 2;
        ssq = o; o += Ts * 16 * 4;
        ssq1 = o; o += Ts * 16 * 4;
        z = o; o += Ts * ZW * 2;
        kv = o; o += Ts * (128 + 64) * 2;
        mix = o; o += 3 * Ts * 512 * 2;
        mg = o; o += Ts * D * 2;
        pb = o; o += Ts * PLE * 2;
        tok_e = o; o += Ts * 2 * 4;
        tok_w = o; o += Ts * 2 * 4;
        tok_rstd = o; o += Ts * 4;
        rowtok = o; o += (2 * Ts + 4096) * 4;
        roww = o; o += (2 * Ts + 4096) * 4;
        rowrstd = o; o += (2 * Ts + 4096) * 4;
        end = o;
    }
};

__device__ __forceinline__ int lane_id() { return (int)__builtin_amdgcn_mbcnt_hi(~0u, __builtin_amdgcn_mbcnt_lo(~0u, 0u)); }
__device__ __forceinline__ unsigned f2bf(float f) { unsigned u = __builtin_bit_cast(unsigned, f); return (u + 0x7fffu + ((u >> 16) & 1u)) >> 16; }
__device__ __forceinline__ unsigned pk2(float lo, float hi) { return f2bf(lo) | (f2bf(hi) << 16); }
__device__ __forceinline__ float bflo(unsigned u) { return __builtin_bit_cast(float, u << 16); }
__device__ __forceinline__ float bfhi(unsigned u) { return __builtin_bit_cast(float, u & 0xffff0000u); }
__device__ __forceinline__ float bf2f(bf16_t b) { return __builtin_bit_cast(float, ((unsigned)b) << 16); }
__device__ __forceinline__ float wave_sum(float v) {
    v += __builtin_bit_cast(float, __builtin_amdgcn_update_dpp(0, __builtin_bit_cast(int, v), 0xB1, 0xf, 0xf, true));
    v += __builtin_bit_cast(float, __builtin_amdgcn_update_dpp(0, __builtin_bit_cast(int, v), 0x4E, 0xf, 0xf, true));
    v += __builtin_bit_cast(float, __builtin_amdgcn_update_dpp(0, __builtin_bit_cast(int, v), 0x141, 0xf, 0xf, true));
    v += __builtin_bit_cast(float, __builtin_amdgcn_update_dpp(0, __builtin_bit_cast(int, v), 0x140, 0xf, 0xf, true));
    const int iv = __builtin_bit_cast(int, v);
    const float r0 = __builtin_bit_cast(float, __builtin_amdgcn_readlane(iv, 0)), r1 = __builtin_bit_cast(float, __builtin_amdgcn_readlane(iv, 16));
    const float r2 = __builtin_bit_cast(float, __builtin_amdgcn_readlane(iv, 32)), r3 = __builtin_bit_cast(float, __builtin_amdgcn_readlane(iv, 48));
    return (r0 + r1) + (r2 + r3);
}
__device__ __forceinline__ float wave_max(float v) {
    int l = lane_id(); asm volatile("" : "+v"(l));
#pragma unroll
    for (int o = 1; o < 64; o <<= 1) v = fmaxf(v, __builtin_bit_cast(float, __builtin_amdgcn_ds_bpermute((l ^ o) << 2, __builtin_bit_cast(int, v))));
    return v;
}
__device__ __forceinline__ float sigmoidf_(float x) { return __builtin_amdgcn_rcpf(1.f + __expf(-x)); }
__device__ __forceinline__ float siluf_(float x) { return x * __builtin_amdgcn_rcpf(1.f + __expf(-x)); }
__device__ __forceinline__ void unpack8(const uint4 u, float* f) {
    f[0] = bflo(u.x); f[1] = bfhi(u.x); f[2] = bflo(u.y); f[3] = bfhi(u.y); f[4] = bflo(u.z); f[5] = bfhi(u.z); f[6] = bflo(u.w); f[7] = bfhi(u.w);
}

namespace pg8 {
constexpr int BM = 256, BK = 64, HALF = 128, HTB = HALF * BK * 2, STAGE_BYTES = 8 * HTB, NXCD = 8, WGM = 4;
__host__ __device__ __forceinline__ int lds_byte(int r, int c) { const int st = (r >> 4) * 2 + (c >> 5), rr = r & 15, cc = c & 31, ob = rr * 64 + cc * 2; return st * 1024 + (ob ^ (((ob >> 9) & 1) << 5)); }
__host__ __device__ __forceinline__ void stage_rc(int b, int& R, int& C) { const int st = b / 1024, sb = b % 1024, swz = sb ^ (((sb >> 9) & 1) << 5); R = (st >> 1) * 16 + swz / 64; C = (st & 1) * 32 + (swz % 64) / 2; }
__host__ __device__ __forceinline__ int perm32(int rho) { const int n = rho >> 4, i = rho & 15; return 8 * (i >> 2) + 4 * n + (i & 3); }

struct Unit { int pm, pn, ta, tb; };
struct Gemm { const bf16_t* A; const bf16_t* Bt; int K; };

__device__ __forceinline__ void tile_of(int L, int nM, int nN, int& pm, int& pn, int wgm = WGM) {
    const int nwg = nM * nN; int wgid = L;
    { const int q = nwg / NXCD, r = nwg % NXCD, xcd = wgid % NXCD, off = wgid / NXCD; wgid = (xcd < r ? xcd * (q + 1) : r * (q + 1) + (xcd - r) * q) + off; }
    const int nig = wgm * nN, gid = wgid / nig, fm = gid * wgm, gsz = (nM - fm) < wgm ? (nM - fm) : wgm;
    pm = fm + ((wgid % nig) % gsz); pn = (wgid % nig) / gsz;
}
struct PlainOrder {
    int nM, nN, G, c, wgm = WGM;
    __device__ __forceinline__ bool next(int i, Unit& u) const {
        const long L = (long)i * G + c; if (L >= (long)nM * nN) return false;
        tile_of((int)L, nM, nN, u.pm, u.pn, wgm); u.ta = u.pm; u.tb = u.pn; return true;
    }
};

typedef float f32x2_cv __attribute__((ext_vector_type(2))); typedef __bf16 bf16x2_cv __attribute__((ext_vector_type(2)));
__device__ __forceinline__ unsigned cvt_pk_bf16(float lo, float hi) { const f32x2_cv v = {lo, hi}; const bf16x2_cv b = __builtin_convertvector(v, bf16x2_cv); return __builtin_bit_cast(unsigned, b); }

template <class Epi, class Sched, bool ALIGN_EPI = true, bool SP2 = true, bool GATHER = false>
__device__ __forceinline__ void gemm_phase(LAS unsigned char* lds, const Gemm g, const Sched& S, const Epi& E, int wave_) {
    int tid_ = wave_ * 64 + lane_id(); asm volatile("" : "+v"(tid_));
    const int tid = tid_, wid = __builtin_amdgcn_readfirstlane(tid >> 6), lane = tid & 63, wr = wid >> 2, wc = wid & 3, fr = lane & 15, fq = lane >> 4;
    int K_ = g.K; asm volatile("" : "+s"(K_));
    const int K = K_, nt = K / BK;
    unsigned voffA[2], voffB[2];
#pragma unroll
    for (int i = 0; i < 2; ++i) { int R, C; stage_rc(tid * 16 + i * 8192, R, C); const int Rb = Epi::PERM ? ((R & ~31) + perm32(R & 31)) : R;
        voffA[i] = (unsigned)(R * K + C) * 2u; voffB[i] = (unsigned)(Rb * K + C) * 2u; }
    const size_t kstep = (size_t)(BK * 2);
    const size_t hstep = (size_t)HALF * K * 2;
    const size_t tstep = 2 * hstep;
    const unsigned ldsw = (unsigned)wid * 1024u;
    const int aoff = lds_byte(wr * 64 + fr, fq * 8), boff = lds_byte(wc * 32 + fr, fq * 8);
#define PG8_SA(b, h) (((b) * 2 + (h)) * HTB)
#define PG8_SB(b, h) ((4 + (b) * 2 + (h)) * HTB)
#define PG8_STAGE(bufoff, gbase, voff) do { _Pragma("unroll") for (int _i = 0; _i < 2; ++_i) \
        __builtin_amdgcn_global_load_lds((const unsigned*)((const char*)(gbase) + (voff)[_i]), (LAS unsigned*)(lds + (bufoff) + ldsw + _i * 8192), 16, 0, 0); } while (0)
#define PG8_LDA(dst, b, h) do { _Pragma("unroll") for (int m = 0; m < 4; ++m) _Pragma("unroll") for (int k = 0; k < 2; ++k) dst[m][k] = *(const LAS bf16x8*)(lds + PG8_SA(b, h) + aoff + m * 2048 + k * 1024); } while (0)
#define PG8_LDB(dst, b, h) do { _Pragma("unroll") for (int n = 0; n < 2; ++n) _Pragma("unroll") for (int k = 0; k < 2; ++k) dst[n][k] = *(const LAS bf16x8*)(lds + PG8_SB(b, h) + boff + n * 2048 + k * 1024); } while (0)
#define PG8_MMA(ai, bj, At, Bt) do { __builtin_amdgcn_s_setprio(1); _Pragma("unroll") for (int m = 0; m < 4; ++m) _Pragma("unroll") for (int n = 0; n < 2; ++n) _Pragma("unroll") for (int k = 0; k < 2; ++k) \
        acc[ai][bj][m][n] = __builtin_amdgcn_mfma_f32_16x16x32_bf16(Bt[n][k], At[m][k], acc[ai][bj][m][n], 0, 0, 0); __builtin_amdgcn_s_setprio(0); } while (0)
#define PG8_WAIT_V(n) asm volatile("s_waitcnt vmcnt(" #n ")" ::: "memory")
#define PG8_WAIT_L(n) asm volatile("s_waitcnt lgkmcnt(" #n ")" ::: "memory")
#define PG8_BAR __builtin_amdgcn_s_barrier()
#define PG8_SCHED __builtin_amdgcn_sched_barrier(0)
    static_assert(!GATHER || SP2, "row-gathered A staging is written for the two-super-phase loop");
    unsigned gc[2][2], gn[2][2];
#define PG8_GOFF(dst, U) do { if constexpr (GATHER) { _Pragma("unroll") for (int _h = 0; _h < 2; ++_h) _Pragma("unroll") for (int _i = 0; _i < 2; ++_i) { int R_, C_; stage_rc(tid * 16 + _i * 8192, R_, C_); \
        int rw_ = S.rowmap((U).ta * 256 + _h * 128 + R_); rw_ = rw_ < 0 ? 0 : rw_; dst[_h][_i] = (unsigned)(rw_ * K + C_) * 2u; } } } while (0)
#define PG8_STAGE_A(bufoff, gbase, half, usenext) do { if constexpr (GATHER) { unsigned vt_[2]; vt_[0] = (usenext) ? gn[half][0] : gc[half][0]; vt_[1] = (usenext) ? gn[half][1] : gc[half][1]; PG8_STAGE(bufoff, gbase, vt_); } \
        else { PG8_STAGE(bufoff, (gbase) + (half) * hstep, voffA); } } while (0)
    Unit cur, nxt; int ui = 0;
    if (!S.next(0, cur)) return;
    PG8_GOFF(gc, cur);
    f32x4 acc[2][2][4][2];
#pragma unroll
    for (int a = 0; a < 2; ++a)
#pragma unroll
        for (int b = 0; b < 2; ++b)
#pragma unroll
            for (int m = 0; m < 4; ++m)
#pragma unroll
                for (int n = 0; n < 2; ++n) acc[a][b][m][n] = (f32x4){0.f, 0.f, 0.f, 0.f};
    bf16x8 At[4][2], B0[2][2], B1[2][2];
    const char* cA = (const char*)g.A + (GATHER ? (size_t)0 : (size_t)cur.ta * tstep); const char* cB = (const char*)g.Bt + (size_t)cur.tb * tstep;
    if constexpr (SP2) {
        PG8_STAGE(PG8_SB(0, 0), cB, voffB); PG8_STAGE(PG8_SB(0, 1), cB + hstep, voffB); PG8_STAGE_A(PG8_SA(0, 0), cA, 0, false); PG8_STAGE_A(PG8_SA(0, 1), cA, 1, false);
        if (wr == 1) PG8_BAR;
        PG8_WAIT_V(2); PG8_BAR;
        PG8_STAGE(PG8_SB(1, 0), cB + kstep, voffB); PG8_STAGE_A(PG8_SA(1, 0), cA + kstep, 0, false); PG8_STAGE(PG8_SB(1, 1), cB + hstep + kstep, voffB);
        PG8_WAIT_V(6); PG8_BAR;
    } else {
        PG8_STAGE(PG8_SB(0, 0), cB, voffB); PG8_STAGE(PG8_SA(0, 0), cA, voffA); PG8_STAGE(PG8_SB(0, 1), cB + hstep, voffB); PG8_STAGE(PG8_SA(0, 1), cA + hstep, voffA);
        if (wr == 1) PG8_BAR;
        PG8_WAIT_V(4); PG8_BAR;
        PG8_STAGE(PG8_SB(1, 0), cB + kstep, voffB); PG8_STAGE(PG8_SA(1, 0), cA + kstep, voffA); PG8_STAGE(PG8_SB(1, 1), cB + hstep + kstep, voffB);
        PG8_WAIT_V(6); PG8_BAR;
    }
    for (;;) {
        const bool has_next = S.next(ui + 1, nxt);
        const char* nA = (has_next && !GATHER) ? (const char*)g.A + (size_t)nxt.ta * tstep : cA; const char* nB = has_next ? (const char*)g.Bt + (size_t)nxt.tb * tstep : cB;
        if (has_next) PG8_GOFF(gn, nxt);
        for (int t = 0; t < nt; t += 2) {
            const bool last = (t == nt - 2);
            const char* a1 = cA + (size_t)(t + 1) * kstep;
            const char* a2 = last ? nA : cA + (size_t)(t + 2) * kstep; const char* b2 = last ? nB : cB + (size_t)(t + 2) * kstep;
            const char* a3 = a2 + kstep; const char* b3 = b2 + kstep;
            if constexpr (SP2) {
            const bool un_ = last && has_next;
            PG8_LDB(B0, 0, 0); PG8_LDB(B1, 0, 1); PG8_SCHED; PG8_LDA(At, 0, 0); PG8_STAGE_A(PG8_SA(1, 1), a1, 1, false);
            PG8_WAIT_V(8); PG8_WAIT_L(0); PG8_BAR; PG8_MMA(0, 0, At, B0); PG8_MMA(0, 1, At, B1); PG8_BAR; PG8_SCHED;
            PG8_LDA(At, 0, 1); PG8_STAGE(PG8_SB(0, 0), b2, voffB); PG8_STAGE(PG8_SB(0, 1), b2 + hstep, voffB); PG8_STAGE_A(PG8_SA(0, 0), a2, 0, un_);
            PG8_WAIT_V(8); PG8_WAIT_L(0); PG8_BAR; PG8_MMA(1, 0, At, B0); PG8_MMA(1, 1, At, B1); PG8_BAR; PG8_SCHED;
            PG8_LDB(B0, 1, 0); PG8_LDB(B1, 1, 1); PG8_SCHED; PG8_LDA(At, 1, 0); PG8_STAGE_A(PG8_SA(0, 1), a2, 1, un_);
            PG8_WAIT_V(8); PG8_WAIT_L(0); PG8_BAR; PG8_MMA(0, 0, At, B0); PG8_MMA(0, 1, At, B1); PG8_BAR; PG8_SCHED;
            PG8_LDA(At, 1, 1); PG8_STAGE(PG8_SB(1, 0), b3, voffB); PG8_STAGE(PG8_SB(1, 1), b3 + hstep, voffB); PG8_STAGE_A(PG8_SA(1, 0), a3, 0, un_);
            PG8_WAIT_V(8); PG8_WAIT_L(0); PG8_BAR; PG8_MMA(1, 0, At, B0); PG8_MMA(1, 1, At, B1); PG8_BAR; PG8_SCHED;
            } else {
            PG8_LDB(B0, 0, 0); PG8_SCHED; PG8_LDA(At, 0, 0); PG8_STAGE(PG8_SA(1, 1), a1 + hstep, voffA);
            PG8_WAIT_L(8); PG8_BAR; PG8_WAIT_L(0); PG8_MMA(0, 0, At, B0); PG8_BAR; PG8_SCHED;
            PG8_LDB(B1, 0, 1); PG8_STAGE(PG8_SB(0, 0), b2, voffB);
            PG8_BAR; PG8_WAIT_L(0); PG8_MMA(0, 1, At, B1); PG8_BAR;
            PG8_LDA(At, 0, 1); PG8_STAGE(PG8_SA(0, 0), a2, voffA);
            PG8_BAR; PG8_WAIT_L(0); PG8_MMA(1, 0, At, B0); PG8_BAR; PG8_SCHED;
            PG8_STAGE(PG8_SB(0, 1), b2 + hstep, voffB);
            PG8_WAIT_V(6); PG8_BAR; PG8_MMA(1, 1, At, B1); PG8_BAR;
            PG8_LDB(B0, 1, 0); PG8_SCHED; PG8_LDA(At, 1, 0); PG8_STAGE(PG8_SA(0, 1), a2 + hstep, voffA);
            PG8_WAIT_L(8); PG8_BAR; PG8_WAIT_L(0); PG8_MMA(0, 0, At, B0); PG8_BAR; PG8_SCHED;
            PG8_LDB(B1, 1, 1); PG8_STAGE(PG8_SB(1, 0), b3, voffB);
            PG8_BAR; PG8_WAIT_L(0); PG8_MMA(0, 1, At, B1); PG8_BAR;
            PG8_LDA(At, 1, 1); PG8_STAGE(PG8_SA(1, 0), a3, voffA);
            PG8_BAR; PG8_WAIT_L(0); PG8_MMA(1, 0, At, B0); PG8_BAR; PG8_SCHED;
            PG8_STAGE(PG8_SB(1, 1), b3 + hstep, voffB);
            PG8_WAIT_V(6); PG8_BAR; PG8_MMA(1, 1, At, B1); PG8_BAR;
            }
        }
        if constexpr (ALIGN_EPI) { if (wr == 0) PG8_BAR; }
        E(acc, cur, wr, wc, fr, fq);
        if (!has_next) break;
#pragma unroll
        for (int a = 0; a < 2; ++a)
#pragma unroll
            for (int b = 0; b < 2; ++b)
#pragma unroll
                for (int m = 0; m < 4; ++m)
#pragma unroll
                    for (int n = 0; n < 2; ++n) acc[a][b][m][n] = (f32x4){0.f, 0.f, 0.f, 0.f};
        cur = nxt; cA = nA; cB = nB; ++ui;
        if constexpr (GATHER) { _Pragma("unroll") for (int _h = 0; _h < 2; ++_h) _Pragma("unroll") for (int _i = 0; _i < 2; ++_i) gc[_h][_i] = gn[_h][_i]; }
        if constexpr (ALIGN_EPI) { if (wr == 1) PG8_BAR; }
    }
    PG8_WAIT_V(0);
    if constexpr (!ALIGN_EPI) { if (wr == 0) PG8_BAR; }
    PG8_BAR;
#undef PG8_SA
#undef PG8_SB
#undef PG8_STAGE
#undef PG8_STAGE_A
#undef PG8_GOFF
#undef PG8_LDA
#undef PG8_LDB
#undef PG8_MMA
#undef PG8_WAIT_V
#undef PG8_WAIT_L
#undef PG8_BAR
#undef PG8_SCHED
}
}

struct LaneT { int r, c, to_acc; };
__device__ __forceinline__ LaneT lane_t() { const int l = lane_id(); LaneT t; t.r = l >> 2; t.c = l & 3; t.to_acc = ((l & 15) * 4 + (l >> 4)) * 4; return t; }
__device__ __forceinline__ u32x4 bperm4(const u32x4 v, int src) { u32x4 r;
    r.x = (unsigned)__builtin_amdgcn_ds_bpermute(src, (int)v.x); r.y = (unsigned)__builtin_amdgcn_ds_bpermute(src, (int)v.y);
    r.z = (unsigned)__builtin_amdgcn_ds_bpermute(src, (int)v.z); r.w = (unsigned)__builtin_amdgcn_ds_bpermute(src, (int)v.w); return r; }
using pg8::Unit; using pg8::cvt_pk_bf16;
__device__ __forceinline__ float rstd_from4(const f32x4 a) { return rsqrtf(((a[0] + a[1]) + (a[2] + a[3])) * (1.0f / 1024.0f) + EPS); }
constexpr int SSQ_TAB_OFF = 131072 + 9216;
__device__ __forceinline__ u32x4 pack8(const f32x4 v0, const f32x4 v1) { u32x4 w; w.x = cvt_pk_bf16(v0[0], v0[1]); w.y = cvt_pk_bf16(v0[2], v0[3]); w.z = cvt_pk_bf16(v1[0], v1[1]); w.w = cvt_pk_bf16(v1[2], v1[3]); return w; }
__device__ __forceinline__ void unpack8v(const u32x4 w, f32x4& v0, f32x4& v1) { v0 = (f32x4){bflo(w.x), bfhi(w.x), bflo(w.y), bfhi(w.y)}; v1 = (f32x4){bflo(w.z), bfhi(w.z), bflo(w.w), bfhi(w.w)}; }
__device__ __forceinline__ f32x4 sig4(const f32x4 x) { return (f32x4){sigmoidf_(x[0]), sigmoidf_(x[1]), sigmoidf_(x[2]), sigmoidf_(x[3])}; }


__device__ __forceinline__ void ssq_tile_reduce(const float (&ss)[2][4], float* ssq_out, const int* rowtok, int pm, int pn, int wr, int wc, int fr, int fq) {
    LAS float* tab = (LAS float*)(uintptr_t)SSQ_TAB_OFF;
    if (fq == 0) {
#pragma unroll
        for (int ai = 0; ai < 2; ++ai)
#pragma unroll
            for (int m = 0; m < 4; ++m) tab[(ai * 128 + wr * 64 + m * 16 + fr) * 4 + wc] = ss[ai][m]; }
    asm volatile("s_waitcnt lgkmcnt(0)" ::: "memory"); __builtin_amdgcn_s_barrier(); asm volatile("" ::: "memory");
    const int r = (wr * 4 + wc) * 64 + fq * 16 + fr;
    if (r < 256) { const f32x4 p = *(const LAS f32x4*)(tab + r * 4); const float t = (p[0] + p[1]) + (p[2] + p[3]);
        if (rowtok) { const int tok = rowtok[pm * 256 + r]; if (tok >= 0) ssq_out[(size_t)tok * 4 + pn] = t; }
        else ssq_out[(size_t)(pm * 256 + r) * 4 + pn] = t; }
}
struct EpiZ {
    static constexpr bool PERM = true;
    bf16_t* Z; const float* ssq; const float* lbl; bf16_t* GZT; bf16_t* IKT;
    __device__ __forceinline__ void operator()(const f32x4 (&acc)[2][2][4][2], const Unit& u, int wr, int wc, int fr, int fq) const {
        const int row0 = u.pm * 256 + wr * 64 + fr, col0 = u.pn * 256 + wc * 32 + 8 * fq;
        const int kind = (u.pn < 2 || u.pn == 6 || u.pn == 7) ? 1 : ((u.pn == 2 || u.pn == 3) ? 2 : 0);
        const bool tiled = u.pn >= GZ_PN0;
        bf16_t* tb = GZT + ((size_t)(u.pm * 12 + (u.pn - GZ_PN0)) << 16) + ((wr * 4 + wc) * 64 + fq * 16 + fr) * 8;
        f32x4 lbv[2][2];
        if (kind == 2) {
#pragma unroll
            for (int bj = 0; bj < 2; ++bj) { lbv[bj][0] = *(const f32x4*)(lbl + col0 - 512 + bj * 128); lbv[bj][1] = *(const f32x4*)(lbl + col0 - 512 + bj * 128 + 4); } }
        f32x4 part[2][4];
#pragma unroll
        for (int ai = 0; ai < 2; ++ai)
#pragma unroll
            for (int m = 0; m < 4; ++m) part[ai][m] = *(const f32x4*)(ssq + (size_t)(row0 + ai * 128 + m * 16) * 4);
#pragma unroll
        for (int ai = 0; ai < 2; ++ai)
#pragma unroll
            for (int m = 0; m < 4; ++m) { const int row = row0 + ai * 128 + m * 16; const float rs = rstd_from4(part[ai][m]); bf16_t* rowp = Z + (size_t)row * ZP + col0;
#pragma unroll
                for (int bj = 0; bj < 2; ++bj) { f32x4 v0 = acc[ai][bj][m][0] * rs, v1 = acc[ai][bj][m][1] * rs;
                    if (kind == 1) {
#pragma unroll
                        for (int j = 0; j < 4; ++j) { v0[j] = v0[j] * __builtin_amdgcn_rcpf(1.f + __expf(-v0[j])); v1[j] = v1[j] * __builtin_amdgcn_rcpf(1.f + __expf(-v1[j])); } }
                    else if (kind == 2) {
#pragma unroll
                        for (int j = 0; j < 4; ++j) { const float l0 = lbv[bj][0][j], l1 = lbv[bj][1][j];
                            v0[j] = __logf(l0 + (1.f - l0) * __builtin_amdgcn_rcpf(1.f + __expf(-v0[j]))); v1[j] = __logf(l1 + (1.f - l1) * __builtin_amdgcn_rcpf(1.f + __expf(-v1[j]))); } }
                    bf16_t* dst = tiled ? tb + ((ai * 4 + m) * 2 + bj) * 4096 : rowp + bj * 128;
                    if (u.pn == C_IK / 256 && bj == 1 && wc < 2) dst = IKT + ((size_t)((u.pm * 16 + ai * 8 + wr * 4 + m) * 2 + wc) * 64 + fq * 16 + fr) * 8;
                    *(u32x4*)dst = pack8(v0, v1); } }
    }
};
struct EpiRes {
    static constexpr bool PERM = true;
    const bf16_t* HIN; bf16_t* HOUT; float* ssq;
    __device__ __forceinline__ void operator()(const f32x4 (&acc)[2][2][4][2], const Unit& u, int wr, int wc, int fr, int fq) const {
        const int row0 = u.pm * 256 + wr * 64 + fr, col0 = u.pn * 256 + wc * 32 + 8 * fq;
        const LaneT LT = lane_t(); float ssv[2][4];
#pragma unroll
        for (int ai = 0; ai < 2; ++ai) {
            u32x4 hv[4][2];
#pragma unroll
            for (int m = 0; m < 4; ++m)
#pragma unroll
                for (int bj = 0; bj < 2; ++bj) hv[m][bj] = *(const u32x4*)(HIN + (size_t)(row0 - fr + LT.r + ai * 128 + m * 16) * D + (col0 - 8 * fq + 8 * LT.c) + bj * 128);
#pragma unroll
            for (int m = 0; m < 4; ++m) { const int row = row0 + ai * 128 + m * 16; bf16_t* bp = HOUT + (size_t)row * D + col0; float ss = 0.f;
#pragma unroll
                for (int bj = 0; bj < 2; ++bj) { f32x4 v0, v1; unpack8v(bperm4(hv[m][bj], LT.to_acc), v0, v1); v0 += acc[ai][bj][m][0]; v1 += acc[ai][bj][m][1];
                    *(u32x4*)(bp + bj * 128) = pack8(v0, v1);
                    ss += (v0[0] * v0[0] + v0[1] * v0[1]) + (v0[2] * v0[2] + v0[3] * v0[3]) + (v1[0] * v1[0] + v1[1] * v1[1]) + (v1[2] * v1[2] + v1[3] * v1[3]); }
                ss += __shfl_xor(ss, 16); ss += __shfl_xor(ss, 32); ssv[ai][m] = ss; } }
        ssq_tile_reduce(ssv, ssq, nullptr, u.pm, u.pn, wr, wc, fr, fq);
    }
};
struct EpiGU {
    static constexpr bool PERM = true;
    bf16_t* HM; const float* ssq; const float* rowrstd;
    __device__ __forceinline__ void operator()(const f32x4 (&acc)[2][2][4][2], const Unit& u, int wr, int wc, int fr, int fq) const {
        const int row0 = u.pm * 256 + wr * 64 + fr, col0 = u.pn * 128 + wc * 32 + 8 * fq;
        float rsv[2][4];
        if (rowrstd) {
#pragma unroll
            for (int ai = 0; ai < 2; ++ai)
#pragma unroll
                for (int m = 0; m < 4; ++m) rsv[ai][m] = rowrstd[row0 + ai * 128 + m * 16];
        } else { f32x4 part[2][4];
#pragma unroll
            for (int ai = 0; ai < 2; ++ai)
#pragma unroll
                for (int m = 0; m < 4; ++m) part[ai][m] = *(const f32x4*)(ssq + (size_t)(row0 + ai * 128 + m * 16) * 4);
#pragma unroll
            for (int ai = 0; ai < 2; ++ai)
#pragma unroll
                for (int m = 0; m < 4; ++m) rsv[ai][m] = rstd_from4(part[ai][m]); }
#pragma unroll
        for (int ai = 0; ai < 2; ++ai)
#pragma unroll
            for (int m = 0; m < 4; ++m) { const int row = row0 + ai * 128 + m * 16; const float rs = rsv[ai][m];
                f32x4 o0, o1;
#pragma unroll
                for (int j = 0; j < 4; ++j) { const float g0 = acc[ai][0][m][0][j] * rs, g1 = acc[ai][0][m][1][j] * rs; o0[j] = siluf_(g0) * (acc[ai][1][m][0][j] * rs); o1[j] = siluf_(g1) * (acc[ai][1][m][1][j] * rs); }
                *(u32x4*)(HM + (size_t)row * DFF + col0) = pack8(o0, o1); }
    }
};
struct EpiMerge {
    static constexpr bool PERM = true;
    bf16_t* MG; const bf16_t* GZT; bf16_t* PT;
    __device__ __forceinline__ void operator()(const f32x4 (&acc)[2][2][4][2], const Unit& u, int wr, int wc, int fr, int fq) const {
        const int br = u.pn >> 2, pn = u.pn & 3;
        const int row0 = u.pm * 256 + wr * 64 + fr, col0 = pn * 256 + wc * 32 + 8 * fq, lo = ((wr * 4 + wc) * 64 + fq * 16 + fr) * 8;
        const bf16_t* gt = GZT + ((size_t)(u.pm * 12 + u.pn) << 16) + lo; bf16_t* pt = PT + ((size_t)(u.pm * 4 + pn) << 16) + lo;
#pragma unroll
        for (int ai = 0; ai < 2; ++ai) {
            u32x4 gv[4][2], pv[4][2];
#pragma unroll
            for (int m = 0; m < 4; ++m)
#pragma unroll
                for (int bj = 0; bj < 2; ++bj) gv[m][bj] = *(const u32x4*)(gt + ((ai * 4 + m) * 2 + bj) * 4096);
            if (br > 0) {
#pragma unroll
                for (int m = 0; m < 4; ++m)
#pragma unroll
                    for (int bj = 0; bj < 2; ++bj) pv[m][bj] = *(const u32x4*)(pt + ((ai * 4 + m) * 2 + bj) * 4096); }
#pragma unroll
            for (int m = 0; m < 4; ++m) { const int row = row0 + ai * 128 + m * 16; bf16_t* mp = MG + (size_t)row * D + col0;
#pragma unroll
                for (int bj = 0; bj < 2; ++bj) { f32x4 g0, g1; unpack8v(gv[m][bj], g0, g1);
                    f32x4 v0 = sig4(g0) * acc[ai][bj][m][0], v1 = sig4(g1) * acc[ai][bj][m][1];
                    if (br > 0) { f32x4 p0, p1; unpack8v(pv[m][bj], p0, p1); v0 += p0; v1 += p1; }
                    *(u32x4*)(br < 2 ? pt + ((ai * 4 + m) * 2 + bj) * 4096 : mp + bj * 128) = pack8(v0, v1); } } }
    }
};
struct EpiBf {
    static constexpr bool PERM = true;
    bf16_t* O;
    __device__ __forceinline__ void operator()(const f32x4 (&acc)[2][2][4][2], const Unit& u, int wr, int wc, int fr, int fq) const {
        bf16_t* ot = O + ((size_t)(u.pm * 4 + u.pn) << 16) + ((wr * 4 + wc) * 64 + fq * 16 + fr) * 8;
#pragma unroll
        for (int ai = 0; ai < 2; ++ai)
#pragma unroll
            for (int m = 0; m < 4; ++m)
#pragma unroll
                for (int bj = 0; bj < 2; ++bj) *(u32x4*)(ot + ((ai * 4 + m) * 2 + bj) * 4096) = pack8(acc[ai][bj][m][0], acc[ai][bj][m][1]);
    }
};
struct EpiPle {
    static constexpr bool PERM = true;
    const bf16_t* HIN; bf16_t* HOUT; float* ssq_out; const float* ssq_in; const bf16_t* PP;
    __device__ __forceinline__ void operator()(const f32x4 (&acc)[2][2][4][2], const Unit& u, int wr, int wc, int fr, int fq) const {
        const int row0 = u.pm * 256 + wr * 64 + fr, col0 = u.pn * 256 + wc * 32 + 8 * fq;
        const LaneT LT = lane_t(); const bf16_t* ppt = PP + ((size_t)(u.pm * 4 + u.pn) << 16) + ((wr * 4 + wc) * 64 + fq * 16 + fr) * 8;
        float rsv[2][4], ssv[2][4];
        { f32x4 part[2][4];
#pragma unroll
        for (int ai = 0; ai < 2; ++ai)
#pragma unroll
            for (int m = 0; m < 4; ++m) part[ai][m] = *(const f32x4*)(ssq_in + (size_t)(row0 + ai * 128 + m * 16) * 4);
#pragma unroll
        for (int ai = 0; ai < 2; ++ai)
#pragma unroll
            for (int m = 0; m < 4; ++m) rsv[ai][m] = rstd_from4(part[ai][m]); }
#pragma unroll
        for (int aim = 0; aim < 4; ++aim) { const int ai = aim >> 1, mb = (aim & 1) * 2;
            u32x4 qv[4][2], hv[4][2];
#pragma unroll
            for (int m = mb; m < mb + 2; ++m)
#pragma unroll
                for (int bj = 0; bj < 2; ++bj) { const size_t o = (size_t)(row0 + ai * 128 + m * 16) * D + col0 + bj * 128, ot_ = (size_t)(row0 - fr + LT.r + ai * 128 + m * 16) * D + (col0 - 8 * fq + 8 * LT.c) + bj * 128; qv[m][bj] = *(const u32x4*)(ppt + ((ai * 4 + m) * 2 + bj) * 4096); hv[m][bj] = *(const u32x4*)(HIN + ot_); (void)o; }
#pragma unroll
            for (int m = mb; m < mb + 2; ++m) { const int row = row0 + ai * 128 + m * 16; const float rs = rsv[ai][m];
                bf16_t* bp = HOUT + (size_t)row * D + col0; float ss = 0.f;
#pragma unroll
                for (int bj = 0; bj < 2; ++bj) { f32x4 p0, p1, v0, v1; unpack8v(qv[m][bj], p0, p1); unpack8v(bperm4(hv[m][bj], LT.to_acc), v0, v1);
                    v0 += sig4(acc[ai][bj][m][0] * rs) * p0; v1 += sig4(acc[ai][bj][m][1] * rs) * p1;
                    *(u32x4*)(bp + bj * 128) = pack8(v0, v1);
                    ss += (v0[0] * v0[0] + v0[1] * v0[1]) + (v0[2] * v0[2] + v0[3] * v0[3]) + (v1[0] * v1[0] + v1[1] * v1[1]) + (v1[2] * v1[2] + v1[3] * v1[3]); }
                ss += __shfl_xor(ss, 16); ss += __shfl_xor(ss, 32); ssv[ai][m] = ss; } }
        ssq_tile_reduce(ssv, ssq_out, nullptr, u.pm, u.pn, wr, wc, fr, fq);
    }
};
template <int RANK> struct EpiMoeDown {
    static constexpr bool PERM = true;
    bf16_t* HB; float* ssq; const int* rowtok; const float* roww;
    __device__ __forceinline__ void operator()(const f32x4 (&acc)[2][2][4][2], const Unit& u, int wr, int wc, int fr, int fq) const {
        const int row0 = u.pm * 256 + wr * 64 + fr, col0 = u.pn * 256 + wc * 32 + 8 * fq;
        int tk[2][4]; float ssv[2][4];
#pragma unroll
        for (int ai = 0; ai < 2; ++ai)
#pragma unroll
            for (int m = 0; m < 4; ++m) tk[ai][m] = rowtok[row0 + ai * 128 + m * 16];
#pragma unroll
        for (int ai = 0; ai < 2; ++ai) {
            u32x4 hv[4][2]; float wv[4];
#pragma unroll
            for (int m = 0; m < 4; ++m) { const int tok = tk[ai][m] < 0 ? 0 : tk[ai][m]; wv[m] = roww[row0 + ai * 128 + m * 16];
#pragma unroll
                for (int bj = 0; bj < 2; ++bj) hv[m][bj] = *(const u32x4*)(HB + (size_t)tok * D + col0 + bj * 128); }
#pragma unroll
            for (int m = 0; m < 4; ++m) { const int tok = tk[ai][m]; const float w = wv[m];
                float ss = 0.f;
                if (tok >= 0) { bf16_t* bp = HB + (size_t)tok * D + col0;
#pragma unroll
                    for (int bj = 0; bj < 2; ++bj) { f32x4 v0, v1; unpack8v(hv[m][bj], v0, v1); v0 += acc[ai][bj][m][0] * w; v1 += acc[ai][bj][m][1] * w;
                        *(u32x4*)(bp + bj * 128) = pack8(v0, v1);
                        if (RANK == 1) ss += (v0[0] * v0[0] + v0[1] * v0[1]) + (v0[2] * v0[2] + v0[3] * v0[3]) + (v1[0] * v1[0] + v1[1] * v1[1]) + (v1[2] * v1[2] + v1[3] * v1[3]); } }
                if (RANK == 1) { ss += __shfl_xor(ss, 16); ss += __shfl_xor(ss, 32); ssv[ai][m] = ss; } } }
        if (RANK == 1) ssq_tile_reduce(ssv, ssq, rowtok, u.pm, u.pn, wr, wc, fr, fq);
    }
};

struct EpiMoeDownM {
    static constexpr bool PERM = true;
    bf16_t* HB; bf16_t* Y1; const int* rowtok; const float* roww; int rsplit;
    __device__ __forceinline__ void operator()(const f32x4 (&acc)[2][2][4][2], const Unit& u, int wr, int wc, int fr, int fq) const {
        const int row0 = u.pm * 256 + wr * 64 + fr, col0 = u.pn * 256 + wc * 32 + 8 * fq;
        int tk[2][4];
#pragma unroll
        for (int ai = 0; ai < 2; ++ai)
#pragma unroll
            for (int m = 0; m < 4; ++m) tk[ai][m] = rowtok[row0 + ai * 128 + m * 16];
        if (u.pm < rsplit) { const LaneT LT = lane_t();
#pragma unroll
            for (int ai = 0; ai < 2; ++ai) {
                u32x4 hv[4][2]; float wv[4];
#pragma unroll
                for (int m = 0; m < 4; ++m) { int tok = rowtok[row0 - fr + LT.r + ai * 128 + m * 16]; tok = tok < 0 ? 0 : tok; wv[m] = roww[row0 + ai * 128 + m * 16];
#pragma unroll
                    for (int bj = 0; bj < 2; ++bj) hv[m][bj] = *(const u32x4*)(HB + (size_t)tok * D + (col0 - 8 * fq + 8 * LT.c) + bj * 128); }
#pragma unroll
                for (int m = 0; m < 4; ++m) { const int tok = tk[ai][m]; const float w = wv[m];
                    const u32x4 hvt[2] = {bperm4(hv[m][0], LT.to_acc), bperm4(hv[m][1], LT.to_acc)};
                    if (tok >= 0) { bf16_t* bp = HB + (size_t)tok * D + col0;
#pragma unroll
                        for (int bj = 0; bj < 2; ++bj) { f32x4 v0, v1; unpack8v(hvt[bj], v0, v1); v0 += acc[ai][bj][m][0] * w; v1 += acc[ai][bj][m][1] * w; *(u32x4*)(bp + bj * 128) = pack8(v0, v1); } } } }
        } else {
#pragma unroll
            for (int ai = 0; ai < 2; ++ai)
#pragma unroll
                for (int m = 0; m < 4; ++m) { const int tok = tk[ai][m]; const float w = roww[row0 + ai * 128 + m * 16];
                    if (tok >= 0) { bf16_t* yp = Y1 + (size_t)tok * D + col0;
#pragma unroll
                        for (int bj = 0; bj < 2; ++bj) *(u32x4*)(yp + bj * 128) = pack8(acc[ai][bj][m][0] * w, acc[ai][bj][m][1] * w); } }
        }
    }
};
struct EpiPpComb {
    static constexpr bool PERM = true;
    bf16_t* PP; bf16_t* HB; const bf16_t* Y1; float* ssq;
    __device__ __forceinline__ void operator()(const f32x4 (&acc)[2][2][4][2], const Unit& u, int wr, int wc, int fr, int fq) const {
        const int row0 = u.pm * 256 + wr * 64 + fr, col0 = u.pn * 256 + wc * 32 + 8 * fq;
        const LaneT LT = lane_t(); bf16_t* ot = PP + ((size_t)(u.pm * 4 + u.pn) << 16) + ((wr * 4 + wc) * 64 + fq * 16 + fr) * 8;
        float ssv[2][4];
#pragma unroll
        for (int ai = 0; ai < 2; ++ai) {
            u32x4 hv[4][2], yv[4][2];
#pragma unroll
            for (int m = 0; m < 4; ++m)
#pragma unroll
                for (int bj = 0; bj < 2; ++bj) { const size_t o = (size_t)(row0 - fr + LT.r + ai * 128 + m * 16) * D + (col0 - 8 * fq + 8 * LT.c) + bj * 128; hv[m][bj] = *(const u32x4*)(HB + o); yv[m][bj] = *(const u32x4*)(Y1 + o); }
#pragma unroll
            for (int m = 0; m < 4; ++m) { const int row = row0 + ai * 128 + m * 16; float ss = 0.f;
#pragma unroll
                for (int bj = 0; bj < 2; ++bj) { *(u32x4*)(ot + ((ai * 4 + m) * 2 + bj) * 4096) = pack8(acc[ai][bj][m][0], acc[ai][bj][m][1]);
                    f32x4 v0, v1, y0, y1; unpack8v(bperm4(hv[m][bj], LT.to_acc), v0, v1); unpack8v(bperm4(yv[m][bj], LT.to_acc), y0, y1); v0 += y0; v1 += y1;
                    *(u32x4*)(HB + (size_t)row * D + col0 + bj * 128) = pack8(v0, v1);
                    ss += (v0[0] * v0[0] + v0[1] * v0[1]) + (v0[2] * v0[2] + v0[3] * v0[3]) + (v1[0] * v1[0] + v1[1] * v1[1]) + (v1[2] * v1[2] + v1[3] * v1[3]); }
                ss += __shfl_xor(ss, 16); ss += __shfl_xor(ss, 32); ssv[ai][m] = ss; } }
        ssq_tile_reduce(ssv, ssq, nullptr, u.pm, u.pn, wr, wc, fr, fq);
    }
};

#define XB_TMO      128
#define XB_XCNT(j)  (256  + 64 * (j))
#define XB_XSUB(j)  (1280 + 64 * (j))
#define XB_XGEN(j)  (2304 + 64 * (j))
#define XB_TOP      3328
#define XB_TOPGEN   3392
#define XCD_BAR_WORDS 3456
#define XB_SPIN_CAP (1u << 20)

__device__ __forceinline__ unsigned xb_ld(unsigned* p)              { return __hip_atomic_load(p, __ATOMIC_RELAXED, __HIP_MEMORY_SCOPE_AGENT); }
__device__ __forceinline__ unsigned xb_add(unsigned* p, unsigned v) { return __hip_atomic_fetch_add(p, v, __ATOMIC_RELAXED, __HIP_MEMORY_SCOPE_AGENT); }
__device__ __forceinline__ unsigned xb_xcc_id() { return (unsigned)__builtin_amdgcn_s_getreg((3 << 11) | 20) & 0xFu; }
#define XB_SPIN(cond, bar) do { unsigned _sp = 0; while (cond) { __builtin_amdgcn_s_sleep(1); \
    if ((++_sp & 255u) == 0u) { if (xb_ld(&(bar)[XB_TMO])) break; if (_sp > XB_SPIN_CAP) { atomicAdd(&(bar)[XB_TMO], 1u); break; } } } } while (0)

struct XcdBarrier { unsigned* bar; unsigned x; volatile LAS unsigned* st; };

__device__ __forceinline__ XcdBarrier xcd_barrier_post(unsigned* bar, volatile LAS unsigned* st) {
    XcdBarrier b; b.bar = bar; b.x = xb_xcc_id(); b.st = st;
    if (threadIdx.x == 0) (void)xb_add(&bar[XB_XCNT(b.x)], 1u);
    return b;
}
__device__ __forceinline__ void xcd_barrier_complete(unsigned* bar, unsigned x, unsigned& nloc, unsigned& nx) {
    const unsigned G = gridDim.x * gridDim.y * gridDim.z;
    unsigned sum, cnt, mine, sp = 0u;
    for (;;) {
        sum = 0u; cnt = 0u; mine = 0u;
#pragma unroll
        for (unsigned j = 0; j < 16; ++j) { const unsigned c = xb_ld(&bar[XB_XCNT(j)]); sum += c; cnt += (c > 0u) ? 1u : 0u; mine = (j == x) ? c : mine; }
        if (sum == G) break;
        __builtin_amdgcn_s_sleep(1);
        if ((++sp & 255u) == 0u) { if (xb_ld(&bar[XB_TMO])) break; if (sp > XB_SPIN_CAP) { atomicAdd(&bar[XB_TMO], 1u); break; } }
    }
    nloc = mine > 0u ? mine : 1u; nx = cnt > 0u ? cnt : 1u;
}
__device__ __forceinline__ void xcd_barrier(const XcdBarrier& b, int wave_) {
    asm volatile("s_waitcnt vmcnt(0)" ::: "memory");
    __syncthreads();
    if (wave_ == 0 && lane_id() == 0) {
        unsigned* bar = b.bar;
        __builtin_amdgcn_s_waitcnt(0);
        unsigned nloc = b.st[0], nx = b.st[1];
        if (nloc == 0u) { xcd_barrier_complete(bar, b.x, nloc, nx); b.st[0] = nloc; b.st[1] = nx; }
        const unsigned old = xb_add(&bar[XB_XSUB(b.x)], 1u);
        const unsigned gen = old / nloc;
        if (old + 1u == (gen + 1u) * nloc) {
            __builtin_amdgcn_fence(__ATOMIC_RELEASE, "agent");
            asm volatile("s_waitcnt vmcnt(0)" ::: "memory");
            const unsigned og = xb_add(&bar[XB_TOP], 1u);
            const unsigned tg = og / nx;
            if (og + 1u == (tg + 1u) * nx) xb_add(&bar[XB_TOPGEN], 1u);
            else XB_SPIN(xb_ld(&bar[XB_TOPGEN]) == tg, bar);
            __builtin_amdgcn_fence(__ATOMIC_ACQUIRE, "agent");
            xb_add(&bar[XB_XGEN(b.x)], 1u);
            asm volatile("s_waitcnt vmcnt(0)" ::: "memory");
        } else {
            XB_SPIN(xb_ld(&bar[XB_XGEN(b.x)]) == gen, bar);
            __builtin_amdgcn_fence(__ATOMIC_ACQUIRE, "agent");
            asm volatile("s_waitcnt vmcnt(0)" ::: "memory");
        }
    }
    __syncthreads();
}

constexpr int RING_BYTES = 131072;
constexpr int LDS_BYTES = 147456;
constexpr int LDSCTL_OFF = LDS_BYTES - 1024;

struct Frame {
    unsigned char* lds; LAS unsigned char* lds3; volatile LAS unsigned* lctl;
    unsigned* ctl; unsigned char* ws;
    int tid, lane, wave, G, bid, wave0;
    __device__ __forceinline__ int og() const { int g = G; asm volatile("" : "+s"(g)); return g; }
    __device__ __forceinline__ void retid() { int t = wave0 * 64 + lane_id(); asm volatile("" : "+v"(t)); tid = t; lane = t & 63; wave = __builtin_amdgcn_readfirstlane(t >> 6); }
};
#define LDS_WAIT() asm volatile("s_waitcnt lgkmcnt(0)" ::: "memory")

__device__ __forceinline__ int conv_rowmap(int mode, int n) {
    if (mode == 1) return n < 3008 ? n : (n < 3012 ? C_IW + (n - 3008) : (n < 4548 ? n - 4 : n + 60));
    if (mode == 2) return 256 * (n >> 7) + (n & 127);
    if (mode == 3) return 256 * (n >> 7) + 128 + (n & 127);
    return n;
}
__device__ __forceinline__ void conv_item(const float* W, int K, int N, const float* ksc, bf16_t* WT, int mode, float* scr, int item, int lane) {
    const int nblk = (N + 31) / 32, kb = item / nblk, nb = item % nblk, k0 = 64 * kb, n0 = 32 * nb;
    const int c4 = (lane & 7) * 4, nl = n0 + c4; const bool nv = nl < N;
#pragma unroll
    for (int i = 0; i < 8; ++i) { const int kk = 8 * i + (lane >> 3); f32x4 v = (f32x4){0.f, 0.f, 0.f, 0.f};
        if (nv) { v = *(const f32x4*)(W + (size_t)(k0 + kk) * N + nl); if (ksc) v = v * ksc[k0 + kk]; }
        float* sp = scr + kk * 33 + c4; sp[0] = v[0]; sp[1] = v[1]; sp[2] = v[2]; sp[3] = v[3]; }
    LDS_WAIT(); __builtin_amdgcn_wave_barrier();
    const int c = lane & 7;
#pragma unroll
    for (int j = 0; j < 4; ++j) { const int n = (lane >> 3) + 8 * j; const int ng = n0 + n;
        if (ng < N) { const float* s = scr + (8 * c) * 33 + n; uint4 o; o.x = pk2(s[0 * 33], s[1 * 33]); o.y = pk2(s[2 * 33], s[3 * 33]); o.z = pk2(s[4 * 33], s[5 * 33]); o.w = pk2(s[6 * 33], s[7 * 33]);
            *(uint4*)(WT + (size_t)conv_rowmap(mode, ng) * K + k0 + 8 * c) = o; } }
    LDS_WAIT(); __builtin_amdgcn_wave_barrier();
}
template <class IN> __device__ __forceinline__ void phase_prologue(Frame& F, const IN in) {
    F.retid();
    float* scr = (float*)(F.lds + F.wave * 16384);
    const int gw = F.bid * NWAVES + F.wave, NGW = F.og() * NWAVES;
    constexpr int NT = 11;
    const int tcount[NT] = {4, 12, 4, 2, 2, 2, 16, 16, 16, 4, 4};
    const int titems[NT] = {16 * 239, 8 * 32, 16 * 32, 16 * 88, 16 * 88, 44 * 32, 16 * 88, 16 * 88, 44 * 32, 16 * 32, 4 * 32};
    int total = 0;
#pragma unroll
    for (int t = 0; t < NT; ++t) total += tcount[t] * titems[t];
    for (int it = gw; it < total; it += NGW) {
        int r = it, t = 0;
#pragma unroll
        for (int q = 0; q < NT - 1; ++q) { if (t == q && r >= tcount[q] * titems[q]) { r -= tcount[q] * titems[q]; t = q + 1; } }
        const int mi = r / titems[t], item = r % titems[t];
        const float* W; int K, N, mode = 0; const float* ksc = nullptr; bf16_t* WT;
        switch (t) {
        case 0: W = in[4] + (size_t)mi * D * IN_W; K = D; N = IN_W; ksc = in[3] + mi * D; WT = (bf16_t*)(F.ws + WS_WIN + mi * SZ_WIN); mode = 1; break;
        case 1: W = in[9] + (size_t)mi * 512 * D; K = 512; N = D; WT = (bf16_t*)(F.ws + WS_WBR + (size_t)mi * D * 512 * 2); break;
        case 2: W = in[10] + (size_t)mi * D * D; K = D; N = D; WT = (bf16_t*)(F.ws + WS_WOUT + mi * SZ_WOUT); break;
        case 3: W = in[12] + (size_t)mi * D * DFF; K = D; N = DFF; ksc = in[11] + (2 * mi) * D; WT = (bf16_t*)(F.ws + WS_WDGU + mi * SZ_WGU); mode = 2; break;
        case 4: W = in[13] + (size_t)mi * D * DFF; K = D; N = DFF; ksc = in[11] + (2 * mi) * D; WT = (bf16_t*)(F.ws + WS_WDGU + mi * SZ_WGU); mode = 3; break;
        case 5: W = in[14] + (size_t)mi * DFF * D; K = DFF; N = D; WT = (bf16_t*)(F.ws + WS_WDD + mi * SZ_WD); break;
        case 6: W = in[16] + (size_t)mi * D * DFF; K = D; N = DFF; ksc = in[11] + (2 * (mi >> 3) + 1) * D; WT = (bf16_t*)(F.ws + WS_WMGU + mi * SZ_WGU); mode = 2; break;
        case 7: W = in[17] + (size_t)mi * D * DFF; K = D; N = DFF; ksc = in[11] + (2 * (mi >> 3) + 1) * D; WT = (bf16_t*)(F.ws + WS_WMGU + mi * SZ_WGU); mode = 3; break;
        case 8: W = in[18] + (size_t)mi * DFF * D; K = DFF; N = D; WT = (bf16_t*)(F.ws + WS_WMD + mi * SZ_WD); break;
        case 9: W = in[20] + (size_t)mi * D * D; K = D; N = D; ksc = in[19] + mi * D; WT = (bf16_t*)(F.ws + WS_WPG + mi * SZ_WOUT); break;
        default: W = in[21] + (size_t)mi * PLE * D; K = PLE; N = D; WT = (bf16_t*)(F.ws + WS_WPP + mi * SZ_WPP); break;
        }
        conv_item(W, K, N, ksc, WT, mode, scr, item, F.lane);
    }
    const int gt = F.bid * NTHR + F.tid, NGT = F.og() * NTHR;
    bf16_t* wkv = (bf16_t*)(F.ws + WS_WKV);
    for (int i = gt; i < 4 * 128 * 128; i += NGT) { const int l = i >> 14, n = (i >> 7) & 127, j = i & 127;
        const float w = n < 64 ? in[7][((size_t)l * 128 + j) * 64 + n] : in[8][((size_t)l * 128 + j) * 64 + (n - 64)];
        wkv[i] = (bf16_t)f2bf(in[6][l * 128 + j] * w); }
    float* lb = (float*)(F.ws + WS_LB);
    for (int ch = gt; ch < 512; ch += NGT) { float v[4], mx = -1e30f;
#pragma unroll
        for (int l = 0; l < 4; ++l) { v[l] = in[2][l * 512 + ch]; mx = fmaxf(mx, v[l]); }
        float s = 0.f;
#pragma unroll
        for (int l = 0; l < 4; ++l) { v[l] = __expf(v[l] - mx); s += v[l]; }
        float c = 0.f; lb[ch] = 0.f;
#pragma unroll
        for (int l = 1; l < 4; ++l) { c += v[l] / s; lb[l * 512 + ch] = c; } }
}

__device__ __forceinline__ void phase_init(Frame& F, const float* x, bf16_t* HBN, float* ssq1, int Ts) {
    F.retid();
    const int gw = F.bid * NWAVES + F.wave, NGW = F.og() * NWAVES;
    for (int r = gw; r < Ts; r += NGW) {
        const f32x4* xr = (const f32x4*)(x + (size_t)r * D) + F.lane; u32x2* br = (u32x2*)(HBN + (size_t)r * D) + F.lane;
        float ss = 0.f;
#pragma unroll
        for (int j = 0; j < 4; ++j) { const f32x4 v = xr[64 * j]; u32x2 w; w.x = pk2(v[0], v[1]); w.y = pk2(v[2], v[3]); br[64 * j] = w; ss += (v[0] * v[0] + v[1] * v[1]) + (v[2] * v[2] + v[3] * v[3]); }
        ss = wave_sum(ss);
        if (F.lane < 4) ssq1[(size_t)r * 4 + F.lane] = F.lane == 0 ? ss : 0.f;
    }
}
__device__ __forceinline__ void phase_final(Frame& F, const bf16_t* HBN, float* OUT, const float* g, int Ts) {
    F.retid();
    const int gw = F.bid * NWAVES + F.wave, NGW = F.og() * NWAVES;
    for (int r = gw; r < Ts; r += NGW) {
        const u32x2* hr = (const u32x2*)(HBN + (size_t)r * D) + F.lane; f32x4* orow = (f32x4*)(OUT + (size_t)r * D) + F.lane; const f32x4* gr = (const f32x4*)g + F.lane; f32x4 v[4]; float ss = 0.f;
#pragma unroll
        for (int j = 0; j < 4; ++j) { const u32x2 w = hr[64 * j]; v[j] = (f32x4){bflo(w.x), bfhi(w.x), bflo(w.y), bfhi(w.y)}; ss += (v[j][0] * v[j][0] + v[j][1] * v[j][1]) + (v[j][2] * v[j][2] + v[j][3] * v[j][3]); }
        const float rs = rsqrtf(wave_sum(ss) * (1.f / D) + EPS);
#pragma unroll
        for (int j = 0; j < 4; ++j) orow[64 * j] = v[j] * rs * gr[64 * j];
    }
}
__device__ __forceinline__ void phase_prep(Frame& F, const bf16_t* Z, bf16_t* KV, const bf16_t* wkvt, const float* p, bf16_t* PB, int Ts) {
    F.retid();
    const int gw = F.bid * NWAVES + F.wave, NGW = F.og() * NWAVES; const int n16 = F.lane & 15, quad = F.lane >> 4;
    for (int tile = gw; tile < Ts / 16; tile += NGW) {
        const int tok = tile * 16 + n16;
        const bf16_t* zr = Z + (size_t)tok * ZP + C_SC + quad * 8;
        bf16x8 bf[4]; float ss = 0.f;
#pragma unroll
        for (int ks = 0; ks < 4; ++ks) { const u32x4 raw = *(const u32x4*)(zr + ks * 32); bf[ks] = __builtin_bit_cast(bf16x8, raw);
            const float a0 = bflo(raw.x), a1 = bfhi(raw.x), a2 = bflo(raw.y), a3 = bfhi(raw.y), a4 = bflo(raw.z), a5 = bfhi(raw.z), a6 = bflo(raw.w), a7 = bfhi(raw.w);
            ss += (a0 * a0 + a1 * a1) + (a2 * a2 + a3 * a3) + (a4 * a4 + a5 * a5) + (a6 * a6 + a7 * a7); }
        ss += __shfl_xor(ss, 16); ss += __shfl_xor(ss, 32);
        const float rs = rsqrtf(ss * (1.f / 128.f) + EPS);
#pragma unroll
        for (int nb = 0; nb < 8; ++nb) { f32x4 acc = (f32x4){0.f, 0.f, 0.f, 0.f};
            const bf16_t* wr_ = wkvt + (size_t)(16 * nb + n16) * 128 + quad * 8;
#pragma unroll
            for (int ks = 0; ks < 4; ++ks) acc = __builtin_amdgcn_mfma_f32_16x16x32_bf16(*(const bf16x8*)(wr_ + ks * 32), bf[ks], acc, 0, 0, 0);
            u32x2 pk; pk.x = pk2(acc[0] * rs, acc[1] * rs); pk.y = pk2(acc[2] * rs, acc[3] * rs);
            *(u32x2*)(KV + (size_t)tok * 128 + 16 * nb + 4 * quad) = pk; }
    }
    (void)p; (void)PB;
}

typedef float f32x16 __attribute__((ext_vector_type(16)));
typedef short s16x4 __attribute__((ext_vector_type(4)));
__device__ __forceinline__ s16x4 tr_read(unsigned addr) { return __builtin_bit_cast(s16x4, __builtin_amdgcn_ds_read_tr16_b64_v4i16((LAS s16x4*)(uintptr_t)addr)); }
__device__ __forceinline__ void hgrn_naive_unit(Frame& F, const bf16_t* Z, bf16_t* OA, const float* lbl, const float* onorm, int b, int h) {
    float* Qs = (float*)F.lds; float* Fs = Qs + 16 * 128; float* Vs = Fs + 16 * 128; float* OP = Vs + 16 * 128;
    const int dv = F.tid & 127, dkg = F.tid >> 7;
    float S[32];
#pragma unroll
    for (int i = 0; i < 32; ++i) S[i] = 0.f;
    const size_t row0 = (size_t)b * SEQ;
    for (int t0 = 0; t0 < SEQ; t0 += 16) {
        __syncthreads();
        for (int i = F.tid; i < 16 * 128; i += NTHR) { const int tt = i >> 7, ch = i & 127; const bf16_t* zr = Z + (row0 + t0 + tt) * ZP + h * 128 + ch;
            const float q = bf2f(zr[C_HQ]), fp = bf2f(zr[C_HF]), v = bf2f(zr[C_HI]); const float lb = lbl[h * 128 + ch];
            Qs[i] = siluf_(q); Fs[i] = lb + (1.f - lb) * sigmoidf_(fp); Vs[i] = v; }
        __syncthreads();
        for (int tt = 0; tt < 16; ++tt) {
            const float vv = Vs[tt * 128 + dv]; float po = 0.f;
            const float* fr_ = Fs + tt * 128 + dkg * 32; const float* qr_ = Qs + tt * 128 + dkg * 32;
#pragma unroll
            for (int i = 0; i < 32; ++i) { const float fi = fr_[i]; S[i] = fi * S[i] + (1.f - fi) * vv; po += S[i] * qr_[i]; }
            OP[(tt * 4 + dkg) * 128 + dv] = po;
        }
        __syncthreads();
#pragma unroll
        for (int k = 0; k < 2; ++k) { const int tt = 2 * F.wave + k;
            float o0 = 0.f, o1 = 0.f;
#pragma unroll
            for (int g = 0; g < 4; ++g) { o0 += OP[(tt * 4 + g) * 128 + F.lane]; o1 += OP[(tt * 4 + g) * 128 + 64 + F.lane]; }
            const float rs = rsqrtf(wave_sum(o0 * o0 + o1 * o1) * (1.f / 128.f) + EPS);
            const bf16_t* zg = Z + (row0 + t0 + tt) * ZP + C_HG + h * 128;
            bf16_t* oa = OA + (row0 + t0 + tt) * 512 + h * 128;
            oa[F.lane] = (bf16_t)f2bf(o0 * rs * onorm[F.lane] * siluf_(bf2f(zg[F.lane])));
            oa[64 + F.lane] = (bf16_t)f2bf(o1 * rs * onorm[64 + F.lane] * siluf_(bf2f(zg[64 + F.lane]))); }
    }
    __syncthreads();
}
__device__ __forceinline__ float row16_sumf(float v) {
    v += __builtin_bit_cast(float, __builtin_amdgcn_update_dpp(0, __builtin_bit_cast(int, v), 0xB1, 0xf, 0xf, true));
    v += __builtin_bit_cast(float, __builtin_amdgcn_update_dpp(0, __builtin_bit_cast(int, v), 0x4E, 0xf, 0xf, true));
    v += __builtin_bit_cast(float, __builtin_amdgcn_update_dpp(0, __builtin_bit_cast(int, v), 0x141, 0xf, 0xf, true));
    v += __builtin_bit_cast(float, __builtin_amdgcn_update_dpp(0, __builtin_bit_cast(int, v), 0x140, 0xf, 0xf, true));
    return v;
}
typedef short s16x4b __attribute__((ext_vector_type(4)));
__device__ __forceinline__ void hgrn_mfma_unit(Frame& F, const bf16_t* Z, bf16_t* OA, const float* onorm, int b, int h) {
    constexpr int RP = 272, PP = 144;
    constexpr int O_QT = 0, O_KT = 17408, O_KD = 34816, O_V = 53248, O_DEC = 70656, O_SSQ = 72704, O_OUT = 74752;
    LAS unsigned char* L = (LAS unsigned char*)F.lds;
    const int tid = F.tid, lane = F.lane, w = F.wave, n16 = lane & 15, quad = lane >> 4, q4 = (lane >> 2) & 3, p4 = lane & 3;
    const int d = tid & 127, I = tid >> 7;
    f32x4 S[8];
#pragma unroll
    for (int k = 0; k < 8; ++k) S[k] = (f32x4){0.f, 0.f, 0.f, 0.f};
    const size_t seq0 = (size_t)b * SEQ;
    const unsigned Lb = (unsigned)(uintptr_t)L;
    const float on = onorm[16 * w + n16];
    bf16_t rq[16], rf[16], rg[16]; u32x4 rv0, rv1;
    const bf16_t* zq = Z + (seq0 + 16 * I) * ZP + h * 128 + d;
    const bf16_t* zg = Z + (seq0 + 4 * quad) * ZP + C_HG + h * 128 + 16 * w + n16;
    const int vr0 = tid >> 4, vc0 = tid & 15;
    const bf16_t* zv = Z + (seq0 + vr0) * ZP + C_HI + h * 128 + vc0 * 8;
#define HG_PREFETCH(c) do { const size_t ro = (size_t)(c) * 64 * ZP; \
        _Pragma("unroll") for (int tt = 0; tt < 16; ++tt) { rq[tt] = zq[ro + (size_t)tt * ZP + C_HQ]; rf[tt] = zq[ro + (size_t)tt * ZP + C_HF]; } \
        _Pragma("unroll") for (int bi = 0; bi < 4; ++bi) _Pragma("unroll") for (int i = 0; i < 4; ++i) rg[bi * 4 + i] = zg[ro + (size_t)(16 * bi + i) * ZP]; \
        rv0 = *(const u32x4*)(zv + ro); rv1 = *(const u32x4*)(zv + ro + (size_t)32 * ZP); } while (0)
    HG_PREFETCH(0);
    for (int c = 0; c < SEQ / 64; ++c) {
        const size_t row = seq0 + (size_t)c * 64;
        __syncthreads();
        *(LAS u32x4*)(L + O_V + vr0 * RP + vc0 * 16) = rv0; *(LAS u32x4*)(L + O_V + (vr0 + 32) * RP + vc0 * 16) = rv1;
        float cl[16], qv[16], kv[16], gv[16]; float run = 0.f;
#pragma unroll
        for (int tt = 0; tt < 16; ++tt) { const float lf = bf2f(rf[tt]); run += lf; cl[tt] = run; kv[tt] = 1.f - __expf(lf); qv[tt] = bf2f(rq[tt]); gv[tt] = bf2f(rg[tt]); }
        const float eB = __expf(run);
        *(LAS float*)(L + O_DEC + (I * 128 + d) * 4) = eB;
        if (c + 1 < SEQ / 64) HG_PREFETCH(c + 1);
#pragma unroll
        for (int tt = 0; tt < 16; ++tt) { const int t = 16 * I + tt;
            *(LAS bf16_t*)(L + O_QT + t * RP + d * 2) = (bf16_t)f2bf(qv[tt] * __expf(cl[tt]));
            const float kk = kv[tt] * __expf(fminf(-cl[tt], 80.f));
            *(LAS bf16_t*)(L + O_KT + t * RP + d * 2) = (bf16_t)f2bf(kk);
            kv[tt] = kk * eB; }
#pragma unroll
        for (int g = 0; g < 4; ++g) { u32x2 pk; pk.x = pk2(kv[4 * g], kv[4 * g + 1]); pk.y = pk2(kv[4 * g + 2], kv[4 * g + 3]); *(LAS u32x2*)(L + O_KD + d * PP + (16 * I + 4 * g) * 2) = pk; }
        __syncthreads();
#pragma unroll 1
        for (int bi = 0; bi < 4; ++bi) {
            const LAS unsigned char* ap = L + O_KT + (16 * bi + n16) * RP + quad * 16;
            const LAS unsigned char* bp = L + O_QT + (16 * bi + n16) * RP + quad * 16;
            f32x4 acc = (f32x4){0.f, 0.f, 0.f, 0.f};
#pragma unroll
            for (int ks = 0; ks < 4; ++ks) acc = __builtin_amdgcn_mfma_f32_16x16x32_bf16(*(const LAS bf16x8*)(ap + ks * 64), *(const LAS bf16x8*)(bp + ks * 64), acc, 0, 0, 0);
#pragma unroll
            for (int i = 0; i < 4; ++i) if (4 * quad + i > n16) acc[i] = 0.f;
            u32x2 pk; pk.x = pg8::cvt_pk_bf16(acc[0], acc[1]); pk.y = pg8::cvt_pk_bf16(acc[2], acc[3]);
            const s16x4b pa = __builtin_bit_cast(s16x4b, pk);
            const s16x4b vfr = __builtin_bit_cast(s16x4b, tr_read(Lb + O_V + (unsigned)((16 * bi + 4 * quad + q4) * RP + (16 * w + 4 * p4) * 2)));
            const bf16x8 pa8 = (bf16x8){pa[0], pa[1], pa[2], pa[3], 0, 0, 0, 0}, vf8 = (bf16x8){vfr[0], vfr[1], vfr[2], vfr[3], vfr[0], vfr[1], vfr[2], vfr[3]};
            f32x4 oo = __builtin_amdgcn_mfma_f32_16x16x32_bf16(pa8, vf8, (f32x4){0.f, 0.f, 0.f, 0.f}, 0, 0, 0);
            const LAS unsigned char* qp = L + O_QT + (16 * bi + n16) * RP + quad * 8;
#pragma unroll
            for (int ks = 0; ks < 4; ++ks) { u32x4 pw; pw.x = pg8::cvt_pk_bf16(S[2 * ks][0], S[2 * ks][1]); pw.y = pg8::cvt_pk_bf16(S[2 * ks][2], S[2 * ks][3]);
                pw.z = pg8::cvt_pk_bf16(S[2 * ks + 1][0], S[2 * ks + 1][1]); pw.w = pg8::cvt_pk_bf16(S[2 * ks + 1][2], S[2 * ks + 1][3]);
                const u32x2 lo = *(const LAS u32x2*)(qp + ks * 64), hi = *(const LAS u32x2*)(qp + ks * 64 + 32);
                u32x4 av; av.x = lo.x; av.y = lo.y; av.z = hi.x; av.w = hi.y;
                oo = __builtin_amdgcn_mfma_f32_16x16x32_bf16(__builtin_bit_cast(bf16x8, av), __builtin_bit_cast(bf16x8, pw), oo, 0, 0, 0); }
            *(LAS f32x4*)(L + O_OUT + ((16 * w + n16) * 64 + 16 * bi + 4 * quad) * 4) = oo;
#pragma unroll
            for (int i = 0; i < 4; ++i) { const float ss = row16_sumf(oo[i] * oo[i]);
                if (n16 == 0) *(LAS float*)(L + O_SSQ + ((16 * bi + 4 * quad + i) * 8 + w) * 4) = ss; }
#pragma unroll
            for (int kb = 0; kb < 8; ++kb) {
                const f32x4 dec = *(const LAS f32x4*)(L + O_DEC + (bi * 128 + 16 * kb + 4 * quad) * 4);
                const s16x4b ka = *(const LAS s16x4b*)(L + O_KD + (16 * kb + n16) * PP + (16 * bi + 4 * quad) * 2);
                S[kb] = __builtin_amdgcn_mfma_f32_16x16x32_bf16((bf16x8){ka[0], ka[1], ka[2], ka[3], 0, 0, 0, 0}, vf8, S[kb] * dec, 0, 0, 0);
            }
        }
        __syncthreads();
#pragma unroll
        for (int bi = 0; bi < 4; ++bi) {
            const f32x4 oo = *(const LAS f32x4*)(L + O_OUT + ((16 * w + n16) * 64 + 16 * bi + 4 * quad) * 4);
#pragma unroll
            for (int i = 0; i < 4; ++i) { const int t = 16 * bi + 4 * quad + i;
                const f32x4 pa = *(const LAS f32x4*)(L + O_SSQ + t * 32), pb = *(const LAS f32x4*)(L + O_SSQ + t * 32 + 16);
                const float rs = rsqrtf((((pa[0] + pa[1]) + (pa[2] + pa[3])) + ((pb[0] + pb[1]) + (pb[2] + pb[3]))) * (1.f / 128.f) + EPS);
                OA[(row + t) * 512 + h * 128 + 16 * w + n16] = (bf16_t)f2bf(oo[i] * rs * on * gv[bi * 4 + i]); } }
    }
#undef HG_PREFETCH
    __syncthreads();
}
__device__ __forceinline__ void sb_naive_unit(Frame& F, const bf16_t* Z, bf16_t* OC, int b, int h, int qblk) {
    const int t = qblk * NTHR + F.tid; const size_t row0 = (size_t)b * SEQ;
    float q[64], o[64];
    { const uint4* qp = (const uint4*)(Z + (row0 + t) * ZP + C_BQ + h * 64);
#pragma unroll
      for (int c = 0; c < 8; ++c) { float f[8]; unpack8(qp[c], f);
#pragma unroll
          for (int e = 0; e < 8; ++e) { q[c * 8 + e] = f[e] * 0.125f; o[c * 8 + e] = 0.f; } } }
    float P = 1.f;
    for (int s = t - 1; s >= 0; --s) {
        if (P < 1e-30f) break;
        const uint4* kp = (const uint4*)(Z + (row0 + s) * ZP + C_BK + h * 64); const uint4* vp = (const uint4*)(Z + (row0 + s) * ZP + C_BV + h * 64);
        float dot = 0.f;
#pragma unroll
        for (int c = 0; c < 8; ++c) { float f[8]; unpack8(kp[c], f);
#pragma unroll
            for (int e = 0; e < 8; ++e) dot += q[c * 8 + e] * f[e]; }
        const float zc = fmaxf(dot, -80.f), ex = __expf(-zc), beta = 1.f / (1.f + ex), A = beta * P;
        P *= ex * beta;
#pragma unroll
        for (int c = 0; c < 8; ++c) { float f[8]; unpack8(vp[c], f);
#pragma unroll
            for (int e = 0; e < 8; ++e) o[c * 8 + e] += A * f[e]; }
    }
    uint4* op = (uint4*)(OC + (row0 + t) * 512 + h * 64);
#pragma unroll
    for (int c = 0; c < 8; ++c) { uint4 w; w.x = pk2(o[c * 8], o[c * 8 + 1]); w.y = pk2(o[c * 8 + 2], o[c * 8 + 3]); w.z = pk2(o[c * 8 + 4], o[c * 8 + 5]); w.w = pk2(o[c * 8 + 6], o[c * 8 + 7]); op[c] = w; }
}
__device__ __forceinline__ void sb_mfma_wave(const bf16_t* Z, bf16_t* OC, int b, int h, int t0, unsigned char* wl, int lane) {
    const int r32 = lane & 31, hi = lane >> 5; const size_t row0 = (size_t)b * SEQ;
    bf16x8 qr[4];
    { const bf16_t* qp = Z + (row0 + t0 + r32) * ZP + C_BQ + h * 64 + hi * 8;
#pragma unroll
      for (int d0 = 0; d0 < 4; ++d0) qr[d0] = *(const bf16x8*)(qp + d0 * 16); }
    const int kappa = 16 * ((r32 >> 2) & 1) + (r32 & 3) + 4 * (r32 >> 3);
    f32x16 o0, o1;
#pragma unroll
    for (int r = 0; r < 16; ++r) { o0[r] = 0.f; o1[r] = 0.f; }
    float C = 1.f; const float cneg = -0.125f * 1.4426950408889634f;
    const int vrow = lane >> 3, vcc = lane & 7;
    const int g = lane >> 4, q4 = (lane >> 2) & 3, p4 = lane & 3;
    const unsigned wl3 = (unsigned)(uintptr_t)(LAS unsigned char*)wl;
    const unsigned trbase = wl3 + (unsigned)((16 * (g >> 1) + q4) * 144 + (16 * (g & 1) + 4 * p4) * 2);
    const int ktd = t0 >> 5;
    for (int kt = ktd; kt >= 0; --kt) {
        const int s0 = kt * 32;
        const bf16_t* kp = Z + (row0 + s0 + kappa) * ZP + C_BK + h * 64 + hi * 8;
        bf16x8 kf[4];
#pragma unroll
        for (int d0 = 0; d0 < 4; ++d0) kf[d0] = *(const bf16x8*)(kp + d0 * 16);
        const bf16_t* vp = Z + (row0 + s0 + vrow) * ZP + C_BV + h * 64 + vcc * 8;
        const u32x4 vv0 = *(const u32x4*)(vp), vv1 = *(const u32x4*)(vp + (size_t)8 * ZP), vv2 = *(const u32x4*)(vp + (size_t)16 * ZP), vv3 = *(const u32x4*)(vp + (size_t)24 * ZP);
        { LAS unsigned char* w3 = (LAS unsigned char*)wl + vrow * 144 + vcc * 16;
          *(LAS u32x4*)(w3) = vv0; *(LAS u32x4*)(w3 + 8 * 144) = vv1; *(LAS u32x4*)(w3 + 16 * 144) = vv2; *(LAS u32x4*)(w3 + 24 * 144) = vv3; }
        f32x16 p;
#pragma unroll
        for (int r = 0; r < 16; ++r) p[r] = 0.f;
#pragma unroll
        for (int d0 = 0; d0 < 4; ++d0) p = __builtin_amdgcn_mfma_f32_32x32x16_bf16(kf[d0], qr[d0], p, 0, 0, 0);
        float A[16]; float run = 1.f;
#pragma unroll
        for (int r = 15; r >= 0; --r) {
            const float zz = fminf(p[r] * cneg, 115.f), e = __builtin_amdgcn_exp2f(zz); float bt = __builtin_amdgcn_rcpf(1.f + e), kp_ = e * bt;
            if (kt == ktd && (16 * hi + r >= r32)) { bt = 0.f; kp_ = 1.f; }
            A[r] = bt * run; run *= kp_;
        }
        const float other = __builtin_bit_cast(float, __builtin_amdgcn_ds_bpermute((lane ^ 32) << 2, __builtin_bit_cast(int, run)));
        const float cin = hi ? C : C * other;
        u32x4 pw0, pw1;
        pw0.x = pg8::cvt_pk_bf16(A[0] * cin, A[1] * cin); pw0.y = pg8::cvt_pk_bf16(A[2] * cin, A[3] * cin); pw0.z = pg8::cvt_pk_bf16(A[4] * cin, A[5] * cin); pw0.w = pg8::cvt_pk_bf16(A[6] * cin, A[7] * cin);
        pw1.x = pg8::cvt_pk_bf16(A[8] * cin, A[9] * cin); pw1.y = pg8::cvt_pk_bf16(A[10] * cin, A[11] * cin); pw1.z = pg8::cvt_pk_bf16(A[12] * cin, A[13] * cin); pw1.w = pg8::cvt_pk_bf16(A[14] * cin, A[15] * cin);
        C = C * run * other;
        asm volatile("s_waitcnt lgkmcnt(0)" ::: "memory");
        s16x4 v0a = tr_read(trbase), v0b = tr_read(trbase + 4 * 144), v1a = tr_read(trbase + 64), v1b = tr_read(trbase + 4 * 144 + 64);
        s16x4 v2a = tr_read(trbase + 8 * 144), v2b = tr_read(trbase + 12 * 144), v3a = tr_read(trbase + 8 * 144 + 64), v3b = tr_read(trbase + 12 * 144 + 64);
#define VF(a, b) (bf16x8){a[0], a[1], a[2], a[3], b[0], b[1], b[2], b[3]}
        o0 = __builtin_amdgcn_mfma_f32_32x32x16_bf16(__builtin_bit_cast(bf16x8, pw0), VF(v0a, v0b), o0, 0, 0, 0);
        o1 = __builtin_amdgcn_mfma_f32_32x32x16_bf16(__builtin_bit_cast(bf16x8, pw0), VF(v1a, v1b), o1, 0, 0, 0);
        o0 = __builtin_amdgcn_mfma_f32_32x32x16_bf16(__builtin_bit_cast(bf16x8, pw1), VF(v2a, v2b), o0, 0, 0, 0);
        o1 = __builtin_amdgcn_mfma_f32_32x32x16_bf16(__builtin_bit_cast(bf16x8, pw1), VF(v3a, v3b), o1, 0, 0, 0);
#undef VF
        asm volatile("s_waitcnt lgkmcnt(0)" ::: "memory");
        if (__all(C < 1e-30f)) break;
    }
    bf16_t* op = OC + (row0 + t0) * 512 + h * 64 + r32;
#pragma unroll
    for (int r = 0; r < 16; ++r) { const int q = (r & 3) + 8 * (r >> 2) + 4 * hi; op[(size_t)q * 512] = (bf16_t)f2bf(o0[r]); op[(size_t)q * 512 + 32] = (bf16_t)f2bf(o1[r]); }
}
__device__ __forceinline__ void dsa_naive_query(const bf16_t* Z, const bf16_t* KV, bf16_t* OB, int tokl, float* wl, int lane) {
    const int b = tokl / SEQ, t = tokl % SEQ, c = t >> 6, nj = c + 1; const size_t row0 = (size_t)b * SEQ;
    float* iq_s = wl; float* q_s = wl + 256; int* list = (int*)(wl + 768); float* Pm = wl + 1024;
    const bf16_t* zr = Z + (size_t)tokl * ZP;
    LDS_WAIT(); __builtin_amdgcn_wave_barrier();
#pragma unroll
    for (int i = 0; i < 4; ++i) iq_s[lane + 64 * i] = bf2f(zr[C_IQ + lane + 64 * i]);
#pragma unroll
    for (int i = 0; i < 8; ++i) q_s[lane + 64 * i] = bf2f(zr[C_SQ + lane + 64 * i]) * 0.125f;
    const float w0 = bf2f(zr[C_IW + 0]) * 0.5f, w1 = bf2f(zr[C_IW + 1]) * 0.5f, w2 = bf2f(zr[C_IW + 2]) * 0.5f, w3 = bf2f(zr[C_IW + 3]) * 0.5f;
    LDS_WAIT(); __builtin_amdgcn_wave_barrier();
    unsigned* keyl = (unsigned*)Pm;
    for (int j = 0; j < nj; ++j) {
        const uint4* kp = (const uint4*)(Z + (row0 + j * 64 + lane) * ZP + C_IK);
        float d0 = 0.f, d1 = 0.f, d2 = 0.f, d3 = 0.f;
#pragma unroll 1
        for (int ch = 0; ch < 8; ++ch) { float f[8]; unpack8(kp[ch], f);
#pragma unroll
            for (int e = 0; e < 8; ++e) { const int dd = ch * 8 + e; d0 += iq_s[dd] * f[e]; d1 += iq_s[64 + dd] * f[e]; d2 += iq_s[128 + dd] * f[e]; d3 += iq_s[192 + dd] * f[e]; } }
        float isc = fmaxf(d0, 0.f) * w0 + fmaxf(d1, 0.f) * w1 + fmaxf(d2, 0.f) * w2 + fmaxf(d3, 0.f) * w3; isc += 0.0f;
        unsigned u = __builtin_bit_cast(unsigned, isc); u ^= (u >> 31) ? 0xffffffffu : 0x80000000u; keyl[j * 64 + lane] = u;
    }
    LDS_WAIT(); __builtin_amdgcn_wave_barrier();
    const unsigned long long lt = (1ull << lane) - 1ull;
    int nsel = 0;
    if (nj <= 4) {
        for (int j = 0; j < nj; ++j) list[j * 64 + lane] = j * 64 + lane;
        nsel = nj * 64;
    } else {
        unsigned thr = 0u;
        for (int bit = 31; bit >= 0; --bit) { const unsigned cand = thr | (1u << bit); int cnt = 0;
            for (int j = 0; j < nj; ++j) cnt += __popcll(__ballot(keyl[j * 64 + lane] >= cand));
            if (cnt >= 256) thr = cand; }
        int cgt = 0;
        for (int j = 0; j < nj; ++j) cgt += __popcll(__ballot(keyl[j * 64 + lane] > thr));
        const int need = 256 - cgt; int beq = 0;
        for (int j = 0; j < nj; ++j) {
            const unsigned kj = keyl[j * 64 + lane];
            const bool gt = kj > thr, eq = kj == thr;
            const unsigned long long meq = __ballot(eq); const int rank = beq + __popcll(meq & lt); beq += __popcll(meq);
            const bool sel = gt || (eq && rank < need);
            const unsigned long long ms = __ballot(sel); if (sel) list[nsel + __popcll(ms & lt)] = j * 64 + lane; nsel += __popcll(ms);
        }
    }
    LDS_WAIT(); __builtin_amdgcn_wave_barrier();
#pragma unroll 1
    for (int i = 0; i < 4; ++i) { const int e = lane + 64 * i; const bool valid = e < nsel; const int s = valid ? list[e] : 0;
        const uint4* kp = (const uint4*)(KV + (row0 + s) * 128);
        float kf[64];
#pragma unroll
        for (int ch = 0; ch < 8; ++ch) unpack8(kp[ch], kf + ch * 8);
#pragma unroll 1
        for (int hh = 0; hh < 8; ++hh) { float d = 0.f;
#pragma unroll
            for (int dd = 0; dd < 64; ++dd) d += q_s[hh * 64 + dd] * kf[dd];
            Pm[e * 8 + hh] = valid ? d : -INFINITY; } }
    LDS_WAIT(); __builtin_amdgcn_wave_barrier();
#pragma unroll 1
    for (int hh = 0; hh < 8; ++hh) { float p[4]; float m = -INFINITY;
#pragma unroll
        for (int i = 0; i < 4; ++i) { p[i] = Pm[(lane + 64 * i) * 8 + hh]; m = fmaxf(m, p[i]); }
        m = wave_max(m); float sm = 0.f;
#pragma unroll
        for (int i = 0; i < 4; ++i) { p[i] = __expf(p[i] - m); sm += p[i]; }
        sm = wave_sum(sm); const float inv = 1.f / sm;
#pragma unroll
        for (int i = 0; i < 4; ++i) Pm[(lane + 64 * i) * 8 + hh] = p[i] * inv; }
    LDS_WAIT(); __builtin_amdgcn_wave_barrier();
    const int hh = lane >> 3, db = (lane & 7) * 8; float o[8];
#pragma unroll
    for (int e = 0; e < 8; ++e) o[e] = 0.f;
    for (int e = 0; e < nsel; ++e) { const int s = list[e]; const float p = Pm[e * 8 + hh]; float f[8]; unpack8(*(const uint4*)(KV + (row0 + s) * 128 + 64 + db), f);
#pragma unroll
        for (int k = 0; k < 8; ++k) o[k] += p * f[k]; }
    uint4 w; w.x = pk2(o[0], o[1]); w.y = pk2(o[2], o[3]); w.z = pk2(o[4], o[5]); w.w = pk2(o[6], o[7]);
    *(uint4*)(OB + (size_t)tokl * 512 + hh * 64 + db) = w;
}
__device__ __forceinline__ int row16_sum(int v) {
    v += __builtin_amdgcn_update_dpp(0, v, 0xB1, 0xf, 0xf, true);
    v += __builtin_amdgcn_update_dpp(0, v, 0x4E, 0xf, 0xf, true);
    v += __builtin_amdgcn_update_dpp(0, v, 0x141, 0xf, 0xf, true);
    v += __builtin_amdgcn_update_dpp(0, v, 0x140, 0xf, 0xf, true);
    return v;
}
__device__ __forceinline__ unsigned pk_gt_cnt8(unsigned cnt, const unsigned* h, unsigned cpk, unsigned onepk) {
    unsigned d0, d1, c1 = 0u;
    asm("v_pk_sub_u16 %1, %4, %12 clamp\n\tv_pk_sub_u16 %2, %5, %12 clamp\n\tv_pk_min_u16 %1, %1, %13\n\tv_pk_min_u16 %2, %2, %13\n\tv_pk_add_u16 %0, %0, %1\n\tv_pk_add_u16 %3, %3, %2\n\t"
        "v_pk_sub_u16 %1, %6, %12 clamp\n\tv_pk_sub_u16 %2, %7, %12 clamp\n\tv_pk_min_u16 %1, %1, %13\n\tv_pk_min_u16 %2, %2, %13\n\tv_pk_add_u16 %0, %0, %1\n\tv_pk_add_u16 %3, %3, %2\n\t"
        "v_pk_sub_u16 %1, %8, %12 clamp\n\tv_pk_sub_u16 %2, %9, %12 clamp\n\tv_pk_min_u16 %1, %1, %13\n\tv_pk_min_u16 %2, %2, %13\n\tv_pk_add_u16 %0, %0, %1\n\tv_pk_add_u16 %3, %3, %2\n\t"
        "v_pk_sub_u16 %1, %10, %12 clamp\n\tv_pk_sub_u16 %2, %11, %12 clamp\n\tv_pk_min_u16 %1, %1, %13\n\tv_pk_min_u16 %2, %2, %13\n\tv_pk_add_u16 %0, %0, %1\n\tv_pk_add_u16 %3, %3, %2"
        : "+v"(cnt), "=&v"(d0), "=&v"(d1), "+v"(c1)
        : "v"(h[0]), "v"(h[1]), "v"(h[2]), "v"(h[3]), "v"(h[4]), "v"(h[5]), "v"(h[6]), "v"(h[7]), "v"(cpk), "v"(onepk));
    unsigned r;
    asm("v_pk_add_u16 %0, %1, %2" : "=v"(r) : "v"(cnt), "v"(c1));
    return r;
}
__device__ __forceinline__ unsigned bfi_(unsigned m, unsigned x, unsigned y) { return (m & x) | (~m & y); }
__device__ __forceinline__ void bt32(unsigned (&A)[32]) {
#pragma unroll
    for (int k = 0; k < 32; ++k) if (!(k & 16)) { const unsigned a = A[k], b = A[k + 16]; A[k] = __builtin_amdgcn_perm(a, b, 0x07060302u); A[k + 16] = __builtin_amdgcn_perm(a, b, 0x05040100u); }
#pragma unroll
    for (int k = 0; k < 32; ++k) if (!(k & 8)) { const unsigned a = A[k], b = A[k + 8]; A[k] = __builtin_amdgcn_perm(a, b, 0x07030501u); A[k + 8] = __builtin_amdgcn_perm(a, b, 0x06020400u); }
#pragma unroll
    for (int k = 0; k < 32; ++k) if (!(k & 4)) { const unsigned a = A[k], b = A[k + 4]; A[k] = bfi_(0x0F0F0F0Fu, b >> 4, a); A[k + 4] = bfi_(0x0F0F0F0Fu, b, a << 4); }
#pragma unroll
    for (int k = 0; k < 32; ++k) if (!(k & 2)) { const unsigned a = A[k], b = A[k + 2]; A[k] = bfi_(0x33333333u, b >> 2, a); A[k + 2] = bfi_(0x33333333u, b, a << 2); }
#pragma unroll
    for (int k = 0; k < 32; ++k) if (!(k & 1)) { const unsigned a = A[k], b = A[k + 1]; A[k] = bfi_(0x55555555u, b >> 1, a); A[k + 1] = bfi_(0x55555555u, b, a << 1); }
}
template <int NW> __device__ __forceinline__ void dsa_bisect_bs(const unsigned* SC, int q, int sl, int hq, int nk, unsigned& thr_out, int& cgt_out) {
    unsigned T0[32], T1[32];
    const unsigned* kq = SC + q * 2048; const int rot = sl + 4 * q;
#pragma unroll
    for (int i = 0; i < 32; ++i) { T0[i] = (i < nk) ? kq[(i * 32 + rot) & 2047] : 0u; if (NW == 2) T1[i] = (32 + i < nk) ? kq[((32 + i) * 32 + rot) & 2047] : 0u; }
    bt32(T0); if (NW == 2) bt32(T1);
    unsigned M0 = ~0u, M1 = ~0u; int G = 0;
    unsigned thrA = 0u, thrB = 0u, tfA = 0u, tfB = 0u; bool doneA = false, doneB = false;
#pragma unroll
    for (int r = 0; r < 32; ++r) {
        const unsigned o0 = M0 & T0[r], o1 = (NW == 2) ? (M1 & T1[r]) : 0u;
        int c = __builtin_popcount(o0) + G; if (NW == 2) c += __builtin_popcount(o1);
        const int cs = row16_sum(c);
        const int cA = __builtin_amdgcn_readlane(cs, 0) + __builtin_amdgcn_readlane(cs, 16), cB = __builtin_amdgcn_readlane(cs, 32) + __builtin_amdgcn_readlane(cs, 48);
        const unsigned bit = 1u << (31 - r);
        const bool dA = cA >= 256, dB = cB >= 256;
        if (!doneA && cA == 256) { doneA = true; tfA = (thrA | bit) - 1u; }
        if (!doneB && cB == 256) { doneB = true; tfB = (thrB | bit) - 1u; }
        if (dA) thrA |= bit;
        if (dB) thrB |= bit;
        const bool dec = hq ? dB : dA;
        M0 = dec ? o0 : (M0 & ~T0[r]); if (NW == 2) M1 = dec ? o1 : (M1 & ~T1[r]);
        G = dec ? G : c;
        if (doneA && doneB) break;
    }
    const int gs = row16_sum(G);
    const int gA = __builtin_amdgcn_readlane(gs, 0) + __builtin_amdgcn_readlane(gs, 16), gB = __builtin_amdgcn_readlane(gs, 32) + __builtin_amdgcn_readlane(gs, 48);
    thr_out = hq ? (doneB ? tfB : thrB) : (doneA ? tfA : thrA);
    cgt_out = hq ? (doneB ? 256 : gB) : (doneA ? 256 : gA);
}
__device__ __forceinline__ int half_incl_scan(int v) {
    v += __builtin_amdgcn_update_dpp(0, v, 0x111, 0xf, 0xf, true);
    v += __builtin_amdgcn_update_dpp(0, v, 0x112, 0xf, 0xf, true);
    v += __builtin_amdgcn_update_dpp(0, v, 0x114, 0xf, 0xf, true);
    v += __builtin_amdgcn_update_dpp(0, v, 0x118, 0xf, 0xf, true);
    v += __builtin_amdgcn_update_dpp(0, v, 0x142, 0xa, 0xf, false);
    return v;
}
__device__ __forceinline__ unsigned top_bits(unsigned m, int k) { unsigned t = 0u; while (k > 0 && m) { const unsigned b = 0x80000000u >> __builtin_clz(m); t |= b; m &= ~b; --k; } return t; }
template <int NW> __device__ __forceinline__ void dsa_select_bs(const unsigned* SC, int q, int sl, int hq, int nk, unsigned& s0_out, unsigned& s1_out) {
    unsigned T0[32], T1[32];
    const unsigned* kq = SC + q * 2048; const int rot = sl + 4 * q;
#pragma unroll
    for (int i = 0; i < 32; ++i) { T0[i] = (i < nk) ? kq[(i * 32 + rot) & 2047] : 0u; if (NW == 2) T1[i] = (32 + i < nk) ? kq[((32 + i) * 32 + rot) & 2047] : 0u; }
    bt32(T0); if (NW == 2) bt32(T1);
    unsigned M0 = ~0u, M1 = (NW == 2) ? ~0u : 0u, G0 = 0u, G1 = 0u, S0 = 0u, S1 = 0u; int Gc = 0;
    bool doneA = false, doneB = false;
#pragma unroll
    for (int r = 0; r < 32; ++r) {
        const unsigned o0 = M0 & T0[r], o1 = (NW == 2) ? (M1 & T1[r]) : 0u;
        int c = __builtin_popcount(o0) + Gc; if (NW == 2) c += __builtin_popcount(o1);
        const int cs = row16_sum(c);
        const int cA = __builtin_amdgcn_readlane(cs, 0) + __builtin_amdgcn_readlane(cs, 16), cB = __builtin_amdgcn_readlane(cs, 32) + __builtin_amdgcn_readlane(cs, 48);
        const bool hitA = !doneA && cA == 256, hitB = !doneB && cB == 256;
        if (hitA || hitB) { if (hq ? hitB : hitA) { S0 = G0 | o0; S1 = G1 | o1; } }
        doneA = doneA || hitA; doneB = doneB || hitB;
        const unsigned X = (hq ? (cB >= 256) : (cA >= 256)) ? 0u : 0xFFFFFFFFu;
        G0 |= o0 & X; G1 |= o1 & X; Gc = X ? c : Gc;
        M0 &= T0[r] ^ X; if (NW == 2) M1 &= T1[r] ^ X;
        if (doneA && doneB) break;
    }
    if (!(doneA && doneB)) {
        const int gs = row16_sum(Gc);
        const int gA = __builtin_amdgcn_readlane(gs, 0) + __builtin_amdgcn_readlane(gs, 16), gB = __builtin_amdgcn_readlane(gs, 32) + __builtin_amdgcn_readlane(gs, 48);
        const int need = 256 - (hq ? gB : gA);
        const int m0 = __builtin_popcount(M0), m = m0 + __builtin_popcount(M1);
        const int before = half_incl_scan(m) - m;
        int k = need - before; k = k < 0 ? 0 : (k > m ? m : k);
        const int k0 = k < m0 ? k : m0;
        const unsigned t0 = top_bits(M0, k0), t1 = top_bits(M1, k - k0);
        if (!(hq ? doneB : doneA)) { S0 = G0 | t0; S1 = G1 | t1; }
    }
    s0_out = S0; s1_out = S1;
}
template <int NKS> __device__ __forceinline__ void dsa_bisect(const unsigned* SC, int q, int sl, int hq, int nk, unsigned& thr_out, int& cgt_out) {
    constexpr int NP = NKS / 2;
    unsigned one = 0x00010001u; asm volatile("" : "+v"(one));
    unsigned P[NP];
    const unsigned* kq = SC + q * 2048; const int rot = sl + 4 * q;
#pragma unroll
    for (int p = 0; p < NP; ++p) { const unsigned k0 = (2 * p < nk) ? kq[(2 * p * 32 + rot) & 2047] : 0u, k1 = (2 * p + 1 < nk) ? kq[((2 * p + 1) * 32 + rot) & 2047] : 0u;
        P[p] = (k0 >> 16) | (k1 & 0xffff0000u); }
#define DSA_COUNT(cpk_, outA, outB) do { unsigned c2_ = 0u; _Pragma("unroll") for (int p = 0; p < NP; p += 8) c2_ = pk_gt_cnt8(c2_, &P[p], (cpk_), one); \
        int c_ = (int)((c2_ & 0xffffu) + (c2_ >> 16)); c_ = row16_sum(c_); \
        outA = __builtin_amdgcn_readlane(c_, 0) + __builtin_amdgcn_readlane(c_, 16); outB = __builtin_amdgcn_readlane(c_, 32) + __builtin_amdgcn_readlane(c_, 48); } while (0)
    unsigned thi = 0u; int atA = 1 << 30, atB = 1 << 30;
#pragma unroll 1
    for (int bit = 15; bit >= 0; --bit) { const unsigned cand = thi | (1u << bit), cm1 = cand - 1u; int cA, cB;
        DSA_COUNT(cm1 * 0x10001u, cA, cB);
        if (cA >= 256) atA = cA; if (cB >= 256) atB = cB;
        if ((hq ? cB : cA) >= 256) thi = cand;
        if (atA == 256 && atB == 256) break; }
    int gA, gB; DSA_COUNT(thi * 0x10001u, gA, gB);
    const int needA = 256 - gA, needB = 256 - gB;
    const unsigned tsh = thi << 16;
#pragma unroll
    for (int p = 0; p < NP; ++p) { const unsigned k0 = (2 * p < nk) ? kq[(2 * p * 32 + rot) & 2047] : 0u, k1 = (2 * p + 1 < nk) ? kq[((2 * p + 1) * 32 + rot) & 2047] : 0u;
        const unsigned l0 = ((k0 ^ tsh) < 0x10000u && 2 * p < nk) ? (k0 & 0xffffu) : 0u, l1 = ((k1 ^ tsh) < 0x10000u && 2 * p + 1 < nk) ? (k1 << 16) : 0u;
        P[p] = l0 | l1; }
    unsigned tlo = 0u; int eA = 1 << 30, eB = 1 << 30;
#pragma unroll 1
    for (int bit = 15; bit >= 0; --bit) { const unsigned cand = tlo | (1u << bit), cm1 = cand - 1u; int cA, cB;
        DSA_COUNT(cm1 * 0x10001u, cA, cB);
        if (cA >= needA) eA = cA - needA; if (cB >= needB) eB = cB - needB;
        if ((hq ? (cB >= needB) : (cA >= needA))) tlo = cand;
        if (eA == 0 && eB == 0) break; }
    int hA, hB; DSA_COUNT(tlo * 0x10001u, hA, hB);
#undef DSA_COUNT
    thr_out = tsh | tlo; cgt_out = hq ? (gB + hB) : (gA + hA);
}
__device__ __forceinline__ bf16x8 lane_t16x4(const bf16x8 x, int srcaddr) {
    const u32x4 v = __builtin_bit_cast(u32x4, x); u32x4 r;
    r.x = (unsigned)__builtin_amdgcn_ds_bpermute(srcaddr, (int)v.x); r.y = (unsigned)__builtin_amdgcn_ds_bpermute(srcaddr, (int)v.y);
    r.z = (unsigned)__builtin_amdgcn_ds_bpermute(srcaddr, (int)v.z); r.w = (unsigned)__builtin_amdgcn_ds_bpermute(srcaddr, (int)v.w);
    return __builtin_bit_cast(bf16x8, r);
}
__device__ __forceinline__ void dsa_mfma_unit(Frame& F, const bf16_t* Z, const bf16_t* KV, const bf16_t* IKT, bf16_t* OB, int tok0) {
    const int lane = F.lane, w = F.wave;
    const int b = tok0 / SEQ, t0 = tok0 % SEQ, c = t0 >> 6, nadm = 64 * (c + 1); const size_t row0 = (size_t)b * SEQ;
    unsigned* SC = (unsigned*)F.lds;
    unsigned short* LST = (unsigned short*)(F.lds + RING_BYTES);
    int* NS = (int*)(F.lds + RING_BYTES + 8192);
    const int n16 = lane & 15, quad = lane >> 4;
    const int lrow = lane >> 2, lpc = lane & 3, tsrc = (n16 * 4 + quad) * 4;
    if (nadm > 256) {
        bf16x8 bq[4][2]; float wq[4];
        { const bf16_t* qrow = Z + (size_t)(tok0 + n16) * ZP + C_IQ + quad * 8;
#pragma unroll
          for (int h = 0; h < 4; ++h) { bq[h][0] = *(const bf16x8*)(qrow + h * 64); bq[h][1] = *(const bf16x8*)(qrow + h * 64 + 32); wq[h] = bf2f(Z[(size_t)(tok0 + n16) * ZP + C_IW + h]) * 0.5f; } }
        const int ntile = nadm >> 4, nks = nadm >> 5; const unsigned nkmagic = 0xFFFFFFFFu / (unsigned)nks + 1u;
#pragma unroll 1
        for (int tl0 = w; tl0 < ntile; tl0 += 32) {
            bf16x8 a0[4], a1[4];
#pragma unroll
            for (int u = 0; u < 4; ++u) { const int tl = tl0 + 8 * u; if (tl < ntile) { const bf16_t* kt_ = IKT + ((row0 >> 4) + tl) * 1024 + lane * 8; a0[u] = *(const bf16x8*)(kt_); a1[u] = *(const bf16x8*)(kt_ + 512); } }
#pragma unroll
            for (int u = 0; u < 4; ++u) { const int tl = tl0 + 8 * u; if (tl < ntile) {
                f32x4 isc = (f32x4){0.f, 0.f, 0.f, 0.f};
                const bf16x8 p0 = a0[u], p1 = a1[u];
#pragma unroll
                for (int h = 0; h < 4; ++h) { f32x4 acc = (f32x4){0.f, 0.f, 0.f, 0.f};
                    acc = __builtin_amdgcn_mfma_f32_16x16x32_bf16(p0, bq[h][0], acc, 0, 0, 0); acc = __builtin_amdgcn_mfma_f32_16x16x32_bf16(p1, bq[h][1], acc, 0, 0, 0);
#pragma unroll
                    for (int i = 0; i < 4; ++i) isc[i] += fmaxf(acc[i], 0.f) * wq[h]; }
                u32x4 keys;
#pragma unroll
                for (int i = 0; i < 4; ++i) { const float v = isc[i] + 0.0f; unsigned u_ = __builtin_bit_cast(unsigned, v); u_ ^= (u_ >> 31) ? 0xffffffffu : 0x80000000u; keys[i] = u_; }
                unsigned lp_ = __umulhi((unsigned)(tl * 16 + 4 * quad), nkmagic), ii_ = (unsigned)(tl * 16 + 4 * quad) - lp_ * (unsigned)nks;
#pragma unroll
                for (int i = 0; i < 4; ++i) { SC[n16 * 2048 + ((ii_ * 32u + lp_ + 4u * n16) & 2047u)] = keys[i]; ++ii_; if (ii_ == (unsigned)nks) { ii_ = 0u; ++lp_; } } } }
        }
    }
    __syncthreads();
    {
        const int hq = lane >> 5, sl = lane & 31, q = 2 * w + hq; int nsel = 0;
        if (nadm <= 256) { for (int i = sl; i < nadm; i += 32) LST[q * 256 + i] = (unsigned short)i; nsel = nadm; }
        else {
            const int nk = nadm >> 5; unsigned s0 = 0u, s1 = 0u;
            if (nk <= 32) dsa_select_bs<1>(SC, q, sl, hq, nk, s0, s1); else dsa_select_bs<2>(SC, q, sl, hq, nk, s0, s1);
            const int nl = __builtin_popcount(s0) + __builtin_popcount(s1); int pos = half_incl_scan(nl) - nl;
            unsigned short* lqw = LST + q * 256; const int kb = sl * nk;
            while (s0) { const int i = __builtin_clz(s0); lqw[pos++] = (unsigned short)(kb + i); s0 &= ~(0x80000000u >> i); }
            while (s1) { const int i = __builtin_clz(s1); lqw[pos++] = (unsigned short)(kb + 32 + i); s1 &= ~(0x80000000u >> i); }
            nsel = 256;
        }
        if (sl == 0) NS[q] = nsel;
    }
    __syncthreads();
    unsigned char* wl = F.lds + w * 10240;
    const unsigned wl3 = (unsigned)(uintptr_t)(LAS unsigned char*)wl;
    const int q4 = (lane >> 2) & 3, p4 = lane & 3;
    const unsigned trb = wl3 + (unsigned)((4 * quad + q4) * 144 + (4 * p4) * 2);
    const int vr = lane >> 3, vc = lane & 7;
    const char* kvb = (const char*)(KV + row0 * 128);
    bf16x8 ka0[8], ka1[8];
#define DSA_KLOADQ(LQ, NSEL, t0) do { _Pragma("unroll") for (int u = 0; u < 8; ++u) if (((t0) + u) * 16 < (NSEL)) { const unsigned ko = (unsigned)(LQ)[((t0) + u) * 16 + lrow] * 256u + (unsigned)lpc * 16u; ka0[u] = *(const bf16x8*)(kvb + ko); ka1[u] = *(const bf16x8*)(kvb + ko + 64u); } } while (0)
    DSA_KLOADQ(LST + (2 * w) * 256, NS[2 * w], 0);
#pragma unroll 1
    for (int qi = 0; qi < 2; ++qi) {
        const int qq = 2 * w + qi, tok = tok0 + qq, nsel = NS[qq];
        const unsigned short* lq = LST + qq * 256;
#define DSA_VLOAD(ch, R) do { const unsigned short* lp = lq + (ch) * 32 + vr; \
            R[0] = *(const u32x4*)(kvb + ((unsigned)lp[0] * 256u + 128u + (unsigned)vc * 16u)); R[1] = *(const u32x4*)(kvb + ((unsigned)lp[8] * 256u + 128u + (unsigned)vc * 16u)); \
            R[2] = *(const u32x4*)(kvb + ((unsigned)lp[16] * 256u + 128u + (unsigned)vc * 16u)); R[3] = *(const u32x4*)(kvb + ((unsigned)lp[24] * 256u + 128u + (unsigned)vc * 16u)); } while (0)
        bf16x8 qf0, qf1;
        { const bf16_t* qp = Z + (size_t)tok * ZP + C_SQ + (n16 & 7) * 64 + quad * 8; qf0 = *(const bf16x8*)(qp); qf1 = *(const bf16x8*)(qp + 32);
          if (n16 >= 8) { qf0 = (bf16x8){0, 0, 0, 0, 0, 0, 0, 0}; qf1 = qf0; } }
        float lg[16][4]; float mx = -INFINITY;
#define DSA_QK(t0) do { _Pragma("unroll") for (int u = 0; u < 8; ++u) { \
            if (((t0) + u) * 16 < nsel) { f32x4 acc = (f32x4){0.f, 0.f, 0.f, 0.f}; \
                acc = __builtin_amdgcn_mfma_f32_16x16x32_bf16(lane_t16x4(ka0[u], tsrc), qf0, acc, 0, 0, 0); acc = __builtin_amdgcn_mfma_f32_16x16x32_bf16(lane_t16x4(ka1[u], tsrc), qf1, acc, 0, 0, 0); \
                _Pragma("unroll") for (int i = 0; i < 4; ++i) { lg[(t0) + u][i] = acc[i] * 0.125f; mx = fmaxf(mx, lg[(t0) + u][i]); } } \
            else { _Pragma("unroll") for (int i = 0; i < 4; ++i) lg[(t0) + u][i] = -INFINITY; } } } while (0)
        DSA_QK(0);
        if (128 < nsel) DSA_KLOADQ(lq, nsel, 8);
        u32x4 vv[4][4];
        DSA_QK(8);
#undef DSA_QK
        if (qi == 0) DSA_KLOADQ(LST + (2 * w + 1) * 256, NS[2 * w + 1], 0);
#pragma unroll
        for (int ch = 0; ch < 4; ++ch) if (ch * 32 < nsel) DSA_VLOAD(ch, vv[ch]);
        mx = fmaxf(mx, __shfl_xor(mx, 16)); mx = fmaxf(mx, __shfl_xor(mx, 32));
        float sm = 0.f;
#pragma unroll
        for (int tl = 0; tl < 16; ++tl)
#pragma unroll
            for (int i = 0; i < 4; ++i) { lg[tl][i] = __expf(lg[tl][i] - mx); sm += lg[tl][i]; }
        sm += __shfl_xor(sm, 16); sm += __shfl_xor(sm, 32);
        const float inv = 1.f / sm;
        f32x4 o[4];
#pragma unroll
        for (int nb = 0; nb < 4; ++nb) o[nb] = (f32x4){0.f, 0.f, 0.f, 0.f};
#pragma unroll
        for (int ch = 0; ch < 8; ++ch) {
            if (ch * 32 < nsel) {
                { LAS unsigned char* w3 = (LAS unsigned char*)wl + (ch & 1) * 4608 + vr * 144 + vc * 16;
                  *(LAS u32x4*)(w3) = vv[ch & 3][0]; *(LAS u32x4*)(w3 + 8 * 144) = vv[ch & 3][1]; *(LAS u32x4*)(w3 + 16 * 144) = vv[ch & 3][2]; *(LAS u32x4*)(w3 + 24 * 144) = vv[ch & 3][3]; }
                if (ch + 4 < 8 && (ch + 4) * 32 < nsel) DSA_VLOAD(ch + 4, vv[ch & 3]);
                u32x4 pw;
                pw.x = pg8::cvt_pk_bf16(lg[2 * ch][0] * inv, lg[2 * ch][1] * inv); pw.y = pg8::cvt_pk_bf16(lg[2 * ch][2] * inv, lg[2 * ch][3] * inv);
                pw.z = pg8::cvt_pk_bf16(lg[2 * ch + 1][0] * inv, lg[2 * ch + 1][1] * inv); pw.w = pg8::cvt_pk_bf16(lg[2 * ch + 1][2] * inv, lg[2 * ch + 1][3] * inv);
                asm volatile("s_waitcnt lgkmcnt(0)" ::: "memory");
                const unsigned tb = trb + (ch & 1) * 4608;
#pragma unroll
                for (int nb = 0; nb < 4; ++nb) { const s16x4 va = tr_read(tb + nb * 32), vb = tr_read(tb + 16 * 144 + nb * 32);
                    o[nb] = __builtin_amdgcn_mfma_f32_16x16x32_bf16(__builtin_bit_cast(bf16x8, pw), (bf16x8){va[0], va[1], va[2], va[3], vb[0], vb[1], vb[2], vb[3]}, o[nb], 0, 0, 0); }
            }
        }
#undef DSA_VLOAD
        asm volatile("s_waitcnt lgkmcnt(0)" ::: "memory");
        if (quad < 2) { bf16_t* op = OB + (size_t)tok * 512 + n16;
#pragma unroll
            for (int nb = 0; nb < 4; ++nb)
#pragma unroll
                for (int i = 0; i < 4; ++i) op[(4 * quad + i) * 64 + nb * 16] = (bf16_t)f2bf(o[nb][i]); }
    }
#undef DSA_KLOADQ
}
__device__ __forceinline__ void phase_mixers(Frame& F, const bf16_t* Z, const bf16_t* KV, bf16_t* MIX, const float* lbl, const float* onorm, unsigned* wq, const float* p, bf16_t* PB, int Ts) {
    F.retid();
    const int NBq = Ts / SEQ; const int NH = NBq * 4, NDSA = Ts / 16, NSBU = NBq * 8 * 8, NPBU = Ts * (PLE / 8) / 4096, NU = NH + NDSA + NSBU + NPBU;
    bf16_t* OA = MIX; bf16_t* OB = MIX + (size_t)Ts * 512; bf16_t* OC = MIX + (size_t)2 * Ts * 512;
    for (;;) {
        __syncthreads();
        if (F.tid == 0) F.lctl[4] = atomicAdd(wq, 1u);
        __syncthreads();
        const int u = (int)F.lctl[4];
        if (u >= NU) break;
        F.retid();
        if (u < NH) { hgrn_mfma_unit(F, Z, OA, onorm, u >> 2, u & 3); }
        else if (u < NH + NDSA) { dsa_mfma_unit(F, Z, KV, KV + (size_t)Ts * 128, OB, (NDSA - 1 - (u - NH)) * 16); }
        else if (u < NH + NDSA + NSBU) { const int idx = u - NH - NDSA; const int qblk = 7 - (idx / (NBq * 8)), bh = idx % (NBq * 8); sb_mfma_wave(Z, OC, bh >> 3, bh & 7, qblk * 256 + F.wave * 32, F.lds + F.wave * 12288, F.lane); }
        else { const size_t i0 = (size_t)(u - NH - NDSA - NSBU) * 4096 + F.tid; f32x4 a[8], b[8];
#pragma unroll
            for (int k = 0; k < 8; ++k) { a[k] = *(const f32x4*)(p + (i0 + k * 512) * 8); b[k] = *(const f32x4*)(p + (i0 + k * 512) * 8 + 4); }
#pragma unroll
            for (int k = 0; k < 8; ++k) { uint4 o; o.x = pk2(a[k][0], a[k][1]); o.y = pk2(a[k][2], a[k][3]); o.z = pk2(b[k][0], b[k][1]); o.w = pk2(b[k][2], b[k][3]); *(uint4*)(PB + (i0 + k * 512) * 8) = o; } }
    }
}

struct MoeTab { int start[17]; };
__device__ __forceinline__ void moe_tab(MoeTab& T, const unsigned* cnt) {
    int s = 0;
#pragma unroll
    for (int g = 0; g < 16; ++g) { T.start[g] = s; s += ((int)__hip_atomic_load(cnt + g, __ATOMIC_RELAXED, __HIP_MEMORY_SCOPE_AGENT) + 255) >> 8; }
    T.start[16] = s;
}
__device__ __forceinline__ int moe_group_of(const MoeTab& T, int r) { int g = 0;
#pragma unroll
    for (int j = 1; j < 16; ++j) g += (r >= T.start[j]) ? 1 : 0;
    return g; }
struct MoeGuOrder { MoeTab T; int G, c; const int* rowtok;
    __device__ __forceinline__ int rowmap(int slot) const { return rowtok[slot]; }
    __device__ __forceinline__ bool next(int i, Unit& u) const { const int R = T.start[16]; const long L = (long)i * G + c; if (L >= (long)R * 22) return false;
        int r, pn; pg8::tile_of((int)L, R, 22, r, pn); const int e = moe_group_of(T, r) & 7; u.pm = r; u.pn = pn; u.ta = r; u.tb = e * 22 + pn; return true; } };
struct MoeDownOrder { MoeTab T; int G, c, rank;
    __device__ __forceinline__ bool next(int i, Unit& u) const { const int r0 = T.start[rank * 8], nr = T.start[rank * 8 + 8] - r0; const long L = (long)i * G + c; if (L >= (long)nr * 4) return false;
        int rr, pn; pg8::tile_of((int)L, nr, 4, rr, pn); const int r = r0 + rr, e = moe_group_of(T, r) & 7; u.pm = r; u.pn = pn; u.ta = r; u.tb = e * 4 + pn; return true; } };
struct MoeDownAllOrder { MoeTab T; int G, c;
    __device__ __forceinline__ bool next(int i, Unit& u) const { const int nr = T.start[16]; const long L = (long)i * G + c; if (L >= (long)nr * 4) return false;
        int r, pn; pg8::tile_of((int)L, nr, 4, r, pn); const int e = moe_group_of(T, r) & 7; u.pm = r; u.pn = pn; u.ta = r; u.tb = e * 4 + pn; return true; } };
struct MergeOrder { int nM, G, c;
    __device__ __forceinline__ bool next(int i, Unit& u) const { const int ib = i / 3, br = i % 3; const long L = (long)ib * G + c; if (L >= (long)nM * 4) return false;
        int pm, pn; pg8::tile_of((int)L, nM, 4, pm, pn); u.pm = pm; u.pn = br * 4 + pn; u.ta = br * nM + pm; u.tb = br * 4 + pn; return true; } };

__device__ __forceinline__ void phase_route(Frame& F, const bf16_t* H, const float* gffn, const float* router, int* tok_e, float* tok_w, float* tok_rstd, int* rowtok, unsigned* cnt, int Ts) {
    F.retid();
    const int gt = F.bid * NTHR + F.tid, NGT = F.og() * NTHR;
    for (int i = gt; i < 2 * Ts + 4096; i += NGT) rowtok[i] = -1;
    volatile LAS unsigned* lc = F.lctl + 16;
    if (F.tid < 16) lc[F.tid] = 0u;
    __syncthreads();
    float* rl = (float*)F.lds;
    { float rv[D * NE / NTHR];
#pragma unroll
      for (int j = 0; j < D * NE / NTHR; ++j) { const int i = F.tid + j * NTHR; rv[j] = router[i] * gffn[i >> 3]; }
#pragma unroll
      for (int j = 0; j < D * NE / NTHR; ++j) rl[F.tid + j * NTHR] = rv[j]; }
    __syncthreads();
    const int lo = (int)((long)Ts * F.bid / F.G), hi = (int)((long)Ts * (F.bid + 1) / F.G);
    for (int tok = lo + F.wave; tok < hi; tok += NWAVES) {
        const u32x2* hr = (const u32x2*)(H + (size_t)tok * D) + F.lane; f32x4 v[4]; float ss = 0.f;
#pragma unroll
        for (int j = 0; j < 4; ++j) { const u32x2 w_ = hr[64 * j]; v[j] = (f32x4){bflo(w_.x), bfhi(w_.x), bflo(w_.y), bfhi(w_.y)}; ss += (v[j][0] * v[j][0] + v[j][1] * v[j][1]) + (v[j][2] * v[j][2] + v[j][3] * v[j][3]); }
        const float rs = rsqrtf(wave_sum(ss) * (1.f / D) + EPS);
        float lgt[8];
#pragma unroll
        for (int e = 0; e < 8; ++e) lgt[e] = 0.f;
#pragma unroll
        for (int j = 0; j < 4; ++j)
#pragma unroll
            for (int q = 0; q < 4; ++q) { const int k = 256 * j + 4 * F.lane + q; const float x = v[j][q] * rs; const f32x4 r0 = *(const f32x4*)(rl + k * 8), r1 = *(const f32x4*)(rl + k * 8 + 4);
                lgt[0] += x * r0[0]; lgt[1] += x * r0[1]; lgt[2] += x * r0[2]; lgt[3] += x * r0[3]; lgt[4] += x * r1[0]; lgt[5] += x * r1[1]; lgt[6] += x * r1[2]; lgt[7] += x * r1[3]; }
#pragma unroll
        for (int e = 0; e < 8; ++e) lgt[e] = wave_sum(lgt[e]);
        int e0 = 0; float l0 = lgt[0];
#pragma unroll
        for (int e = 1; e < 8; ++e) if (lgt[e] > l0) { l0 = lgt[e]; e0 = e; }
        int e1 = -1; float l1 = -INFINITY;
#pragma unroll
        for (int e = 0; e < 8; ++e) if (e != e0 && lgt[e] > l1) { l1 = lgt[e]; e1 = e; }
        const float wa = 1.f / (1.f + __expf(l1 - l0));
        if (F.lane == 0) { tok_e[tok * 2] = e0; tok_e[tok * 2 + 1] = e1; tok_w[tok * 2] = wa; tok_w[tok * 2 + 1] = 1.f - wa; tok_rstd[tok] = rs;
            __hip_atomic_fetch_add((LAS unsigned*)(lc + e0), 1u, __ATOMIC_RELAXED, __HIP_MEMORY_SCOPE_WORKGROUP); __hip_atomic_fetch_add((LAS unsigned*)(lc + 8 + e1), 1u, __ATOMIC_RELAXED, __HIP_MEMORY_SCOPE_WORKGROUP); }
    }
    __syncthreads();
    if (F.tid < 16) { const unsigned n = lc[F.tid]; if (n) atomicAdd(cnt + F.tid, n); }
    __syncthreads();
}
__device__ __forceinline__ void phase_scatter(Frame& F, const bf16_t* HB, bf16_t* VP, const int* tok_e, const float* tok_w, const float* tok_rstd, int* rowtok, float* roww, float* rowrstd, unsigned* cnt, int Ts) {
    F.retid();
    MoeTab T; moe_tab(T, cnt);
    volatile LAS unsigned* lc = F.lctl + 16; volatile LAS unsigned* lb = F.lctl + 32;
    int* posl = (int*)F.lds;
    if (F.tid < 16) lc[F.tid] = 0u;
    __syncthreads();
    const int lo = (int)((long)Ts * F.bid / F.G), hi = (int)((long)Ts * (F.bid + 1) / F.G), n = hi - lo;
    int e0 = 0, e1 = 0, li0 = 0, li1 = 0;
    if (F.tid < n) { const int tok = lo + F.tid; e0 = tok_e[tok * 2]; e1 = tok_e[tok * 2 + 1];
        li0 = (int)__hip_atomic_fetch_add((LAS unsigned*)(lc + e0), 1u, __ATOMIC_RELAXED, __HIP_MEMORY_SCOPE_WORKGROUP); li1 = (int)__hip_atomic_fetch_add((LAS unsigned*)(lc + 8 + e1), 1u, __ATOMIC_RELAXED, __HIP_MEMORY_SCOPE_WORKGROUP); }
    __syncthreads();
    if (F.tid < 16) { const unsigned c = lc[F.tid]; int st = 0;
#pragma unroll
        for (int g = 0; g < 16; ++g) st = (F.tid == g) ? T.start[g] : st;
        lb[F.tid] = (unsigned)st * 256u + (c ? atomicAdd(cnt + 64 + F.tid, c) : 0u); }
    __syncthreads();
    if (F.tid < n) { const int tok = lo + F.tid; const int p0 = (int)lb[e0] + li0, p1 = (int)lb[8 + e1] + li1; const float rs = tok_rstd[tok];
        rowtok[p0] = tok; roww[p0] = tok_w[tok * 2]; rowrstd[p0] = rs; rowtok[p1] = tok; roww[p1] = tok_w[tok * 2 + 1]; rowrstd[p1] = rs; }
    __syncthreads();
    __syncthreads();
}

constexpr int WGM_INPROJ = 4, WGM_GU = 4;
constexpr int NPHL = 13;
__host__ __device__ inline bool phase_active(int k, int l) {
    if (k == 0) return l == 0;
    if (k >= 8 && k <= 10) return (l & 1) == 1;
    if (k == 12) return l == DEPTH - 1;
    return true;
}
struct Args { const float* in[23]; float* out; unsigned char* ws; int ph_lo, ph_hi, single, Ts; };

typedef const __attribute__((address_space(4))) Args* KArgs;
struct Ctx { unsigned char* ws; float* out; int Ts, nM; ActMap M; KArgs ap;
    __device__ __forceinline__ const float* in(int i) const { return ap->in[i]; } };
#define CTX() Ctx C; { KArgs ap_ = (KArgs)__builtin_amdgcn_kernarg_segment_ptr(); asm volatile("" : "+s"(ap_)); C.ap = ap_; C.ws = ap_->ws; C.out = ap_->out; C.Ts = ap_->Ts; C.nM = C.Ts / 256; C.M.init((size_t)C.Ts); }
#define WSP(T, off) ((T*)(C.ws + (off)))

__global__ void __launch_bounds__(NTHR, 2) fwd(Args a) {
    extern __shared__ __attribute__((aligned(16))) unsigned char lds_raw[];
    Frame F;
    F.lds = lds_raw; F.lds3 = (LAS unsigned char*)lds_raw; F.lctl = (volatile LAS unsigned*)(F.lds3 + LDSCTL_OFF);
    F.tid = threadIdx.x; F.lane = F.tid & 63; F.wave = __builtin_amdgcn_readfirstlane(F.tid >> 6); F.wave0 = F.wave; F.G = gridDim.x; F.bid = blockIdx.x;
    F.ws = a.ws; F.ctl = (unsigned*)(a.ws + WS_CTL);
    for (int u = F.tid; u < (LDS_BYTES - LDSCTL_OFF) / 4; u += NTHR) F.lctl[u] = 0u;
    __syncthreads();
    XcdBarrier bar; bar.bar = F.ctl + CW_BAR; bar.x = 0; bar.st = nullptr;
    if (a.single) bar = xcd_barrier_post(F.ctl + CW_BAR, F.lctl);
    const int lo = a.ph_lo, hi = a.ph_hi, single = a.single;
#define RUN(p) (lo <= (p) && (p) < hi)
#define SEAM(p) do { if (single && (p) + 1 < hi) xcd_barrier(bar, F.wave0); } while (0)
    const int NSB = BATCH * SEQ / a.Ts;

    if (RUN(0)) { phase_prologue(F, a.in); SEAM(0); }

    for (int sb = 0; sb < NSB; ++sb) {
        for (int l = 0; l < DEPTH; ++l) {
            const int pbase = 1 + (sb * DEPTH + l) * NPHL; const int sl = sb * DEPTH + l;
            if (pbase + NPHL <= lo || pbase >= hi) continue;
#define HPTR (C.out + (size_t)sb * C.Ts * D)
            if (l == 0 && RUN(pbase + 0)) { CTX(); phase_init(F, C.in(0) + (size_t)sb * C.Ts * D, WSP(bf16_t, C.M.hbn), WSP(float, C.M.ssq1), C.Ts); SEAM(pbase + 0); }
            if (RUN(pbase + 1)) { CTX();
                pg8::Gemm g{WSP(bf16_t, C.M.hbn), WSP(const bf16_t, WS_WIN + l * SZ_WIN), D}; pg8::PlainOrder S{C.nM, ZW / 256, F.G, F.bid, WGM_INPROJ}; EpiZ E{WSP(bf16_t, C.M.z), WSP(float, C.M.ssq1), WSP(float, WS_LB) + l * 512, WSP(bf16_t, C.M.z) + (size_t)C.Ts * ZP, WSP(bf16_t, C.M.kv) + (size_t)C.Ts * 128};
                pg8::gemm_phase(F.lds3, g, S, E, F.wave0); SEAM(pbase + 1); }
            if (RUN(pbase + 2)) { CTX(); phase_prep(F, WSP(bf16_t, C.M.z), WSP(bf16_t, C.M.kv), WSP(bf16_t, WS_WKV + l * SZ_WKV), C.in(1) + ((size_t)l * BATCH * SEQ + (size_t)sb * C.Ts) * PLE, WSP(bf16_t, C.M.pb), C.Ts); SEAM(pbase + 2); }
            if (RUN(pbase + 3)) { CTX(); phase_mixers(F, WSP(bf16_t, C.M.z), WSP(bf16_t, C.M.kv), WSP(bf16_t, C.M.mix), WSP(float, WS_LB) + l * 512, C.in(5) + l * 128, WSP(unsigned, WS_CTL) + CW_WQ + 64 * sl, C.in(1) + ((size_t)l * BATCH * SEQ + (size_t)sb * C.Ts) * PLE, WSP(bf16_t, C.M.pb), C.Ts); SEAM(pbase + 3); }
            if (RUN(pbase + 4)) { CTX();
                pg8::Gemm g{WSP(bf16_t, C.M.mix), WSP(const bf16_t, WS_WBR + l * SZ_WBR), 512}; MergeOrder S{C.nM, F.G, F.bid}; EpiMerge E{WSP(bf16_t, C.M.mg), WSP(bf16_t, C.M.z) + (size_t)C.Ts * ZP, WSP(bf16_t, C.M.hb)};
                pg8::gemm_phase(F.lds3, g, S, E, F.wave0); SEAM(pbase + 4); }
            if (RUN(pbase + 5)) { CTX();
                pg8::Gemm g{WSP(bf16_t, C.M.mg), WSP(const bf16_t, WS_WOUT + l * SZ_WOUT), D}; pg8::PlainOrder S{C.nM, 4, F.G, F.bid}; EpiRes E{WSP(bf16_t, C.M.hbn), WSP(bf16_t, C.M.hb), WSP(float, C.M.ssq)};
                pg8::gemm_phase(F.lds3, g, S, E, F.wave0); SEAM(pbase + 5); }
            if ((l & 1) == 0) {
                if (RUN(pbase + 6)) { CTX();
                    pg8::Gemm g{WSP(bf16_t, C.M.hb), WSP(const bf16_t, WS_WDGU + (l >> 1) * SZ_WGU), D}; pg8::PlainOrder S{C.nM, 22, F.G, F.bid, WGM_GU}; EpiGU E{WSP(bf16_t, C.M.z), WSP(float, C.M.ssq), nullptr};
                    pg8::gemm_phase(F.lds3, g, S, E, F.wave0); SEAM(pbase + 6); }
                if (RUN(pbase + 7)) { CTX();
                    pg8::Gemm g{WSP(bf16_t, C.M.z), WSP(const bf16_t, WS_WDD + (l >> 1) * SZ_WD), DFF}; pg8::PlainOrder S{C.nM, 4, F.G, F.bid}; EpiRes E{WSP(bf16_t, C.M.hb), WSP(bf16_t, C.M.hb), WSP(float, C.M.ssq)};
                    pg8::gemm_phase(F.lds3, g, S, E, F.wave0); SEAM(pbase + 7); }
            } else {
#define MCNT (WSP(unsigned, WS_CTL) + CW_MOE + 256 * sl)
                if (RUN(pbase + 6)) { CTX(); phase_route(F, WSP(bf16_t, C.M.hb), C.in(11) + l * D, C.in(15) + (size_t)(l >> 1) * D * NE, WSP(int, C.M.tok_e), WSP(float, C.M.tok_w), WSP(float, C.M.tok_rstd), WSP(int, C.M.rowtok), MCNT, C.Ts); SEAM(pbase + 6); }
                if (RUN(pbase + 7)) { CTX(); phase_scatter(F, WSP(bf16_t, C.M.hb), WSP(bf16_t, C.M.mix), WSP(int, C.M.tok_e), WSP(float, C.M.tok_w), WSP(float, C.M.tok_rstd), WSP(int, C.M.rowtok), WSP(float, C.M.roww), WSP(float, C.M.rowrstd), MCNT, C.Ts); SEAM(pbase + 7); }
                if (RUN(pbase + 8)) { CTX();
                    pg8::Gemm g{WSP(bf16_t, C.M.hb), WSP(const bf16_t, WS_WMGU + (size_t)(l >> 1) * 8 * SZ_WGU), D}; MoeGuOrder S; moe_tab(S.T, MCNT); S.G = F.G; S.c = F.bid; S.rowtok = WSP(int, C.M.rowtok); EpiGU E{WSP(bf16_t, C.M.z), nullptr, WSP(float, C.M.rowrstd)};
                    pg8::gemm_phase<EpiGU, MoeGuOrder, true, true, true>(F.lds3, g, S, E, F.wave0); SEAM(pbase + 8); }
                if (RUN(pbase + 9)) { CTX();
                    pg8::Gemm g{WSP(bf16_t, C.M.z), WSP(const bf16_t, WS_WMD + (size_t)(l >> 1) * 8 * SZ_WD), DFF}; MoeDownAllOrder S; moe_tab(S.T, MCNT); S.G = F.G; S.c = F.bid;
                    EpiMoeDownM E{WSP(bf16_t, C.M.hb), WSP(bf16_t, C.M.mg), WSP(int, C.M.rowtok), WSP(float, C.M.roww), S.T.start[8]};
                    pg8::gemm_phase(F.lds3, g, S, E, F.wave0); SEAM(pbase + 9); }
            }
            if ((l & 1) == 1) {
                if (RUN(pbase + 10)) { CTX(); pg8::Gemm g{WSP(bf16_t, C.M.pb), WSP(const bf16_t, WS_WPP + l * SZ_WPP), PLE}; pg8::PlainOrder S{C.nM, 4, F.G, F.bid};
                    EpiPpComb E{WSP(bf16_t, C.M.mix), WSP(bf16_t, C.M.hb), WSP(bf16_t, C.M.mg), WSP(float, C.M.ssq)}; pg8::gemm_phase(F.lds3, g, S, E, F.wave0); SEAM(pbase + 10); }
            }
            if (RUN(pbase + 11)) {
                if ((l & 1) == 0) { CTX(); pg8::Gemm g{WSP(bf16_t, C.M.pb), WSP(const bf16_t, WS_WPP + l * SZ_WPP), PLE}; pg8::PlainOrder S{C.nM, 4, F.G, F.bid}; EpiBf E{WSP(bf16_t, C.M.mix)}; pg8::gemm_phase(F.lds3, g, S, E, F.wave0); }
                { CTX(); pg8::Gemm g{WSP(bf16_t, C.M.hb), WSP(const bf16_t, WS_WPG + l * SZ_WOUT), D}; pg8::PlainOrder S{C.nM, 4, F.G, F.bid};
                  EpiPle E{WSP(bf16_t, C.M.hb), WSP(bf16_t, C.M.hbn), WSP(float, C.M.ssq1), WSP(float, C.M.ssq), WSP(bf16_t, C.M.mix)}; pg8::gemm_phase(F.lds3, g, S, E, F.wave0); }
                SEAM(pbase + 11); }
            if (l == DEPTH - 1 && RUN(pbase + 12)) { CTX(); phase_final(F, WSP(bf16_t, C.M.hbn), HPTR, C.in(22), C.Ts); SEAM(pbase + 12); }
        }
    }
#undef RUN
#undef SEAM
}

#ifndef MK_SINGLE
#define MK_SINGLE 1
#endif
extern "C" void kernel_launch(void* const* d_in, const int* in_sizes, int n_in, void* d_out, int out_size, void* d_ws, size_t ws_size, hipStream_t stream) {
    static int grid = 0, Ts = 0;
    if (grid == 0) {
        int dev = 0, cus = 0;
        if (hipGetDevice(&dev) != hipSuccess || hipDeviceGetAttribute(&cus, hipDeviceAttributeMultiprocessorCount, dev) != hipSuccess) { fprintf(stderr, "kernel_launch: device query failed\n"); grid = -1; return; }
        if (hipFuncSetAttribute((const void*)fwd, hipFuncAttributeMaxDynamicSharedMemorySize, LDS_BYTES) != hipSuccess) { fprintf(stderr, "kernel_launch: hipFuncSetAttribute failed\n"); grid = -1; return; }
        int per_cu = 0; (void)hipOccupancyMaxActiveBlocksPerMultiprocessor(&per_cu, (const void*)fwd, NTHR, LDS_BYTES); (void)hipGetLastError();
        const int nbs[3] = {16, 8, 4};
        for (int i = 0; i < 3 && !Ts; ++i) { ActMap M; M.init((size_t)nbs[i] * SEQ); if (M.end <= ws_size) Ts = nbs[i] * SEQ; }
        if (!Ts || n_in != 23 || per_cu < 1) { fprintf(stderr, "kernel_launch: unsupported (ws %zu, n_in %d, occupancy %d)\n", ws_size, n_in, per_cu); grid = -1; return; }
        grid = cus;
    }
    if (grid < 0) return;
    (void)hipMemsetAsync((char*)d_ws + WS_CTL, 0, CTL_BYTES, stream);
    Args a{};
    for (int i = 0; i < 23; ++i) a.in[i] = (const float*)d_in[i];
    a.out = (float*)d_out; a.ws = (unsigned char*)d_ws; a.Ts = Ts;
    const int NSB = BATCH * SEQ / Ts, NPH = 1 + NSB * DEPTH * NPHL;
#if MK_SINGLE
    a.ph_lo = 0; a.ph_hi = NPH; a.single = 1;
    hipLaunchKernelGGL(fwd, dim3(grid), dim3(NTHR), LDS_BYTES, stream, a);
#else
    a.single = 0;
    for (int ph = 0; ph < NPH; ++ph) {
        if (ph > 0) { const int r = (ph - 1) % (DEPTH * NPHL); if (!phase_active(r % NPHL, r / NPHL)) continue; }
        a.ph_lo = ph; a.ph_hi = ph + 1;
        hipLaunchKernelGGL(fwd, dim3(grid), dim3(NTHR), LDS_BYTES, stream, a);
    }
#endif
}
```

```cpp
#include <hip/hip_runtime.h>
#include <cstdio>
#include <cstdint>

#define LAS __attribute__((address_space(3)))
#define GAS __attribute__((address_space(1)))
typedef unsigned short bf16_t;
typedef short bf16x8 __attribute__((ext_vector_type(8)));
typedef float f32x4 __attribute__((ext_vector_type(4)));
typedef unsigned u32x4 __attribute__((ext_vector_type(4)));
typedef unsigned u32x2 __attribute__((ext_vector_type(2)));

constexpr int D = 1024, SEQ = 2048, BATCH = 32, DEPTH = 4;
constexpr int ZW = 7680, ZP = 4608;
constexpr int C_HQ = 0, C_HF = 512, C_HI = 1024, C_HG = 1536, C_SQ = 2048, C_SC = 2560, C_IQ = 2688, C_IK = 2944, C_BQ = 3008, C_BK = 3520, C_BV = 4032, C_IW = 4544, C_GZ = 4608;
constexpr int GZ_PN0 = C_GZ / 256;
constexpr int IN_W = 7620, DFF = 2816, NE = 8, PLE = 256;
constexpr float EPS = 1e-6f;
constexpr int NWAVES = 8, NTHR = 512;

constexpr size_t MiB = 1u << 20;
constexpr size_t WS_CTL = 0, CTL_BYTES = 1 * MiB;
constexpr int CW_BAR = 4096;
constexpr int CW_WQ = 8192;
constexpr int CW_MOE = 16384;
constexpr size_t SZ_WIN = (size_t)ZW * D * 2, SZ_WBR = (size_t)3 * D * 512 * 2, SZ_WOUT = (size_t)D * D * 2, SZ_WGU = (size_t)2 * DFF * D * 2, SZ_WD = (size_t)D * DFF * 2,
                 SZ_WPP = (size_t)D * PLE * 2, SZ_WKV = (size_t)128 * 128 * 2;
constexpr size_t WS_WIN = 1 * MiB;
constexpr size_t WS_WBR = WS_WIN + 4 * SZ_WIN;
constexpr size_t WS_WOUT = WS_WBR + 4 * SZ_WBR;
constexpr size_t WS_WDGU = WS_WOUT + 4 * SZ_WOUT;
constexpr size_t WS_WDD = WS_WDGU + 2 * SZ_WGU;
constexpr size_t WS_WMGU = WS_WDD + 2 * SZ_WD;
constexpr size_t WS_WMD = WS_WMGU + 16 * SZ_WGU;
constexpr size_t WS_WPG = WS_WMD + 16 * SZ_WD;
constexpr size_t WS_WPP = WS_WPG + 4 * SZ_WOUT;
constexpr size_t WS_WKV = WS_WPP + 4 * SZ_WPP;
constexpr size_t WS_LB = WS_WKV + 4 * SZ_WKV;
constexpr size_t WS_ACT = ((WS_LB + 4 * 512 * 4 + 4095) / 4096) * 4096;
struct ActMap {
    size_t hb, hbn, ssq, ssq1, z, kv, mix, mg, pb, tok_e, tok_w, tok_rstd, rowtok, roww, rowrstd, end;
    __host__ __device__ void init(size_t Ts) {
        size_t o = WS_ACT;
        hb = o; o += Ts * D * 2;
        hbn = o; o += Ts * D * 2;
        ssq = o; o += Ts * 16 * 4;
        ssq1 = o; o += Ts * 16 * 4;
        z = o; o += Ts * ZW * 2;
        kv = o; o += Ts * (128 + 64) * 2;
        mix = o; o += 3 * Ts * 512 * 2;
        mg = o; o += Ts * D * 2;
        pb = o; o += Ts * PLE * 2;
        tok_e = o; o += Ts * 2 * 4;
        tok_w = o; o += Ts * 2 * 4;
        tok_rstd = o; o += Ts * 4;
        rowtok = o; o += (2 * Ts + 4096) * 4;
        roww = o; o += (2 * Ts + 4096) * 4;
        rowrstd = o; o += (2 * Ts + 4096) * 4;
        end = o;
    }
};

__device__ __forceinline__ int lane_id() { return (int)__builtin_amdgcn_mbcnt_hi(~0u, __builtin_amdgcn_mbcnt_lo(~0u, 0u)); }
__device__ __forceinline__ unsigned f2bf(float f) { unsigned u = __builtin_bit_cast(unsigned, f); return (u + 0x7fffu + ((u >> 16) & 1u)) >> 16; }
__device__ __forceinline__ unsigned pk2(float lo, float hi) { return f2bf(lo) | (f2bf(hi) << 16); }
__device__ __forceinline__ float bflo(unsigned u) { return __builtin_bit_cast(float, u << 16); }
__device__ __forceinline__ float bfhi(unsigned u) { return __builtin_bit_cast(float, u & 0xffff0000u); }
__device__ __forceinline__ float bf2f(bf16_t b) { return __builtin_bit_cast(float, ((unsigned)b) << 16); }
__device__ __forceinline__ float wave_sum(float v) {
    v += __builtin_bit_cast(float, __builtin_amdgcn_update_dpp(0, __builtin_bit_cast(int, v), 0xB1, 0xf, 0xf, true));
    v += __builtin_bit_cast(float, __builtin_amdgcn_update_dpp(0, __builtin_bit_cast(int, v), 0x4E, 0xf, 0xf, true));
    v += __builtin_bit_cast(float, __builtin_amdgcn_update_dpp(0, __builtin_bit_cast(int, v), 0x141, 0xf, 0xf, true));
    v += __builtin_bit_cast(float, __builtin_amdgcn_update_dpp(0, __builtin_bit_cast(int, v), 0x140, 0xf, 0xf, true));
    const int iv = __builtin_bit_cast(int, v);
    const float r0 = __builtin_bit_cast(float, __builtin_amdgcn_readlane(iv, 0)), r1 = __builtin_bit_cast(float, __builtin_amdgcn_readlane(iv, 16));
    const float r2 = __builtin_bit_cast(float, __builtin_amdgcn_readlane(iv, 32)), r3 = __builtin_bit_cast(float, __builtin_amdgcn_readlane(iv, 48));
    return (r0 + r1) + (r2 + r3);
}
__device__ __forceinline__ float wave_max(float v) {
    int l = lane_id(); asm volatile("" : "+v"(l));
#pragma unroll
    for (int o = 1; o < 64; o <<= 1) v = fmaxf(v, __builtin_bit_cast(float, __builtin_amdgcn_ds_bpermute((l ^ o) << 2, __builtin_bit_cast(int, v))));
    return v;
}
__device__ __forceinline__ float sigmoidf_(float x) { return __builtin_amdgcn_rcpf(1.f + __expf(-x)); }
__device__ __forceinline__ float siluf_(float x) { return x * __builtin_amdgcn_rcpf(1.f + __expf(-x)); }
__device__ __forceinline__ void unpack8(const uint4 u, float* f) {
    f[0] = bflo(u.x); f[1] = bfhi(u.x); f[2] = bflo(u.y); f[3] = bfhi(u.y); f[4] = bflo(u.z); f[5] = bfhi(u.z); f[6] = bflo(u.w); f[7] = bfhi(u.w);
}

namespace pg8 {
constexpr int BM = 256, BK = 64, HALF = 128, HTB = HALF * BK * 2, STAGE_BYTES = 8 * HTB, NXCD = 8, WGM = 4;
__host__ __device__ __forceinline__ int lds_byte(int r, int c) { const int st = (r >> 4) * 2 + (c >> 5), rr = r & 15, cc = c & 31, ob = rr * 64 + cc * 2; return st * 1024 + (ob ^ (((ob >> 9) & 1) << 5)); }
__host__ __device__ __forceinline__ void stage_rc(int b, int& R, int& C) { const int st = b / 1024, sb = b % 1024, swz = sb ^ (((sb >> 9) & 1) << 5); R = (st >> 1) * 16 + swz / 64; C = (st & 1) * 32 + (swz % 64) / 2; }
__host__ __device__ __forceinline__ int perm32(int rho) { const int n = rho >> 4, i = rho & 15; return 8 * (i >> 2) + 4 * n + (i & 3); }

struct Unit { int pm, pn, ta, tb; };
struct Gemm { const bf16_t* A; const bf16_t* Bt; int K; };

__device__ __forceinline__ void tile_of(int L, int nM, int nN, int& pm, int& pn, int wgm = WGM) {
    const int nwg = nM * nN; int wgid = L;
    { const int q = nwg / NXCD, r = nwg % NXCD, xcd = wgid % NXCD, off = wgid / NXCD; wgid = (xcd < r ? xcd * (q + 1) : r * (q + 1) + (xcd - r) * q) + off; }
    const int nig = wgm * nN, gid = wgid / nig, fm = gid * wgm, gsz = (nM - fm) < wgm ? (nM - fm) : wgm;
    pm = fm + ((wgid % nig) % gsz); pn = (wgid % nig) / gsz;
}
struct PlainOrder {
    int nM, nN, G, c, wgm = WGM;
    __device__ __forceinline__ bool next(int i, Unit& u) const {
        const long L = (long)i * G + c; if (L >= (long)nM * nN) return false;
        tile_of((int)L, nM, nN, u.pm, u.pn, wgm); u.ta = u.pm; u.tb = u.pn; return true;
    }
};

typedef float f32x2_cv __attribute__((ext_vector_type(2))); typedef __bf16 bf16x2_cv __attribute__((ext_vector_type(2)));
__device__ __forceinline__ unsigned cvt_pk_bf16(float lo, float hi) { const f32x2_cv v = {lo, hi}; const bf16x2_cv b = __builtin_convertvector(v, bf16x2_cv); return __builtin_bit_cast(unsigned, b); }

template <class Epi, class Sched, bool ALIGN_EPI = true, bool SP2 = true, bool GATHER = false>
__device__ __forceinline__ void gemm_phase(LAS unsigned char* lds, const Gemm g, const Sched& S, const Epi& E, int wave_) {
    int tid_ = wave_ * 64 + lane_id(); asm volatile("" : "+v"(tid_));
    const int tid = tid_, wid = __builtin_amdgcn_readfirstlane(tid >> 6), lane = tid & 63, wr = wid >> 2, wc = wid & 3, fr = lane & 15, fq = lane >> 4;
    int K_ = g.K; asm volatile("" : "+s"(K_));
    const int K = K_, nt = K / BK;
    unsigned voffA[2], voffB[2];
#pragma unroll
    for (int i = 0; i < 2; ++i) { int R, C; stage_rc(tid * 16 + i * 8192, R, C); const int Rb = Epi::PERM ? ((R & ~31) + perm32(R & 31)) : R;
        voffA[i] = (unsigned)(R * K + C) * 2u; voffB[i] = (unsigned)(Rb * K + C) * 2u; }
    const size_t kstep = (size_t)(BK * 2);
    const size_t hstep = (size_t)HALF * K * 2;
    const size_t tstep = 2 * hstep;
    const unsigned ldsw = (unsigned)wid * 1024u;
    const int aoff = lds_byte(wr * 64 + fr, fq * 8), boff = lds_byte(wc * 32 + fr, fq * 8);
#define PG8_SA(b, h) (((b) * 2 + (h)) * HTB)
#define PG8_SB(b, h) ((4 + (b) * 2 + (h)) * HTB)
#define PG8_STAGE(bufoff, gbase, voff) do { _Pragma("unroll") for (int _i = 0; _i < 2; ++_i) \
        __builtin_amdgcn_global_load_lds((const unsigned*)((const char*)(gbase) + (voff)[_i]), (LAS unsigned*)(lds + (bufoff) + ldsw + _i * 8192), 16, 0, 0); } while (0)
#define PG8_LDA(dst, b, h) do { _Pragma("unroll") for (int m = 0; m < 4; ++m) _Pragma("unroll") for (int k = 0; k < 2; ++k) dst[m][k] = *(const LAS bf16x8*)(lds + PG8_SA(b, h) + aoff + m * 2048 + k * 1024); } while (0)
#define PG8_LDB(dst, b, h) do { _Pragma("unroll") for (int n = 0; n < 2; ++n) _Pragma("unroll") for (int k = 0; k < 2; ++k) dst[n][k] = *(const LAS bf16x8*)(lds + PG8_SB(b, h) + boff + n * 2048 + k * 1024); } while (0)
#define PG8_MMA(ai, bj, At, Bt) do { __builtin_amdgcn_s_setprio(1); _Pragma("unroll") for (int m = 0; m < 4; ++m) _Pragma("unroll") for (int n = 0; n < 2; ++n) _Pragma("unroll") for (int k = 0; k < 2; ++k) \
        acc[ai][bj][m][n] = __builtin_amdgcn_mfma_f32_16x16x32_bf16(Bt[n][k], At[m][k], acc[ai][bj][m][n], 0, 0, 0); __builtin_amdgcn_s_setprio(0); } while (0)
#define PG8_WAIT_V(n) asm volatile("s_waitcnt vmcnt(" #n ")" ::: "memory")
#define PG8_WAIT_L(n) asm volatile("s_waitcnt lgkmcnt(" #n ")" ::: "memory")
#define PG8_BAR __builtin_amdgcn_s_barrier()
#define PG8_SCHED __builtin_amdgcn_sched_barrier(0)
    static_assert(!GATHER || SP2, "row-gathered A staging is written for the two-super-phase loop");
    unsigned gc[2][2], gn[2][2];
#define PG8_GOFF(dst, U) do { if constexpr (GATHER) { _Pragma("unroll") for (int _h = 0; _h < 2; ++_h) _Pragma("unroll") for (int _i = 0; _i < 2; ++_i) { int R_, C_; stage_rc(tid * 16 + _i * 8192, R_, C_); \
        int rw_ = S.rowmap((U).ta * 256 + _h * 128 + R_); rw_ = rw_ < 0 ? 0 : rw_; dst[_h][_i] = (unsigned)(rw_ * K + C_) * 2u; } } } while (0)
#define PG8_STAGE_A(bufoff, gbase, half, usenext) do { if constexpr (GATHER) { unsigned vt_[2]; vt_[0] = (usenext) ? gn[half][0] : gc[half][0]; vt_[1] = (usenext) ? gn[half][1] : gc[half][1]; PG8_STAGE(bufoff, gbase, vt_); } \
        else { PG8_STAGE(bufoff, (gbase) + (half) * hstep, voffA); } } while (0)
    Unit cur, nxt; int ui = 0;
    if (!S.next(0, cur)) return;
    PG8_GOFF(gc, cur);
    f32x4 acc[2][2][4][2];
#pragma unroll
    for (int a = 0; a < 2; ++a)
#pragma unroll
        for (int b = 0; b < 2; ++b)
#pragma unroll
            for (int m = 0; m < 4; ++m)
#pragma unroll
                for (int n = 0; n < 2; ++n) acc[a][b][m][n] = (f32x4){0.f, 0.f, 0.f, 0.f};
    bf16x8 At[4][2], B0[2][2], B1[2][2];
    const char* cA = (const char*)g.A + (GATHER ? (size_t)0 : (size_t)cur.ta * tstep); const char* cB = (const char*)g.Bt + (size_t)cur.tb * tstep;
    if constexpr (SP2) {
        PG8_STAGE(PG8_SB(0, 0), cB, voffB); PG8_STAGE(PG8_SB(0, 1), cB + hstep, voffB); PG8_STAGE_A(PG8_SA(0, 0), cA, 0, false); PG8_STAGE_A(PG8_SA(0, 1), cA, 1, false);
        if (wr == 1) PG8_BAR;
        PG8_WAIT_V(2); PG8_BAR;
        PG8_STAGE(PG8_SB(1, 0), cB + kstep, voffB); PG8_STAGE_A(PG8_SA(1, 0), cA + kstep, 0, false); PG8_STAGE(PG8_SB(1, 1), cB + hstep + kstep, voffB);
        PG8_WAIT_V(6); PG8_BAR;
    } else {
        PG8_STAGE(PG8_SB(0, 0), cB, voffB); PG8_STAGE(PG8_SA(0, 0), cA, voffA); PG8_STAGE(PG8_SB(0, 1), cB + hstep, voffB); PG8_STAGE(PG8_SA(0, 1), cA + hstep, voffA);
        if (wr == 1) PG8_BAR;
        PG8_WAIT_V(4); PG8_BAR;
        PG8_STAGE(PG8_SB(1, 0), cB + kstep, voffB); PG8_STAGE(PG8_SA(1, 0), cA + kstep, voffA); PG8_STAGE(PG8_SB(1, 1), cB + hstep + kstep, voffB);
        PG8_WAIT_V(6); PG8_BAR;
    }
    for (;;) {
        if constexpr (Epi::PRE) E.pre(cur, tid, ui);
        const bool has_next = S.next(ui + 1, nxt);
        const char* nA = (has_next && !GATHER) ? (const char*)g.A + (size_t)nxt.ta * tstep : cA; const char* nB = has_next ? (const char*)g.Bt + (size_t)nxt.tb * tstep : cB;
        if (has_next) PG8_GOFF(gn, nxt);
        for (int t = 0; t < nt; t += 2) {
            const bool last = (t == nt - 2);
            const char* a1 = cA + (size_t)(t + 1) * kstep;
            const char* a2 = last ? nA : cA + (size_t)(t + 2) * kstep; const char* b2 = last ? nB : cB + (size_t)(t + 2) * kstep;
            const char* a3 = a2 + kstep; const char* b3 = b2 + kstep;
            if constexpr (SP2) {
            const bool un_ = last && has_next;
            PG8_LDB(B0, 0, 0); PG8_LDB(B1, 0, 1); PG8_SCHED; PG8_LDA(At, 0, 0); PG8_STAGE_A(PG8_SA(1, 1), a1, 1, false);
            PG8_WAIT_V(8); PG8_WAIT_L(0); PG8_BAR; PG8_MMA(0, 0, At, B0); PG8_MMA(0, 1, At, B1); PG8_BAR; PG8_SCHED;
            PG8_LDA(At, 0, 1); PG8_STAGE(PG8_SB(0, 0), b2, voffB); PG8_STAGE(PG8_SB(0, 1), b2 + hstep, voffB); PG8_STAGE_A(PG8_SA(0, 0), a2, 0, un_);
            PG8_WAIT_V(8); PG8_WAIT_L(0); PG8_BAR; PG8_MMA(1, 0, At, B0); PG8_MMA(1, 1, At, B1); PG8_BAR; PG8_SCHED;
            PG8_LDB(B0, 1, 0); PG8_LDB(B1, 1, 1); PG8_SCHED; PG8_LDA(At, 1, 0); PG8_STAGE_A(PG8_SA(0, 1), a2, 1, un_);
            PG8_WAIT_V(8); PG8_WAIT_L(0); PG8_BAR; PG8_MMA(0, 0, At, B0); PG8_MMA(0, 1, At, B1); PG8_BAR; PG8_SCHED;
            PG8_LDA(At, 1, 1); PG8_STAGE(PG8_SB(1, 0), b3, voffB); PG8_STAGE(PG8_SB(1, 1), b3 + hstep, voffB); PG8_STAGE_A(PG8_SA(1, 0), a3, 0, un_);
            PG8_WAIT_V(8); PG8_WAIT_L(0); PG8_BAR; PG8_MMA(1, 0, At, B0); PG8_MMA(1, 1, At, B1); PG8_BAR; PG8_SCHED;
            } else {
            PG8_LDB(B0, 0, 0); PG8_SCHED; PG8_LDA(At, 0, 0); PG8_STAGE(PG8_SA(1, 1), a1 + hstep, voffA);
            PG8_WAIT_L(8); PG8_BAR; PG8_WAIT_L(0); PG8_MMA(0, 0, At, B0); PG8_BAR; PG8_SCHED;
            PG8_LDB(B1, 0, 1); PG8_STAGE(PG8_SB(0, 0), b2, voffB);
            PG8_BAR; PG8_WAIT_L(0); PG8_MMA(0, 1, At, B1); PG8_BAR;
            PG8_LDA(At, 0, 1); PG8_STAGE(PG8_SA(0, 0), a2, voffA);
            PG8_BAR; PG8_WAIT_L(0); PG8_MMA(1, 0, At, B0); PG8_BAR; PG8_SCHED;
            PG8_STAGE(PG8_SB(0, 1), b2 + hstep, voffB);
            PG8_WAIT_V(6); PG8_BAR; PG8_MMA(1, 1, At, B1); PG8_BAR;
            PG8_LDB(B0, 1, 0); PG8_SCHED; PG8_LDA(At, 1, 0); PG8_STAGE(PG8_SA(0, 1), a2 + hstep, voffA);
            PG8_WAIT_L(8); PG8_BAR; PG8_WAIT_L(0); PG8_MMA(0, 0, At, B0); PG8_BAR; PG8_SCHED;
            PG8_LDB(B1, 1, 1); PG8_STAGE(PG8_SB(1, 0), b3, voffB);
            PG8_BAR; PG8_WAIT_L(0); PG8_MMA(0, 1, At, B1); PG8_BAR;
            PG8_LDA(At, 1, 1); PG8_STAGE(PG8_SA(1, 0), a3, voffA);
            PG8_BAR; PG8_WAIT_L(0); PG8_MMA(1, 0, At, B0); PG8_BAR; PG8_SCHED;
            PG8_STAGE(PG8_SB(1, 1), b3 + hstep, voffB);
            PG8_WAIT_V(6); PG8_BAR; PG8_MMA(1, 1, At, B1); PG8_BAR;
            }
        }
        if constexpr (ALIGN_EPI) { if (wr == 0) PG8_BAR; }
        if constexpr (Epi::PRE) E(acc, cur, wr, wc, fr, fq, ui); else E(acc, cur, wr, wc, fr, fq);
        if (!has_next) break;
#pragma unroll
        for (int a = 0; a < 2; ++a)
#pragma unroll
            for (int b = 0; b < 2; ++b)
#pragma unroll
                for (int m = 0; m < 4; ++m)
#pragma unroll
                    for (int n = 0; n < 2; ++n) acc[a][b][m][n] = (f32x4){0.f, 0.f, 0.f, 0.f};
        cur = nxt; cA = nA; cB = nB; ++ui;
        if constexpr (GATHER) { _Pragma("unroll") for (int _h = 0; _h < 2; ++_h) _Pragma("unroll") for (int _i = 0; _i < 2; ++_i) gc[_h][_i] = gn[_h][_i]; }
        if constexpr (ALIGN_EPI) { if (wr == 1) PG8_BAR; }
    }
    PG8_WAIT_V(0);
    if constexpr (!ALIGN_EPI) { if (wr == 0) PG8_BAR; }
    PG8_BAR;
#undef PG8_SA
#undef PG8_SB
#undef PG8_STAGE
#undef PG8_STAGE_A
#undef PG8_GOFF
#undef PG8_LDA
#undef PG8_LDB
#undef PG8_MMA
#undef PG8_WAIT_V
#undef PG8_WAIT_L
#undef PG8_BAR
#undef PG8_SCHED
}
}

struct LaneT { int r, c, to_acc; };
__device__ __forceinline__ LaneT lane_t() { const int l = lane_id(); LaneT t; t.r = l >> 2; t.c = l & 3; t.to_acc = ((l & 15) * 4 + (l >> 4)) * 4; return t; }
__device__ __forceinline__ u32x4 bperm4(const u32x4 v, int src) { u32x4 r;
    r.x = (unsigned)__builtin_amdgcn_ds_bpermute(src, (int)v.x); r.y = (unsigned)__builtin_amdgcn_ds_bpermute(src, (int)v.y);
    r.z = (unsigned)__builtin_amdgcn_ds_bpermute(src, (int)v.z); r.w = (unsigned)__builtin_amdgcn_ds_bpermute(src, (int)v.w); return r; }
using pg8::Unit; using pg8::cvt_pk_bf16;
__device__ __forceinline__ float rstd_from4(const f32x4 a) { return rsqrtf(((a[0] + a[1]) + (a[2] + a[3])) * (1.0f / 1024.0f) + EPS); }
constexpr int SSQ_TAB_OFF = 131072 + 9216;
__device__ __forceinline__ u32x4 pack8(const f32x4 v0, const f32x4 v1) { u32x4 w; w.x = cvt_pk_bf16(v0[0], v0[1]); w.y = cvt_pk_bf16(v0[2], v0[3]); w.z = cvt_pk_bf16(v1[0], v1[1]); w.w = cvt_pk_bf16(v1[2], v1[3]); return w; }
__device__ __forceinline__ void unpack8v(const u32x4 w, f32x4& v0, f32x4& v1) { v0 = (f32x4){bflo(w.x), bfhi(w.x), bflo(w.y), bfhi(w.y)}; v1 = (f32x4){bflo(w.z), bfhi(w.z), bflo(w.w), bfhi(w.w)}; }
__device__ __forceinline__ f32x4 sig4(const f32x4 x) { return (f32x4){sigmoidf_(x[0]), sigmoidf_(x[1]), sigmoidf_(x[2]), sigmoidf_(x[3])}; }


__device__ __forceinline__ void ssq_tile_reduce(const float (&ss)[2][4], float* ssq_out, const int* rowtok, int pm, int pn, int wr, int wc, int fr, int fq) {
    LAS float* tab = (LAS float*)(uintptr_t)SSQ_TAB_OFF;
    if (fq == 0) {
#pragma unroll
        for (int ai = 0; ai < 2; ++ai)
#pragma unroll
            for (int m = 0; m < 4; ++m) tab[(ai * 128 + wr * 64 + m * 16 + fr) * 4 + wc] = ss[ai][m]; }
    asm volatile("s_waitcnt lgkmcnt(0)" ::: "memory"); __builtin_amdgcn_s_barrier(); asm volatile("" ::: "memory");
    const int r = (wr * 4 + wc) * 64 + fq * 16 + fr;
    if (r < 256) { const f32x4 p = *(const LAS f32x4*)(tab + r * 4); const float t = (p[0] + p[1]) + (p[2] + p[3]);
        if (rowtok) { const int tok = rowtok[pm * 256 + r]; if (tok >= 0) ssq_out[(size_t)tok * 4 + pn] = t; }
        else ssq_out[(size_t)(pm * 256 + r) * 4 + pn] = t; }
}
struct EpiZ {
    static constexpr bool PERM = true, PRE = true;
    bf16_t* Z; const float* ssq; const float* lbl; bf16_t* GZT; bf16_t* IKT;
    __device__ __forceinline__ void pre(const Unit& u, int tid, int ui) const {
        if (tid < 256) { const f32x4 p4 = *(const f32x4*)(ssq + (size_t)(u.pm * 256 + tid) * 4); ((LAS float*)(uintptr_t)SSQ_TAB_OFF)[(ui & 1) * 256 + tid] = rstd_from4(p4); }
    }
    __device__ __forceinline__ void operator()(const f32x4 (&acc)[2][2][4][2], const Unit& u, int wr, int wc, int fr, int fq, int ui) const {
        const int row0 = u.pm * 256 + wr * 64 + fr, col0 = u.pn * 256 + wc * 32 + 8 * fq;
        const LAS float* rtab = (const LAS float*)(uintptr_t)SSQ_TAB_OFF + (ui & 1) * 256 + wr * 64 + fr;
        const int kind = (u.pn < 2 || u.pn == 6 || u.pn == 7) ? 1 : ((u.pn == 2 || u.pn == 3) ? 2 : 0);
        const bool tiled = u.pn >= GZ_PN0;
        bf16_t* tb = GZT + ((size_t)(u.pm * 12 + (u.pn - GZ_PN0)) << 16) + ((wr * 4 + wc) * 64 + fq * 16 + fr) * 8;
        f32x4 lbv[2][2];
        if (kind == 2) {
#pragma unroll
            for (int bj = 0; bj < 2; ++bj) { lbv[bj][0] = *(const f32x4*)(lbl + col0 - 512 + bj * 128); lbv[bj][1] = *(const f32x4*)(lbl + col0 - 512 + bj * 128 + 4); } }
#pragma unroll
        for (int ai = 0; ai < 2; ++ai)
#pragma unroll
            for (int m = 0; m < 4; ++m) { const int row = row0 + ai * 128 + m * 16; const float rs = rtab[ai * 128 + m * 16]; bf16_t* rowp = Z + (size_t)row * ZP + col0;
#pragma unroll
                for (int bj = 0; bj < 2; ++bj) { f32x4 v0 = acc[ai][bj][m][0] * rs, v1 = acc[ai][bj][m][1] * rs;
                    if (kind == 1) {
#pragma unroll
                        for (int j = 0; j < 4; ++j) { v0[j] = v0[j] * __builtin_amdgcn_rcpf(1.f + __expf(-v0[j])); v1[j] = v1[j] * __builtin_amdgcn_rcpf(1.f + __expf(-v1[j])); } }
                    else if (kind == 2) {
#pragma unroll
                        for (int j = 0; j < 4; ++j) { const float l0 = lbv[bj][0][j], l1 = lbv[bj][1][j];
                            v0[j] = __logf(l0 + (1.f - l0) * __builtin_amdgcn_rcpf(1.f + __expf(-v0[j]))); v1[j] = __logf(l1 + (1.f - l1) * __builtin_amdgcn_rcpf(1.f + __expf(-v1[j]))); } }
                    bf16_t* dst = tiled ? tb + ((ai * 4 + m) * 2 + bj) * 4096 : rowp + bj * 128;
                    if (u.pn == C_IK / 256 && bj == 1 && wc < 2) dst = IKT + ((size_t)((u.pm * 16 + ai * 8 + wr * 4 + m) * 2 + wc) * 64 + fq * 16 + fr) * 8;
                    *(u32x4*)dst = pack8(v0, v1); } }
    }
};
struct EpiRes {
    static constexpr bool PERM = true, PRE = false;
    const bf16_t* HIN; bf16_t* HOUT; float* ssq;
    __device__ __forceinline__ void operator()(const f32x4 (&acc)[2][2][4][2], const Unit& u, int wr, int wc, int fr, int fq) const {
        const int row0 = u.pm * 256 + wr * 64 + fr, col0 = u.pn * 256 + wc * 32 + 8 * fq;
        const LaneT LT = lane_t(); float ssv[2][4];
#pragma unroll
        for (int ai = 0; ai < 2; ++ai) {
            u32x4 hv[4][2];
#pragma unroll
            for (int m = 0; m < 4; ++m)
#pragma unroll
                for (int bj = 0; bj < 2; ++bj) hv[m][bj] = *(const u32x4*)(HIN + (size_t)(row0 - fr + LT.r + ai * 128 + m * 16) * D + (col0 - 8 * fq + 8 * LT.c) + bj * 128);
#pragma unroll
            for (int m = 0; m < 4; ++m) { const int row = row0 + ai * 128 + m * 16; bf16_t* bp = HOUT + (size_t)row * D + col0; float ss = 0.f;
#pragma unroll
                for (int bj = 0; bj < 2; ++bj) { f32x4 v0, v1; unpack8v(bperm4(hv[m][bj], LT.to_acc), v0, v1); v0 += acc[ai][bj][m][0]; v1 += acc[ai][bj][m][1];
                    *(u32x4*)(bp + bj * 128) = pack8(v0, v1);
                    ss += (v0[0] * v0[0] + v0[1] * v0[1]) + (v0[2] * v0[2] + v0[3] * v0[3]) + (v1[0] * v1[0] + v1[1] * v1[1]) + (v1[2] * v1[2] + v1[3] * v1[3]); }
                ss += __shfl_xor(ss, 16); ss += __shfl_xor(ss, 32); ssv[ai][m] = ss; } }
        ssq_tile_reduce(ssv, ssq, nullptr, u.pm, u.pn, wr, wc, fr, fq);
    }
};
struct EpiGU {
    static constexpr bool PERM = true, PRE = true;
    bf16_t* HM; const float* ssq; const float* rowrstd;
    __device__ __forceinline__ void pre(const Unit& u, int tid, int ui) const {
        if (tid < 256) { float r_; if (rowrstd) r_ = rowrstd[u.pm * 256 + tid]; else r_ = rstd_from4(*(const f32x4*)(ssq + (size_t)(u.pm * 256 + tid) * 4));
            ((LAS float*)(uintptr_t)SSQ_TAB_OFF)[(ui & 1) * 256 + tid] = r_; }
    }
    __device__ __forceinline__ void operator()(const f32x4 (&acc)[2][2][4][2], const Unit& u, int wr, int wc, int fr, int fq, int ui) const {
        const int row0 = u.pm * 256 + wr * 64 + fr, col0 = u.pn * 128 + wc * 32 + 8 * fq;
        const LAS float* rtab = (const LAS float*)(uintptr_t)SSQ_TAB_OFF + (ui & 1) * 256 + wr * 64 + fr;
#pragma unroll
        for (int ai = 0; ai < 2; ++ai)
#pragma unroll
            for (int m = 0; m < 4; ++m) { const int row = row0 + ai * 128 + m * 16; const float rs = rtab[ai * 128 + m * 16];
                f32x4 o0, o1;
#pragma unroll
                for (int j = 0; j < 4; ++j) { const float g0 = acc[ai][0][m][0][j] * rs, g1 = acc[ai][0][m][1][j] * rs; o0[j] = siluf_(g0) * (acc[ai][1][m][0][j] * rs); o1[j] = siluf_(g1) * (acc[ai][1][m][1][j] * rs); }
                *(u32x4*)(HM + (size_t)row * DFF + col0) = pack8(o0, o1); }
    }
};
struct EpiMerge {
    static constexpr bool PERM = true, PRE = false;
    bf16_t* MG; const bf16_t* GZT; bf16_t* PT;
    __device__ __forceinline__ void operator()(const f32x4 (&acc)[2][2][4][2], const Unit& u, int wr, int wc, int fr, int fq) const {
        const int br = u.pn >> 2, pn = u.pn & 3;
        const int row0 = u.pm * 256 + wr * 64 + fr, col0 = pn * 256 + wc * 32 + 8 * fq, lo = ((wr * 4 + wc) * 64 + fq * 16 + fr) * 8;
        const bf16_t* gt = GZT + ((size_t)(u.pm * 12 + u.pn) << 16) + lo; bf16_t* pt = PT + ((size_t)(u.pm * 4 + pn) << 16) + lo;
#pragma unroll
        for (int ai = 0; ai < 2; ++ai) {
            u32x4 gv[4][2], pv[4][2];
#pragma unroll
            for (int m = 0; m < 4; ++m)
#pragma unroll
                for (int bj = 0; bj < 2; ++bj) gv[m][bj] = *(const u32x4*)(gt + ((ai * 4 + m) * 2 + bj) * 4096);
            if (br > 0) {
#pragma unroll
                for (int m = 0; m < 4; ++m)
#pragma unroll
                    for (int bj = 0; bj < 2; ++bj) pv[m][bj] = *(const u32x4*)(pt + ((ai * 4 + m) * 2 + bj) * 4096); }
#pragma unroll
            for (int m = 0; m < 4; ++m) { const int row = row0 + ai * 128 + m * 16; bf16_t* mp = MG + (size_t)row * D + col0;
#pragma unroll
                for (int bj = 0; bj < 2; ++bj) { f32x4 g0, g1; unpack8v(gv[m][bj], g0, g1);
                    f32x4 v0 = sig4(g0) * acc[ai][bj][m][0], v1 = sig4(g1) * acc[ai][bj][m][1];
                    if (br > 0) { f32x4 p0, p1; unpack8v(pv[m][bj], p0, p1); v0 += p0; v1 += p1; }
                    *(u32x4*)(br < 2 ? pt + ((ai * 4 + m) * 2 + bj) * 4096 : mp + bj * 128) = pack8(v0, v1); } } }
    }
};
struct EpiBf {
    static constexpr bool PERM = true, PRE = false;
    bf16_t* O;
    __device__ __forceinline__ void operator()(const f32x4 (&acc)[2][2][4][2], const Unit& u, int wr, int wc, int fr, int fq) const {
        bf16_t* ot = O + ((size_t)(u.pm * 4 + u.pn) << 16) + ((wr * 4 + wc) * 64 + fq * 16 + fr) * 8;
#pragma unroll
        for (int ai = 0; ai < 2; ++ai)
#pragma unroll
            for (int m = 0; m < 4; ++m)
#pragma unroll
                for (int bj = 0; bj < 2; ++bj) *(u32x4*)(ot + ((ai * 4 + m) * 2 + bj) * 4096) = pack8(acc[ai][bj][m][0], acc[ai][bj][m][1]);
    }
};
struct EpiPle {
    static constexpr bool PERM = true, PRE = false;
    const bf16_t* HIN; bf16_t* HOUT; float* ssq_out; const float* ssq_in; const bf16_t* PP;
    __device__ __forceinline__ void operator()(const f32x4 (&acc)[2][2][4][2], const Unit& u, int wr, int wc, int fr, int fq) const {
        const int row0 = u.pm * 256 + wr * 64 + fr, col0 = u.pn * 256 + wc * 32 + 8 * fq;
        const LaneT LT = lane_t(); const bf16_t* ppt = PP + ((size_t)(u.pm * 4 + u.pn) << 16) + ((wr * 4 + wc) * 64 + fq * 16 + fr) * 8;
        float rsv[2][4], ssv[2][4];
        { f32x4 part[2][4];
#pragma unroll
        for (int ai = 0; ai < 2; ++ai)
#pragma unroll
            for (int m = 0; m < 4; ++m) part[ai][m] = *(const f32x4*)(ssq_in + (size_t)(row0 + ai * 128 + m * 16) * 4);
#pragma unroll
        for (int ai = 0; ai < 2; ++ai)
#pragma unroll
            for (int m = 0; m < 4; ++m) rsv[ai][m] = rstd_from4(part[ai][m]); }
#pragma unroll
        for (int aim = 0; aim < 4; ++aim) { const int ai = aim >> 1, mb = (aim & 1) * 2;
            u32x4 qv[4][2], hv[4][2];
#pragma unroll
            for (int m = mb; m < mb + 2; ++m)
#pragma unroll
                for (int bj = 0; bj < 2; ++bj) { const size_t o = (size_t)(row0 + ai * 128 + m * 16) * D + col0 + bj * 128, ot_ = (size_t)(row0 - fr + LT.r + ai * 128 + m * 16) * D + (col0 - 8 * fq + 8 * LT.c) + bj * 128; qv[m][bj] = *(const u32x4*)(ppt + ((ai * 4 + m) * 2 + bj) * 4096); hv[m][bj] = *(const u32x4*)(HIN + ot_); (void)o; }
#pragma unroll
            for (int m = mb; m < mb + 2; ++m) { const int row = row0 + ai * 128 + m * 16; const float rs = rsv[ai][m];
                bf16_t* bp = HOUT + (size_t)row * D + col0; float ss = 0.f;
#pragma unroll
                for (int bj = 0; bj < 2; ++bj) { f32x4 p0, p1, v0, v1; unpack8v(qv[m][bj], p0, p1); unpack8v(bperm4(hv[m][bj], LT.to_acc), v0, v1);
                    v0 += sig4(acc[ai][bj][m][0] * rs) * p0; v1 += sig4(acc[ai][bj][m][1] * rs) * p1;
                    *(u32x4*)(bp + bj * 128) = pack8(v0, v1);
                    ss += (v0[0] * v0[0] + v0[1] * v0[1]) + (v0[2] * v0[2] + v0[3] * v0[3]) + (v1[0] * v1[0] + v1[1] * v1[1]) + (v1[2] * v1[2] + v1[3] * v1[3]); }
                ss += __shfl_xor(ss, 16); ss += __shfl_xor(ss, 32); ssv[ai][m] = ss; } }
        ssq_tile_reduce(ssv, ssq_out, nullptr, u.pm, u.pn, wr, wc, fr, fq);
    }
};
template <int RANK> struct EpiMoeDown {
    static constexpr bool PERM = true, PRE = false;
    bf16_t* HB; float* ssq; const int* rowtok; const float* roww;
    __device__ __forceinline__ void operator()(const f32x4 (&acc)[2][2][4][2], const Unit& u, int wr, int wc, int fr, int fq) const {
        const int row0 = u.pm * 256 + wr * 64 + fr, col0 = u.pn * 256 + wc * 32 + 8 * fq;
        int tk[2][4]; float ssv[2][4];
#pragma unroll
        for (int ai = 0; ai < 2; ++ai)
#pragma unroll
            for (int m = 0; m < 4; ++m) tk[ai][m] = rowtok[row0 + ai * 128 + m * 16];
#pragma unroll
        for (int ai = 0; ai < 2; ++ai) {
            u32x4 hv[4][2]; float wv[4];
#pragma unroll
            for (int m = 0; m < 4; ++m) { const int tok = tk[ai][m] < 0 ? 0 : tk[ai][m]; wv[m] = roww[row0 + ai * 128 + m * 16];
#pragma unroll
                for (int bj = 0; bj < 2; ++bj) hv[m][bj] = *(const u32x4*)(HB + (size_t)tok * D + col0 + bj * 128); }
#pragma unroll
            for (int m = 0; m < 4; ++m) { const int tok = tk[ai][m]; const float w = wv[m];
                float ss = 0.f;
                if (tok >= 0) { bf16_t* bp = HB + (size_t)tok * D + col0;
#pragma unroll
                    for (int bj = 0; bj < 2; ++bj) { f32x4 v0, v1; unpack8v(hv[m][bj], v0, v1); v0 += acc[ai][bj][m][0] * w; v1 += acc[ai][bj][m][1] * w;
                        *(u32x4*)(bp + bj * 128) = pack8(v0, v1);
                        if (RANK == 1) ss += (v0[0] * v0[0] + v0[1] * v0[1]) + (v0[2] * v0[2] + v0[3] * v0[3]) + (v1[0] * v1[0] + v1[1] * v1[1]) + (v1[2] * v1[2] + v1[3] * v1[3]); } }
                if (RANK == 1) { ss += __shfl_xor(ss, 16); ss += __shfl_xor(ss, 32); ssv[ai][m] = ss; } } }
        if (RANK == 1) ssq_tile_reduce(ssv, ssq, rowtok, u.pm, u.pn, wr, wc, fr, fq);
    }
};

struct EpiMoeDownM {
    static constexpr bool PERM = true, PRE = false;
    bf16_t* HB; bf16_t* Y1; const int* rowtok; const float* roww; int rsplit;
    __device__ __forceinline__ void operator()(const f32x4 (&acc)[2][2][4][2], const Unit& u, int wr, int wc, int fr, int fq) const {
        const int row0 = u.pm * 256 + wr * 64 + fr, col0 = u.pn * 256 + wc * 32 + 8 * fq;
        int tk[2][4];
#pragma unroll
        for (int ai = 0; ai < 2; ++ai)
#pragma unroll
            for (int m = 0; m < 4; ++m) tk[ai][m] = rowtok[row0 + ai * 128 + m * 16];
        if (u.pm < rsplit) { const LaneT LT = lane_t();
#pragma unroll
            for (int ai = 0; ai < 2; ++ai) {
                u32x4 hv[4][2]; float wv[4];
#pragma unroll
                for (int m = 0; m < 4; ++m) { int tok = rowtok[row0 - fr + LT.r + ai * 128 + m * 16]; tok = tok < 0 ? 0 : tok; wv[m] = roww[row0 + ai * 128 + m * 16];
#pragma unroll
                    for (int bj = 0; bj < 2; ++bj) hv[m][bj] = *(const u32x4*)(HB + (size_t)tok * D + (col0 - 8 * fq + 8 * LT.c) + bj * 128); }
#pragma unroll
                for (int m = 0; m < 4; ++m) { const int tok = tk[ai][m]; const float w = wv[m];
                    const u32x4 hvt[2] = {bperm4(hv[m][0], LT.to_acc), bperm4(hv[m][1], LT.to_acc)};
                    if (tok >= 0) { bf16_t* bp = HB + (size_t)tok * D + col0;
#pragma unroll
                        for (int bj = 0; bj < 2; ++bj) { f32x4 v0, v1; unpack8v(hvt[bj], v0, v1); v0 += acc[ai][bj][m][0] * w; v1 += acc[ai][bj][m][1] * w; *(u32x4*)(bp + bj * 128) = pack8(v0, v1); } } } }
        } else {
#pragma unroll
            for (int ai = 0; ai < 2; ++ai)
#pragma unroll
                for (int m = 0; m < 4; ++m) { const int tok = tk[ai][m]; const float w = roww[row0 + ai * 128 + m * 16];
                    if (tok >= 0) { bf16_t* yp = Y1 + (size_t)tok * D + col0;
#pragma unroll
                        for (int bj = 0; bj < 2; ++bj) *(u32x4*)(yp + bj * 128) = pack8(acc[ai][bj][m][0] * w, acc[ai][bj][m][1] * w); } }
        }
    }
};
struct EpiPpComb {
    static constexpr bool PERM = true, PRE = false;
    bf16_t* PP; bf16_t* HB; const bf16_t* Y1; float* ssq;
    __device__ __forceinline__ void operator()(const f32x4 (&acc)[2][2][4][2], const Unit& u, int wr, int wc, int fr, int fq) const {
        const int row0 = u.pm * 256 + wr * 64 + fr, col0 = u.pn * 256 + wc * 32 + 8 * fq;
        const LaneT LT = lane_t(); bf16_t* ot = PP + ((size_t)(u.pm * 4 + u.pn) << 16) + ((wr * 4 + wc) * 64 + fq * 16 + fr) * 8;
        float ssv[2][4];
#pragma unroll
        for (int ai = 0; ai < 2; ++ai) {
            u32x4 hv[4][2], yv[4][2];
#pragma unroll
            for (int m = 0; m < 4; ++m)
#pragma unroll
                for (int bj = 0; bj < 2; ++bj) { const size_t o = (size_t)(row0 - fr + LT.r + ai * 128 + m * 16) * D + (col0 - 8 * fq + 8 * LT.c) + bj * 128; hv[m][bj] = *(const u32x4*)(HB + o); yv[m][bj] = *(const u32x4*)(Y1 + o); }
#pragma unroll
            for (int m = 0; m < 4; ++m) { const int row = row0 + ai * 128 + m * 16; float ss = 0.f;
#pragma unroll
                for (int bj = 0; bj < 2; ++bj) { *(u32x4*)(ot + ((ai * 4 + m) * 2 + bj) * 4096) = pack8(acc[ai][bj][m][0], acc[ai][bj][m][1]);
                    f32x4 v0, v1, y0, y1; unpack8v(bperm4(hv[m][bj], LT.to_acc), v0, v1); unpack8v(bperm4(yv[m][bj], LT.to_acc), y0, y1); v0 += y0; v1 += y1;
                    *(u32x4*)(HB + (size_t)row * D + col0 + bj * 128) = pack8(v0, v1);
                    ss += (v0[0] * v0[0] + v0[1] * v0[1]) + (v0[2] * v0[2] + v0[3] * v0[3]) + (v1[0] * v1[0] + v1[1] * v1[1]) + (v1[2] * v1[2] + v1[3] * v1[3]); }
                ss += __shfl_xor(ss, 16); ss += __shfl_xor(ss, 32); ssv[ai][m] = ss; } }
        ssq_tile_reduce(ssv, ssq, nullptr, u.pm, u.pn, wr, wc, fr, fq);
    }
};

#define XB_TMO      128
#define XB_XCNT(j)  (256  + 64 * (j))
#define XB_XSUB(j)  (1280 + 64 * (j))
#define XB_XGEN(j)  (2304 + 64 * (j))
#define XB_TOP      3328
#define XB_TOPGEN   3392
#define XCD_BAR_WORDS 3456
#define XB_SPIN_CAP (1u << 20)

__device__ __forceinline__ unsigned xb_ld(unsigned* p)              { return __hip_atomic_load(p, __ATOMIC_RELAXED, __HIP_MEMORY_SCOPE_AGENT); }
__device__ __forceinline__ unsigned xb_add(unsigned* p, unsigned v) { return __hip_atomic_fetch_add(p, v, __ATOMIC_RELAXED, __HIP_MEMORY_SCOPE_AGENT); }
__device__ __forceinline__ unsigned xb_xcc_id() { return (unsigned)__builtin_amdgcn_s_getreg((3 << 11) | 20) & 0xFu; }
#define XB_SPIN(cond, bar) do { unsigned _sp = 0; while (cond) { __builtin_amdgcn_s_sleep(1); \
    if ((++_sp & 255u) == 0u) { if (xb_ld(&(bar)[XB_TMO])) break; if (_sp > XB_SPIN_CAP) { atomicAdd(&(bar)[XB_TMO], 1u); break; } } } } while (0)

struct XcdBarrier { unsigned* bar; unsigned x; volatile LAS unsigned* st; };

__device__ __forceinline__ XcdBarrier xcd_barrier_post(unsigned* bar, volatile LAS unsigned* st) {
    XcdBarrier b; b.bar = bar; b.x = xb_xcc_id(); b.st = st;
    if (threadIdx.x == 0) (void)xb_add(&bar[XB_XCNT(b.x)], 1u);
    return b;
}
__device__ __forceinline__ void xcd_barrier_complete(unsigned* bar, unsigned x, unsigned& nloc, unsigned& nx) {
    const unsigned G = gridDim.x * gridDim.y * gridDim.z;
    unsigned sum, cnt, mine, sp = 0u;
    for (;;) {
        sum = 0u; cnt = 0u; mine = 0u;
#pragma unroll
        for (unsigned j = 0; j < 16; ++j) { const unsigned c = xb_ld(&bar[XB_XCNT(j)]); sum += c; cnt += (c > 0u) ? 1u : 0u; mine = (j == x) ? c : mine; }
        if (sum == G) break;
        __builtin_amdgcn_s_sleep(1);
        if ((++sp & 255u) == 0u) { if (xb_ld(&bar[XB_TMO])) break; if (sp > XB_SPIN_CAP) { atomicAdd(&bar[XB_TMO], 1u); break; } }
    }
    nloc = mine > 0u ? mine : 1u; nx = cnt > 0u ? cnt : 1u;
}
__device__ __forceinline__ void xcd_barrier(const XcdBarrier& b, int wave_) {
    asm volatile("s_waitcnt vmcnt(0)" ::: "memory");
    __syncthreads();
    if (wave_ == 0 && lane_id() == 0) {
        unsigned* bar = b.bar;
        __builtin_amdgcn_s_waitcnt(0);
        unsigned nloc = b.st[0], nx = b.st[1];
        if (nloc == 0u) { xcd_barrier_complete(bar, b.x, nloc, nx); b.st[0] = nloc; b.st[1] = nx; }
        const unsigned old = xb_add(&bar[XB_XSUB(b.x)], 1u);
        const unsigned gen = old / nloc;
        if (old + 1u == (gen + 1u) * nloc) {
            __builtin_amdgcn_fence(__ATOMIC_RELEASE, "agent");
            asm volatile("s_waitcnt vmcnt(0)" ::: "memory");
            const unsigned og = xb_add(&bar[XB_TOP], 1u);
            const unsigned tg = og / nx;
            if (og + 1u == (tg + 1u) * nx) xb_add(&bar[XB_TOPGEN], 1u);
            else XB_SPIN(xb_ld(&bar[XB_TOPGEN]) == tg, bar);
            __builtin_amdgcn_fence(__ATOMIC_ACQUIRE, "agent");
            xb_add(&bar[XB_XGEN(b.x)], 1u);
            asm volatile("s_waitcnt vmcnt(0)" ::: "memory");
        } else {
            XB_SPIN(xb_ld(&bar[XB_XGEN(b.x)]) == gen, bar);
            __builtin_amdgcn_fence(__ATOMIC_ACQUIRE, "agent");
            asm volatile("s_waitcnt vmcnt(0)" ::: "memory");
        }
    }
    __syncthreads();
}

constexpr int RING_BYTES = 131072;
constexpr int LDS_BYTES = 147456;
constexpr int LDSCTL_OFF = LDS_BYTES - 1024;

struct Frame {
    unsigned char* lds; LAS unsigned char* lds3; volatile LAS unsigned* lctl;
    unsigned* ctl; unsigned char* ws;
    int tid, lane, wave, G, bid, wave0;
    __device__ __forceinline__ int og() const { int g = G; asm volatile("" : "+s"(g)); return g; }
    __device__ __forceinline__ void retid() { int t = wave0 * 64 + lane_id(); asm volatile("" : "+v"(t)); tid = t; lane = t & 63; wave = __builtin_amdgcn_readfirstlane(t >> 6); }
};
#define LDS_WAIT() asm volatile("s_waitcnt lgkmcnt(0)" ::: "memory")

__device__ __forceinline__ int conv_rowmap(int mode, int n) {
    if (mode == 1) return n < 3008 ? n : (n < 3012 ? C_IW + (n - 3008) : (n < 4548 ? n - 4 : n + 60));
    if (mode == 2) return 256 * (n >> 7) + (n & 127);
    if (mode == 3) return 256 * (n >> 7) + 128 + (n & 127);
    return n;
}
__device__ __forceinline__ void conv_item(const float* W, int K, int N, const float* ksc, bf16_t* WT, int mode, float* scr, int item, int lane) {
    const int nblk = (N + 31) / 32, kb = item / nblk, nb = item % nblk, k0 = 64 * kb, n0 = 32 * nb;
    const int c4 = (lane & 7) * 4, nl = n0 + c4; const bool nv = nl < N;
#pragma unroll
    for (int i = 0; i < 8; ++i) { const int kk = 8 * i + (lane >> 3); f32x4 v = (f32x4){0.f, 0.f, 0.f, 0.f};
        if (nv) { v = *(const f32x4*)(W + (size_t)(k0 + kk) * N + nl); if (ksc) v = v * ksc[k0 + kk]; }
        float* sp = scr + kk * 33 + c4; sp[0] = v[0]; sp[1] = v[1]; sp[2] = v[2]; sp[3] = v[3]; }
    LDS_WAIT(); __builtin_amdgcn_wave_barrier();
    const int c = lane & 7;
#pragma unroll
    for (int j = 0; j < 4; ++j) { const int n = (lane >> 3) + 8 * j; const int ng = n0 + n;
        if (ng < N) { const float* s = scr + (8 * c) * 33 + n; uint4 o; o.x = pk2(s[0 * 33], s[1 * 33]); o.y = pk2(s[2 * 33], s[3 * 33]); o.z = pk2(s[4 * 33], s[5 * 33]); o.w = pk2(s[6 * 33], s[7 * 33]);
            *(uint4*)(WT + (size_t)conv_rowmap(mode, ng) * K + k0 + 8 * c) = o; } }
    LDS_WAIT(); __builtin_amdgcn_wave_barrier();
}
template <class IN> __device__ __forceinline__ void phase_prologue(Frame& F, const IN in) {
    F.retid();
    float* scr = (float*)(F.lds + F.wave * 16384);
    const int gw = F.bid * NWAVES + F.wave, NGW = F.og() * NWAVES;
    constexpr int NT = 11;
    const int tcount[NT] = {4, 12, 4, 2, 2, 2, 16, 16, 16, 4, 4};
    const int titems[NT] = {16 * 239, 8 * 32, 16 * 32, 16 * 88, 16 * 88, 44 * 32, 16 * 88, 16 * 88, 44 * 32, 16 * 32, 4 * 32};
    int total = 0;
#pragma unroll
    for (int t = 0; t < NT; ++t) total += tcount[t] * titems[t];
    for (int it = gw; it < total; it += NGW) {
        int r = it, t = 0;
#pragma unroll
        for (int q = 0; q < NT - 1; ++q) { if (t == q && r >= tcount[q] * titems[q]) { r -= tcount[q] * titems[q]; t = q + 1; } }
        const int mi = r / titems[t], item = r % titems[t];
        const float* W; int K, N, mode = 0; const float* ksc = nullptr; bf16_t* WT;
        switch (t) {
        case 0: W = in[4] + (size_t)mi * D * IN_W; K = D; N = IN_W; ksc = in[3] + mi * D; WT = (bf16_t*)(F.ws + WS_WIN + mi * SZ_WIN); mode = 1; break;
        case 1: W = in[9] + (size_t)mi * 512 * D; K = 512; N = D; WT = (bf16_t*)(F.ws + WS_WBR + (size_t)mi * D * 512 * 2); break;
        case 2: W = in[10] + (size_t)mi * D * D; K = D; N = D; WT = (bf16_t*)(F.ws + WS_WOUT + mi * SZ_WOUT); break;
        case 3: W = in[12] + (size_t)mi * D * DFF; K = D; N = DFF; ksc = in[11] + (2 * mi) * D; WT = (bf16_t*)(F.ws + WS_WDGU + mi * SZ_WGU); mode = 2; break;
        case 4: W = in[13] + (size_t)mi * D * DFF; K = D; N = DFF; ksc = in[11] + (2 * mi) * D; WT = (bf16_t*)(F.ws + WS_WDGU + mi * SZ_WGU); mode = 3; break;
        case 5: W = in[14] + (size_t)mi * DFF * D; K = DFF; N = D; WT = (bf16_t*)(F.ws + WS_WDD + mi * SZ_WD); break;
        case 6: W = in[16] + (size_t)mi * D * DFF; K = D; N = DFF; ksc = in[11] + (2 * (mi >> 3) + 1) * D; WT = (bf16_t*)(F.ws + WS_WMGU + mi * SZ_WGU); mode = 2; break;
        case 7: W = in[17] + (size_t)mi * D * DFF; K = D; N = DFF; ksc = in[11] + (2 * (mi >> 3) + 1) * D; WT = (bf16_t*)(F.ws + WS_WMGU + mi * SZ_WGU); mode = 3; break;
        case 8: W = in[18] + (size_t)mi * DFF * D; K = DFF; N = D; WT = (bf16_t*)(F.ws + WS_WMD + mi * SZ_WD); break;
        case 9: W = in[20] + (size_t)mi * D * D; K = D; N = D; ksc = in[19] + mi * D; WT = (bf16_t*)(F.ws + WS_WPG + mi * SZ_WOUT); break;
        default: W = in[21] + (size_t)mi * PLE * D; K = PLE; N = D; WT = (bf16_t*)(F.ws + WS_WPP + mi * SZ_WPP); break;
        }
        conv_item(W, K, N, ksc, WT, mode, scr, item, F.lane);
    }
    const int gt = F.bid * NTHR + F.tid, NGT = F.og() * NTHR;
    bf16_t* wkv = (bf16_t*)(F.ws + WS_WKV);
    for (int i = gt; i < 4 * 128 * 128; i += NGT) { const int l = i >> 14, n = (i >> 7) & 127, j = i & 127;
        const float w = n < 64 ? in[7][((size_t)l * 128 + j) * 64 + n] : in[8][((size_t)l * 128 + j) * 64 + (n - 64)];
        wkv[i] = (bf16_t)f2bf(in[6][l * 128 + j] * w); }
    float* lb = (float*)(F.ws + WS_LB);
    for (int ch = gt; ch < 512; ch += NGT) { float v[4], mx = -1e30f;
#pragma unroll
        for (int l = 0; l < 4; ++l) { v[l] = in[2][l * 512 + ch]; mx = fmaxf(mx, v[l]); }
        float s = 0.f;
#pragma unroll
        for (int l = 0; l < 4; ++l) { v[l] = __expf(v[l] - mx); s += v[l]; }
        float c = 0.f; lb[ch] = 0.f;
#pragma unroll
        for (int l = 1; l < 4; ++l) { c += v[l] / s; lb[l * 512 + ch] = c; } }
}

__device__ __forceinline__ void phase_init(Frame& F, const float* x, bf16_t* HBN, float* ssq1, int Ts) {
    F.retid();
    const int gw = F.bid * NWAVES + F.wave, NGW = F.og() * NWAVES;
    for (int r = gw; r < Ts; r += NGW) {
        const f32x4* xr = (const f32x4*)(x + (size_t)r * D) + F.lane; u32x2* br = (u32x2*)(HBN + (size_t)r * D) + F.lane;
        float ss = 0.f;
#pragma unroll
        for (int j = 0; j < 4; ++j) { const f32x4 v = xr[64 * j]; u32x2 w; w.x = pk2(v[0], v[1]); w.y = pk2(v[2], v[3]); br[64 * j] = w; ss += (v[0] * v[0] + v[1] * v[1]) + (v[2] * v[2] + v[3] * v[3]); }
        ss = wave_sum(ss);
        if (F.lane < 4) ssq1[(size_t)r * 4 + F.lane] = F.lane == 0 ? ss : 0.f;
    }
}
__device__ __forceinline__ void phase_final(Frame& F, const bf16_t* HBN, float* OUT, const float* g, int Ts) {
    F.retid();
    const int gw = F.bid * NWAVES + F.wave, NGW = F.og() * NWAVES;
    for (int r = gw; r < Ts; r += NGW) {
        const u32x2* hr = (const u32x2*)(HBN + (size_t)r * D) + F.lane; f32x4* orow = (f32x4*)(OUT + (size_t)r * D) + F.lane; const f32x4* gr = (const f32x4*)g + F.lane; f32x4 v[4]; float ss = 0.f;
#pragma unroll
        for (int j = 0; j < 4; ++j) { const u32x2 w = hr[64 * j]; v[j] = (f32x4){bflo(w.x), bfhi(w.x), bflo(w.y), bfhi(w.y)}; ss += (v[j][0] * v[j][0] + v[j][1] * v[j][1]) + (v[j][2] * v[j][2] + v[j][3] * v[j][3]); }
        const float rs = rsqrtf(wave_sum(ss) * (1.f / D) + EPS);
#pragma unroll
        for (int j = 0; j < 4; ++j) orow[64 * j] = v[j] * rs * gr[64 * j];
    }
}
__device__ __forceinline__ void phase_prep(Frame& F, const bf16_t* Z, bf16_t* KV, const bf16_t* wkvt, const float* p, bf16_t* PB, int Ts) {
    F.retid();
    const int gw = F.bid * NWAVES + F.wave, NGW = F.og() * NWAVES; const int n16 = F.lane & 15, quad = F.lane >> 4;
    for (int tile = gw; tile < Ts / 16; tile += NGW) {
        const int tok = tile * 16 + n16;
        const bf16_t* zr = Z + (size_t)tok * ZP + C_SC + quad * 8;
        bf16x8 bf[4]; float ss = 0.f;
#pragma unroll
        for (int ks = 0; ks < 4; ++ks) { const u32x4 raw = *(const u32x4*)(zr + ks * 32); bf[ks] = __builtin_bit_cast(bf16x8, raw);
            const float a0 = bflo(raw.x), a1 = bfhi(raw.x), a2 = bflo(raw.y), a3 = bfhi(raw.y), a4 = bflo(raw.z), a5 = bfhi(raw.z), a6 = bflo(raw.w), a7 = bfhi(raw.w);
            ss += (a0 * a0 + a1 * a1) + (a2 * a2 + a3 * a3) + (a4 * a4 + a5 * a5) + (a6 * a6 + a7 * a7); }
        ss += __shfl_xor(ss, 16); ss += __shfl_xor(ss, 32);
        const float rs = rsqrtf(ss * (1.f / 128.f) + EPS);
#pragma unroll
        for (int nb = 0; nb < 8; ++nb) { f32x4 acc = (f32x4){0.f, 0.f, 0.f, 0.f};
            const bf16_t* wr_ = wkvt + (size_t)(16 * nb + n16) * 128 + quad * 8;
#pragma unroll
            for (int ks = 0; ks < 4; ++ks) acc = __builtin_amdgcn_mfma_f32_16x16x32_bf16(*(const bf16x8*)(wr_ + ks * 32), bf[ks], acc, 0, 0, 0);
            u32x2 pk; pk.x = pk2(acc[0] * rs, acc[1] * rs); pk.y = pk2(acc[2] * rs, acc[3] * rs);
            *(u32x2*)(KV + (size_t)tok * 128 + 16 * nb + 4 * quad) = pk; }
    }
    (void)p; (void)PB;
}

typedef float f32x16 __attribute__((ext_vector_type(16)));
typedef short s16x4 __attribute__((ext_vector_type(4)));
__device__ __forceinline__ s16x4 tr_read(unsigned addr) { return __builtin_bit_cast(s16x4, __builtin_amdgcn_ds_read_tr16_b64_v4i16((LAS s16x4*)(uintptr_t)addr)); }
__device__ __forceinline__ void hgrn_naive_unit(Frame& F, const bf16_t* Z, bf16_t* OA, const float* lbl, const float* onorm, int b, int h) {
    float* Qs = (float*)F.lds; float* Fs = Qs + 16 * 128; float* Vs = Fs + 16 * 128; float* OP = Vs + 16 * 128;
    const int dv = F.tid & 127, dkg = F.tid >> 7;
    float S[32];
#pragma unroll
    for (int i = 0; i < 32; ++i) S[i] = 0.f;
    const size_t row0 = (size_t)b * SEQ;
    for (int t0 = 0; t0 < SEQ; t0 += 16) {
        __syncthreads();
        for (int i = F.tid; i < 16 * 128; i += NTHR) { const int tt = i >> 7, ch = i & 127; const bf16_t* zr = Z + (row0 + t0 + tt) * ZP + h * 128 + ch;
            const float q = bf2f(zr[C_HQ]), fp = bf2f(zr[C_HF]), v = bf2f(zr[C_HI]); const float lb = lbl[h * 128 + ch];
            Qs[i] = siluf_(q); Fs[i] = lb + (1.f - lb) * sigmoidf_(fp); Vs[i] = v; }
        __syncthreads();
        for (int tt = 0; tt < 16; ++tt) {
            const float vv = Vs[tt * 128 + dv]; float po = 0.f;
            const float* fr_ = Fs + tt * 128 + dkg * 32; const float* qr_ = Qs + tt * 128 + dkg * 32;
#pragma unroll
            for (int i = 0; i < 32; ++i) { const float fi = fr_[i]; S[i] = fi * S[i] + (1.f - fi) * vv; po += S[i] * qr_[i]; }
            OP[(tt * 4 + dkg) * 128 + dv] = po;
        }
        __syncthreads();
#pragma unroll
        for (int k = 0; k < 2; ++k) { const int tt = 2 * F.wave + k;
            float o0 = 0.f, o1 = 0.f;
#pragma unroll
            for (int g = 0; g < 4; ++g) { o0 += OP[(tt * 4 + g) * 128 + F.lane]; o1 += OP[(tt * 4 + g) * 128 + 64 + F.lane]; }
            const float rs = rsqrtf(wave_sum(o0 * o0 + o1 * o1) * (1.f / 128.f) + EPS);
            const bf16_t* zg = Z + (row0 + t0 + tt) * ZP + C_HG + h * 128;
            bf16_t* oa = OA + (row0 + t0 + tt) * 512 + h * 128;
            oa[F.lane] = (bf16_t)f2bf(o0 * rs * onorm[F.lane] * siluf_(bf2f(zg[F.lane])));
            oa[64 + F.lane] = (bf16_t)f2bf(o1 * rs * onorm[64 + F.lane] * siluf_(bf2f(zg[64 + F.lane]))); }
    }
    __syncthreads();
}
__device__ __forceinline__ float row16_sumf(float v) {
    v += __builtin_bit_cast(float, __builtin_amdgcn_update_dpp(0, __builtin_bit_cast(int, v), 0xB1, 0xf, 0xf, true));
    v += __builtin_bit_cast(float, __builtin_amdgcn_update_dpp(0, __builtin_bit_cast(int, v), 0x4E, 0xf, 0xf, true));
    v += __builtin_bit_cast(float, __builtin_amdgcn_update_dpp(0, __builtin_bit_cast(int, v), 0x141, 0xf, 0xf, true));
    v += __builtin_bit_cast(float, __builtin_amdgcn_update_dpp(0, __builtin_bit_cast(int, v), 0x140, 0xf, 0xf, true));
    return v;
}
typedef short s16x4b __attribute__((ext_vector_type(4)));
__device__ __forceinline__ void hgrn_mfma_unit(Frame& F, const bf16_t* Z, bf16_t* OA, const float* onorm, int b, int h) {
    constexpr int RP = 272, PP = 144;
    constexpr int O_QT = 0, O_KT = 17408, O_KD = 34816, O_V = 53248, O_DEC = 70656, O_SSQ = 72704, O_OUT = 74752;
    LAS unsigned char* L = (LAS unsigned char*)F.lds;
    const int tid = F.tid, lane = F.lane, w = F.wave, n16 = lane & 15, quad = lane >> 4, q4 = (lane >> 2) & 3, p4 = lane & 3;
    const int d = tid & 127, I = tid >> 7;
    f32x4 S[8];
#pragma unroll
    for (int k = 0; k < 8; ++k) S[k] = (f32x4){0.f, 0.f, 0.f, 0.f};
    const size_t seq0 = (size_t)b * SEQ;
    const unsigned Lb = (unsigned)(uintptr_t)L;
    const float on = onorm[16 * w + n16];
    bf16_t rq[16], rf[16], rg[16]; u32x4 rv0, rv1;
    const bf16_t* zq = Z + (seq0 + 16 * I) * ZP + h * 128 + d;
    const bf16_t* zg = Z + (seq0 + 4 * quad) * ZP + C_HG + h * 128 + 16 * w + n16;
    const int vr0 = tid >> 4, vc0 = tid & 15;
    const bf16_t* zv = Z + (seq0 + vr0) * ZP + C_HI + h * 128 + vc0 * 8;
#define HG_PREFETCH(c) do { const size_t ro = (size_t)(c) * 64 * ZP; \
        _Pragma("unroll") for (int tt = 0; tt < 16; ++tt) { rq[tt] = zq[ro + (size_t)tt * ZP + C_HQ]; rf[tt] = zq[ro + (size_t)tt * ZP + C_HF]; } \
        _Pragma("unroll") for (int bi = 0; bi < 4; ++bi) _Pragma("unroll") for (int i = 0; i < 4; ++i) rg[bi * 4 + i] = zg[ro + (size_t)(16 * bi + i) * ZP]; \
        rv0 = *(const u32x4*)(zv + ro); rv1 = *(const u32x4*)(zv + ro + (size_t)32 * ZP); } while (0)
    HG_PREFETCH(0);
    for (int c = 0; c < SEQ / 64; ++c) {
        const size_t row = seq0 + (size_t)c * 64;
        __syncthreads();
        *(LAS u32x4*)(L + O_V + vr0 * RP + vc0 * 16) = rv0; *(LAS u32x4*)(L + O_V + (vr0 + 32) * RP + vc0 * 16) = rv1;
        float cl[16], qv[16], kv[16], gv[16]; float run = 0.f;
#pragma unroll
        for (int tt = 0; tt < 16; ++tt) { const float lf = bf2f(rf[tt]); run += lf; cl[tt] = run; kv[tt] = 1.f - __expf(lf); qv[tt] = bf2f(rq[tt]); gv[tt] = bf2f(rg[tt]); }
        const float eB = __expf(run);
        *(LAS float*)(L + O_DEC + (I * 128 + d) * 4) = eB;
        if (c + 1 < SEQ / 64) HG_PREFETCH(c + 1);
#pragma unroll
        for (int tt = 0; tt < 16; ++tt) { const int t = 16 * I + tt;
            *(LAS bf16_t*)(L + O_QT + t * RP + d * 2) = (bf16_t)f2bf(qv[tt] * __expf(cl[tt]));
            const float kk = kv[tt] * __expf(fminf(-cl[tt], 80.f));
            *(LAS bf16_t*)(L + O_KT + t * RP + d * 2) = (bf16_t)f2bf(kk);
            kv[tt] = kk * eB; }
#pragma unroll
        for (int g = 0; g < 4; ++g) { u32x2 pk; pk.x = pk2(kv[4 * g], kv[4 * g + 1]); pk.y = pk2(kv[4 * g + 2], kv[4 * g + 3]); *(LAS u32x2*)(L + O_KD + d * PP + (16 * I + 4 * g) * 2) = pk; }
        __syncthreads();
#pragma unroll 1
        for (int bi = 0; bi < 4; ++bi) {
            const LAS unsigned char* ap = L + O_KT + (16 * bi + n16) * RP + quad * 16;
            const LAS unsigned char* bp = L + O_QT + (16 * bi + n16) * RP + quad * 16;
            f32x4 acc = (f32x4){0.f, 0.f, 0.f, 0.f};
#pragma unroll
            for (int ks = 0; ks < 4; ++ks) acc = __builtin_amdgcn_mfma_f32_16x16x32_bf16(*(const LAS bf16x8*)(ap + ks * 64), *(const LAS bf16x8*)(bp + ks * 64), acc, 0, 0, 0);
#pragma unroll
            for (int i = 0; i < 4; ++i) if (4 * quad + i > n16) acc[i] = 0.f;
            u32x2 pk; pk.x = pg8::cvt_pk_bf16(acc[0], acc[1]); pk.y = pg8::cvt_pk_bf16(acc[2], acc[3]);
            const s16x4b pa = __builtin_bit_cast(s16x4b, pk);
            const s16x4b vfr = __builtin_bit_cast(s16x4b, tr_read(Lb + O_V + (unsigned)((16 * bi + 4 * quad + q4) * RP + (16 * w + 4 * p4) * 2)));
            const bf16x8 pa8 = (bf16x8){pa[0], pa[1], pa[2], pa[3], 0, 0, 0, 0}, vf8 = (bf16x8){vfr[0], vfr[1], vfr[2], vfr[3], vfr[0], vfr[1], vfr[2], vfr[3]};
            f32x4 oo = __builtin_amdgcn_mfma_f32_16x16x32_bf16(pa8, vf8, (f32x4){0.f, 0.f, 0.f, 0.f}, 0, 0, 0);
            const LAS unsigned char* qp = L + O_QT + (16 * bi + n16) * RP + quad * 8;
#pragma unroll
            for (int ks = 0; ks < 4; ++ks) { u32x4 pw; pw.x = pg8::cvt_pk_bf16(S[2 * ks][0], S[2 * ks][1]); pw.y = pg8::cvt_pk_bf16(S[2 * ks][2], S[2 * ks][3]);
                pw.z = pg8::cvt_pk_bf16(S[2 * ks + 1][0], S[2 * ks + 1][1]); pw.w = pg8::cvt_pk_bf16(S[2 * ks + 1][2], S[2 * ks + 1][3]);
                const u32x2 lo = *(const LAS u32x2*)(qp + ks * 64), hi = *(const LAS u32x2*)(qp + ks * 64 + 32);
                u32x4 av; av.x = lo.x; av.y = lo.y; av.z = hi.x; av.w = hi.y;
                oo = __builtin_amdgcn_mfma_f32_16x16x32_bf16(__builtin_bit_cast(bf16x8, av), __builtin_bit_cast(bf16x8, pw), oo, 0, 0, 0); }
            *(LAS f32x4*)(L + O_OUT + ((16 * w + n16) * 64 + 16 * bi + 4 * quad) * 4) = oo;
#pragma unroll
            for (int i = 0; i < 4; ++i) { const float ss = row16_sumf(oo[i] * oo[i]);
                if (n16 == 0) *(LAS float*)(L + O_SSQ + ((16 * bi + 4 * quad + i) * 8 + w) * 4) = ss; }
#pragma unroll
            for (int kb = 0; kb < 8; ++kb) {
                const f32x4 dec = *(const LAS f32x4*)(L + O_DEC + (bi * 128 + 16 * kb + 4 * quad) * 4);
                const s16x4b ka = *(const LAS s16x4b*)(L + O_KD + (16 * kb + n16) * PP + (16 * bi + 4 * quad) * 2);
                S[kb] = __builtin_amdgcn_mfma_f32_16x16x32_bf16((bf16x8){ka[0], ka[1], ka[2], ka[3], 0, 0, 0, 0}, vf8, S[kb] * dec, 0, 0, 0);
            }
        }
        __syncthreads();
#pragma unroll
        for (int bi = 0; bi < 4; ++bi) {
            const f32x4 oo = *(const LAS f32x4*)(L + O_OUT + ((16 * w + n16) * 64 + 16 * bi + 4 * quad) * 4);
#pragma unroll
            for (int i = 0; i < 4; ++i) { const int t = 16 * bi + 4 * quad + i;
                const f32x4 pa = *(const LAS f32x4*)(L + O_SSQ + t * 32), pb = *(const LAS f32x4*)(L + O_SSQ + t * 32 + 16);
                const float rs = rsqrtf((((pa[0] + pa[1]) + (pa[2] + pa[3])) + ((pb[0] + pb[1]) + (pb[2] + pb[3]))) * (1.f / 128.f) + EPS);
                OA[(row + t) * 512 + h * 128 + 16 * w + n16] = (bf16_t)f2bf(oo[i] * rs * on * gv[bi * 4 + i]); } }
    }
#undef HG_PREFETCH
    __syncthreads();
}
__device__ __forceinline__ void sb_naive_unit(Frame& F, const bf16_t* Z, bf16_t* OC, int b, int h, int qblk) {
    const int t = qblk * NTHR + F.tid; const size_t row0 = (size_t)b * SEQ;
    float q[64], o[64];
    { const uint4* qp = (const uint4*)(Z + (row0 + t) * ZP + C_BQ + h * 64);
#pragma unroll
      for (int c = 0; c < 8; ++c) { float f[8]; unpack8(qp[c], f);
#pragma unroll
          for (int e = 0; e < 8; ++e) { q[c * 8 + e] = f[e] * 0.125f; o[c * 8 + e] = 0.f; } } }
    float P = 1.f;
    for (int s = t - 1; s >= 0; --s) {
        if (P < 1e-30f) break;
        const uint4* kp = (const uint4*)(Z + (row0 + s) * ZP + C_BK + h * 64); const uint4* vp = (const uint4*)(Z + (row0 + s) * ZP + C_BV + h * 64);
        float dot = 0.f;
#pragma unroll
        for (int c = 0; c < 8; ++c) { float f[8]; unpack8(kp[c], f);
#pragma unroll
            for (int e = 0; e < 8; ++e) dot += q[c * 8 + e] * f[e]; }
        const float zc = fmaxf(dot, -80.f), ex = __expf(-zc), beta = 1.f / (1.f + ex), A = beta * P;
        P *= ex * beta;
#pragma unroll
        for (int c = 0; c < 8; ++c) { float f[8]; unpack8(vp[c], f);
#pragma unroll
            for (int e = 0; e < 8; ++e) o[c * 8 + e] += A * f[e]; }
    }
    uint4* op = (uint4*)(OC + (row0 + t) * 512 + h * 64);
#pragma unroll
    for (int c = 0; c < 8; ++c) { uint4 w; w.x = pk2(o[c * 8], o[c * 8 + 1]); w.y = pk2(o[c * 8 + 2], o[c * 8 + 3]); w.z = pk2(o[c * 8 + 4], o[c * 8 + 5]); w.w = pk2(o[c * 8 + 6], o[c * 8 + 7]); op[c] = w; }
}
__device__ __forceinline__ void sb_mfma_wave(const bf16_t* Z, bf16_t* OC, int b, int h, int t0, unsigned char* wl, int lane) {
    const int r32 = lane & 31, hi = lane >> 5; const size_t row0 = (size_t)b * SEQ;
    bf16x8 qr[4];
    { const bf16_t* qp = Z + (row0 + t0 + r32) * ZP + C_BQ + h * 64 + hi * 8;
#pragma unroll
      for (int d0 = 0; d0 < 4; ++d0) qr[d0] = *(const bf16x8*)(qp + d0 * 16); }
    const int kappa = 16 * ((r32 >> 2) & 1) + (r32 & 3) + 4 * (r32 >> 3);
    f32x16 o0, o1;
#pragma unroll
    for (int r = 0; r < 16; ++r) { o0[r] = 0.f; o1[r] = 0.f; }
    float C = 1.f; const float cneg = -0.125f * 1.4426950408889634f;
    const int vrow = lane >> 3, vcc = lane & 7;
    const int g = lane >> 4, q4 = (lane >> 2) & 3, p4 = lane & 3;
    const unsigned wl3 = (unsigned)(uintptr_t)(LAS unsigned char*)wl;
    const unsigned trbase = wl3 + (unsigned)((16 * (g >> 1) + q4) * 144 + (16 * (g & 1) + 4 * p4) * 2);
    const int ktd = t0 >> 5;
    for (int kt = ktd; kt >= 0; --kt) {
        const int s0 = kt * 32;
        const bf16_t* kp = Z + (row0 + s0 + kappa) * ZP + C_BK + h * 64 + hi * 8;
        bf16x8 kf[4];
#pragma unroll
        for (int d0 = 0; d0 < 4; ++d0) kf[d0] = *(const bf16x8*)(kp + d0 * 16);
        const bf16_t* vp = Z + (row0 + s0 + vrow) * ZP + C_BV + h * 64 + vcc * 8;
        const u32x4 vv0 = *(const u32x4*)(vp), vv1 = *(const u32x4*)(vp + (size_t)8 * ZP), vv2 = *(const u32x4*)(vp + (size_t)16 * ZP), vv3 = *(const u32x4*)(vp + (size_t)24 * ZP);
        { LAS unsigned char* w3 = (LAS unsigned char*)wl + vrow * 144 + vcc * 16;
          *(LAS u32x4*)(w3) = vv0; *(LAS u32x4*)(w3 + 8 * 144) = vv1; *(LAS u32x4*)(w3 + 16 * 144) = vv2; *(LAS u32x4*)(w3 + 24 * 144) = vv3; }
        f32x16 p;
#pragma unroll
        for (int r = 0; r < 16; ++r) p[r] = 0.f;
#pragma unroll
        for (int d0 = 0; d0 < 4; ++d0) p = __builtin_amdgcn_mfma_f32_32x32x16_bf16(kf[d0], qr[d0], p, 0, 0, 0);
        float A[16]; float run = 1.f;
#pragma unroll
        for (int r = 15; r >= 0; --r) {
            const float zz = fminf(p[r] * cneg, 115.f), e = __builtin_amdgcn_exp2f(zz); float bt = __builtin_amdgcn_rcpf(1.f + e), kp_ = e * bt;
            if (kt == ktd && (16 * hi + r >= r32)) { bt = 0.f; kp_ = 1.f; }
            A[r] = bt * run; run *= kp_;
        }
        const float other = __builtin_bit_cast(float, __builtin_amdgcn_ds_bpermute((lane ^ 32) << 2, __builtin_bit_cast(int, run)));
        const float cin = hi ? C : C * other;
        u32x4 pw0, pw1;
        pw0.x = pg8::cvt_pk_bf16(A[0] * cin, A[1] * cin); pw0.y = pg8::cvt_pk_bf16(A[2] * cin, A[3] * cin); pw0.z = pg8::cvt_pk_bf16(A[4] * cin, A[5] * cin); pw0.w = pg8::cvt_pk_bf16(A[6] * cin, A[7] * cin);
        pw1.x = pg8::cvt_pk_bf16(A[8] * cin, A[9] * cin); pw1.y = pg8::cvt_pk_bf16(A[10] * cin, A[11] * cin); pw1.z = pg8::cvt_pk_bf16(A[12] * cin, A[13] * cin); pw1.w = pg8::cvt_pk_bf16(A[14] * cin, A[15] * cin);
        C = C * run * other;
        asm volatile("s_waitcnt lgkmcnt(0)" ::: "memory");
        s16x4 v0a = tr_read(trbase), v0b = tr_read(trbase + 4 * 144), v1a = tr_read(trbase + 64), v1b = tr_read(trbase + 4 * 144 + 64);
        s16x4 v2a = tr_read(trbase + 8 * 144), v2b = tr_read(trbase + 12 * 144), v3a = tr_read(trbase + 8 * 144 + 64), v3b = tr_read(trbase + 12 * 144 + 64);
#define VF(a, b) (bf16x8){a[0], a[1], a[2], a[3], b[0], b[1], b[2], b[3]}
        o0 = __builtin_amdgcn_mfma_f32_32x32x16_bf16(__builtin_bit_cast(bf16x8, pw0), VF(v0a, v0b), o0, 0, 0, 0);
        o1 = __builtin_amdgcn_mfma_f32_32x32x16_bf16(__builtin_bit_cast(bf16x8, pw0), VF(v1a, v1b), o1, 0, 0, 0);
        o0 = __builtin_amdgcn_mfma_f32_32x32x16_bf16(__builtin_bit_cast(bf16x8, pw1), VF(v2a, v2b), o0, 0, 0, 0);
        o1 = __builtin_amdgcn_mfma_f32_32x32x16_bf16(__builtin_bit_cast(bf16x8, pw1), VF(v3a, v3b), o1, 0, 0, 0);
#undef VF
        asm volatile("s_waitcnt lgkmcnt(0)" ::: "memory");
        if (__all(C < 1e-30f)) break;
    }
    bf16_t* op = OC + (row0 + t0) * 512 + h * 64 + r32;
#pragma unroll
    for (int r = 0; r < 16; ++r) { const int q = (r & 3) + 8 * (r >> 2) + 4 * hi; op[(size_t)q * 512] = (bf16_t)f2bf(o0[r]); op[(size_t)q * 512 + 32] = (bf16_t)f2bf(o1[r]); }
}
__device__ __forceinline__ void dsa_naive_query(const bf16_t* Z, const bf16_t* KV, bf16_t* OB, int tokl, float* wl, int lane) {
    const int b = tokl / SEQ, t = tokl % SEQ, c = t >> 6, nj = c + 1; const size_t row0 = (size_t)b * SEQ;
    float* iq_s = wl; float* q_s = wl + 256; int* list = (int*)(wl + 768); float* Pm = wl + 1024;
    const bf16_t* zr = Z + (size_t)tokl * ZP;
    LDS_WAIT(); __builtin_amdgcn_wave_barrier();
#pragma unroll
    for (int i = 0; i < 4; ++i) iq_s[lane + 64 * i] = bf2f(zr[C_IQ + lane + 64 * i]);
#pragma unroll
    for (int i = 0; i < 8; ++i) q_s[lane + 64 * i] = bf2f(zr[C_SQ + lane + 64 * i]) * 0.125f;
    const float w0 = bf2f(zr[C_IW + 0]) * 0.5f, w1 = bf2f(zr[C_IW + 1]) * 0.5f, w2 = bf2f(zr[C_IW + 2]) * 0.5f, w3 = bf2f(zr[C_IW + 3]) * 0.5f;
    LDS_WAIT(); __builtin_amdgcn_wave_barrier();
    unsigned* keyl = (unsigned*)Pm;
    for (int j = 0; j < nj; ++j) {
        const uint4* kp = (const uint4*)(Z + (row0 + j * 64 + lane) * ZP + C_IK);
        float d0 = 0.f, d1 = 0.f, d2 = 0.f, d3 = 0.f;
#pragma unroll 1
        for (int ch = 0; ch < 8; ++ch) { float f[8]; unpack8(kp[ch], f);
#pragma unroll
            for (int e = 0; e < 8; ++e) { const int dd = ch * 8 + e; d0 += iq_s[dd] * f[e]; d1 += iq_s[64 + dd] * f[e]; d2 += iq_s[128 + dd] * f[e]; d3 += iq_s[192 + dd] * f[e]; } }
        float isc = fmaxf(d0, 0.f) * w0 + fmaxf(d1, 0.f) * w1 + fmaxf(d2, 0.f) * w2 + fmaxf(d3, 0.f) * w3; isc += 0.0f;
        unsigned u = __builtin_bit_cast(unsigned, isc); u ^= (u >> 31) ? 0xffffffffu : 0x80000000u; keyl[j * 64 + lane] = u;
    }
    LDS_WAIT(); __builtin_amdgcn_wave_barrier();
    const unsigned long long lt = (1ull << lane) - 1ull;
    int nsel = 0;
    if (nj <= 4) {
        for (int j = 0; j < nj; ++j) list[j * 64 + lane] = j * 64 + lane;
        nsel = nj * 64;
    } else {
        unsigned thr = 0u;
        for (int bit = 31; bit >= 0; --bit) { const unsigned cand = thr | (1u << bit); int cnt = 0;
            for (int j = 0; j < nj; ++j) cnt += __popcll(__ballot(keyl[j * 64 + lane] >= cand));
            if (cnt >= 256) thr = cand; }
        int cgt = 0;
        for (int j = 0; j < nj; ++j) cgt += __popcll(__ballot(keyl[j * 64 + lane] > thr));
        const int need = 256 - cgt; int beq = 0;
        for (int j = 0; j < nj; ++j) {
            const unsigned kj = keyl[j * 64 + lane];
            const bool gt = kj > thr, eq = kj == thr;
            const unsigned long long meq = __ballot(eq); const int rank = beq + __popcll(meq & lt); beq += __popcll(meq);
            const bool sel = gt || (eq && rank < need);
            const unsigned long long ms = __ballot(sel); if (sel) list[nsel + __popcll(ms & lt)] = j * 64 + lane; nsel += __popcll(ms);
        }
    }
    LDS_WAIT(); __builtin_amdgcn_wave_barrier();
#pragma unroll 1
    for (int i = 0; i < 4; ++i) { const int e = lane + 64 * i; const bool valid = e < nsel; const int s = valid ? list[e] : 0;
        const uint4* kp = (const uint4*)(KV + (row0 + s) * 128);
        float kf[64];
#pragma unroll
        for (int ch = 0; ch < 8; ++ch) unpack8(kp[ch], kf + ch * 8);
#pragma unroll 1
        for (int hh = 0; hh < 8; ++hh) { float d = 0.f;
#pragma unroll
            for (int dd = 0; dd < 64; ++dd) d += q_s[hh * 64 + dd] * kf[dd];
            Pm[e * 8 + hh] = valid ? d : -INFINITY; } }
    LDS_WAIT(); __builtin_amdgcn_wave_barrier();
#pragma unroll 1
    for (int hh = 0; hh < 8; ++hh) { float p[4]; float m = -INFINITY;
#pragma unroll
        for (int i = 0; i < 4; ++i) { p[i] = Pm[(lane + 64 * i) * 8 + hh]; m = fmaxf(m, p[i]); }
        m = wave_max(m); float sm = 0.f;
#pragma unroll
        for (int i = 0; i < 4; ++i) { p[i] = __expf(p[i] - m); sm += p[i]; }
        sm = wave_sum(sm); const float inv = 1.f / sm;
#pragma unroll
        for (int i = 0; i < 4; ++i) Pm[(lane + 64 * i) * 8 + hh] = p[i] * inv; }
    LDS_WAIT(); __builtin_amdgcn_wave_barrier();
    const int hh = lane >> 3, db = (lane & 7) * 8; float o[8];
#pragma unroll
    for (int e = 0; e < 8; ++e) o[e] = 0.f;
    for (int e = 0; e < nsel; ++e) { const int s = list[e]; const float p = Pm[e * 8 + hh]; float f[8]; unpack8(*(const uint4*)(KV + (row0 + s) * 128 + 64 + db), f);
#pragma unroll
        for (int k = 0; k < 8; ++k) o[k] += p * f[k]; }
    uint4 w; w.x = pk2(o[0], o[1]); w.y = pk2(o[2], o[3]); w.z = pk2(o[4], o[5]); w.w = pk2(o[6], o[7]);
    *(uint4*)(OB + (size_t)tokl * 512 + hh * 64 + db) = w;
}
__device__ __forceinline__ int row16_sum(int v) {
    v += __builtin_amdgcn_update_dpp(0, v, 0xB1, 0xf, 0xf, true);
    v += __builtin_amdgcn_update_dpp(0, v, 0x4E, 0xf, 0xf, true);
    v += __builtin_amdgcn_update_dpp(0, v, 0x141, 0xf, 0xf, true);
    v += __builtin_amdgcn_update_dpp(0, v, 0x140, 0xf, 0xf, true);
    return v;
}
__device__ __forceinline__ unsigned pk_gt_cnt8(unsigned cnt, const unsigned* h, unsigned cpk, unsigned onepk) {
    unsigned d0, d1, c1 = 0u;
    asm("v_pk_sub_u16 %1, %4, %12 clamp\n\tv_pk_sub_u16 %2, %5, %12 clamp\n\tv_pk_min_u16 %1, %1, %13\n\tv_pk_min_u16 %2, %2, %13\n\tv_pk_add_u16 %0, %0, %1\n\tv_pk_add_u16 %3, %3, %2\n\t"
        "v_pk_sub_u16 %1, %6, %12 clamp\n\tv_pk_sub_u16 %2, %7, %12 clamp\n\tv_pk_min_u16 %1, %1, %13\n\tv_pk_min_u16 %2, %2, %13\n\tv_pk_add_u16 %0, %0, %1\n\tv_pk_add_u16 %3, %3, %2\n\t"
        "v_pk_sub_u16 %1, %8, %12 clamp\n\tv_pk_sub_u16 %2, %9, %12 clamp\n\tv_pk_min_u16 %1, %1, %13\n\tv_pk_min_u16 %2, %2, %13\n\tv_pk_add_u16 %0, %0, %1\n\tv_pk_add_u16 %3, %3, %2\n\t"
        "v_pk_sub_u16 %1, %10, %12 clamp\n\tv_pk_sub_u16 %2, %11, %12 clamp\n\tv_pk_min_u16 %1, %1, %13\n\tv_pk_min_u16 %2, %2, %13\n\tv_pk_add_u16 %0, %0, %1\n\tv_pk_add_u16 %3, %3, %2"
        : "+v"(cnt), "=&v"(d0), "=&v"(d1), "+v"(c1)
        : "v"(h[0]), "v"(h[1]), "v"(h[2]), "v"(h[3]), "v"(h[4]), "v"(h[5]), "v"(h[6]), "v"(h[7]), "v"(cpk), "v"(onepk));
    unsigned r;
    asm("v_pk_add_u16 %0, %1, %2" : "=v"(r) : "v"(cnt), "v"(c1));
    return r;
}
__device__ __forceinline__ unsigned bfi_(unsigned m, unsigned x, unsigned y) { return (m & x) | (~m & y); }
__device__ __forceinline__ void bt32(unsigned (&A)[32]) {
#pragma unroll
    for (int k = 0; k < 32; ++k) if (!(k & 16)) { const unsigned a = A[k], b = A[k + 16]; A[k] = __builtin_amdgcn_perm(a, b, 0x07060302u); A[k + 16] = __builtin_amdgcn_perm(a, b, 0x05040100u); }
#pragma unroll
    for (int k = 0; k < 32; ++k) if (!(k & 8)) { const unsigned a = A[k], b = A[k + 8]; A[k] = __builtin_amdgcn_perm(a, b, 0x07030501u); A[k + 8] = __builtin_amdgcn_perm(a, b, 0x06020400u); }
#pragma unroll
    for (int k = 0; k < 32; ++k) if (!(k & 4)) { const unsigned a = A[k], b = A[k + 4]; A[k] = bfi_(0x0F0F0F0Fu, b >> 4, a); A[k + 4] = bfi_(0x0F0F0F0Fu, b, a << 4); }
#pragma unroll
    for (int k = 0; k < 32; ++k) if (!(k & 2)) { const unsigned a = A[k], b = A[k + 2]; A[k] = bfi_(0x33333333u, b >> 2, a); A[k + 2] = bfi_(0x33333333u, b, a << 2); }
#pragma unroll
    for (int k = 0; k < 32; ++k) if (!(k & 1)) { const unsigned a = A[k], b = A[k + 1]; A[k] = bfi_(0x55555555u, b >> 1, a); A[k + 1] = bfi_(0x55555555u, b, a << 1); }
}
template <int NW> __device__ __forceinline__ void dsa_bisect_bs(const unsigned* SC, int q, int sl, int hq, int nk, unsigned& thr_out, int& cgt_out) {
    unsigned T0[32], T1[32];
    const unsigned* kq = SC + q * 2048; const int rot = sl + 4 * q;
#pragma unroll
    for (int i = 0; i < 32; ++i) { T0[i] = (i < nk) ? kq[(i * 32 + rot) & 2047] : 0u; if (NW == 2) T1[i] = (32 + i < nk) ? kq[((32 + i) * 32 + rot) & 2047] : 0u; }
    bt32(T0); if (NW == 2) bt32(T1);
    unsigned M0 = ~0u, M1 = ~0u; int G = 0;
    unsigned thrA = 0u, thrB = 0u, tfA = 0u, tfB = 0u; bool doneA = false, doneB = false;
#pragma unroll
    for (int r = 0; r < 32; ++r) {
        const unsigned o0 = M0 & T0[r], o1 = (NW == 2) ? (M1 & T1[r]) : 0u;
        int c = __builtin_popcount(o0) + G; if (NW == 2) c += __builtin_popcount(o1);
        const int cs = row16_sum(c);
        const int cA = __builtin_amdgcn_readlane(cs, 0) + __builtin_amdgcn_readlane(cs, 16), cB = __builtin_amdgcn_readlane(cs, 32) + __builtin_amdgcn_readlane(cs, 48);
        const unsigned bit = 1u << (31 - r);
        const bool dA = cA >= 256, dB = cB >= 256;
        if (!doneA && cA == 256) { doneA = true; tfA = (thrA | bit) - 1u; }
        if (!doneB && cB == 256) { doneB = true; tfB = (thrB | bit) - 1u; }
        if (dA) thrA |= bit;
        if (dB) thrB |= bit;
        const bool dec = hq ? dB : dA;
        M0 = dec ? o0 : (M0 & ~T0[r]); if (NW == 2) M1 = dec ? o1 : (M1 & ~T1[r]);
        G = dec ? G : c;
        if (doneA && doneB) break;
    }
    const int gs = row16_sum(G);
    const int gA = __builtin_amdgcn_readlane(gs, 0) + __builtin_amdgcn_readlane(gs, 16), gB = __builtin_amdgcn_readlane(gs, 32) + __builtin_amdgcn_readlane(gs, 48);
    thr_out = hq ? (doneB ? tfB : thrB) : (doneA ? tfA : thrA);
    cgt_out = hq ? (doneB ? 256 : gB) : (doneA ? 256 : gA);
}
__device__ __forceinline__ int half_incl_scan(int v) {
    v += __builtin_amdgcn_update_dpp(0, v, 0x111, 0xf, 0xf, true);
    v += __builtin_amdgcn_update_dpp(0, v, 0x112, 0xf, 0xf, true);
    v += __builtin_amdgcn_update_dpp(0, v, 0x114, 0xf, 0xf, true);
    v += __builtin_amdgcn_update_dpp(0, v, 0x118, 0xf, 0xf, true);
    v += __builtin_amdgcn_update_dpp(0, v, 0x142, 0xa, 0xf, false);
    return v;
}
__device__ __forceinline__ unsigned top_bits(unsigned m, int k) { unsigned t = 0u; while (k > 0 && m) { const unsigned b = 0x80000000u >> __builtin_clz(m); t |= b; m &= ~b; --k; } return t; }
template <int NW> __device__ __forceinline__ void dsa_select_bs(const unsigned* SC, int q, int sl, int hq, int nk, unsigned& s0_out, unsigned& s1_out) {
    unsigned T0[32], T1[32];
    const unsigned* kq = SC + q * 2048; const int rot = sl + 4 * q;
#pragma unroll
    for (int i = 0; i < 32; ++i) { T0[i] = (i < nk) ? kq[(i * 32 + rot) & 2047] : 0u; if (NW == 2) T1[i] = (32 + i < nk) ? kq[((32 + i) * 32 + rot) & 2047] : 0u; }
    bt32(T0); if (NW == 2) bt32(T1);
    unsigned M0 = ~0u, M1 = (NW == 2) ? ~0u : 0u, G0 = 0u, G1 = 0u, S0 = 0u, S1 = 0u; int Gc = 0;
    bool doneA = false, doneB = false;
#pragma unroll
    for (int r = 0; r < 32; ++r) {
        const unsigned o0 = M0 & T0[r], o1 = (NW == 2) ? (M1 & T1[r]) : 0u;
        int c = __builtin_popcount(o0) + Gc; if (NW == 2) c += __builtin_popcount(o1);
        const int cs = row16_sum(c);
        const int cA = __builtin_amdgcn_readlane(cs, 0) + __builtin_amdgcn_readlane(cs, 16), cB = __builtin_amdgcn_readlane(cs, 32) + __builtin_amdgcn_readlane(cs, 48);
        const bool hitA = !doneA && cA == 256, hitB = !doneB && cB == 256;
        if (hitA || hitB) { if (hq ? hitB : hitA) { S0 = G0 | o0; S1 = G1 | o1; } }
        doneA = doneA || hitA; doneB = doneB || hitB;
        const unsigned X = (hq ? (cB >= 256) : (cA >= 256)) ? 0u : 0xFFFFFFFFu;
        G0 |= o0 & X; G1 |= o1 & X; Gc = X ? c : Gc;
        M0 &= T0[r] ^ X; if (NW == 2) M1 &= T1[r] ^ X;
        if (doneA && doneB) break;
    }
    if (!(doneA && doneB)) {
        const int gs = row16_sum(Gc);
        const int gA = __builtin_amdgcn_readlane(gs, 0) + __builtin_amdgcn_readlane(gs, 16), gB = __builtin_amdgcn_readlane(gs, 32) + __builtin_amdgcn_readlane(gs, 48);
        const int need = 256 - (hq ? gB : gA);
        const int m0 = __builtin_popcount(M0), m = m0 + __builtin_popcount(M1);
        const int before = half_incl_scan(m) - m;
        int k = need - before; k = k < 0 ? 0 : (k > m ? m : k);
        const int k0 = k < m0 ? k : m0;
        const unsigned t0 = top_bits(M0, k0), t1 = top_bits(M1, k - k0);
        if (!(hq ? doneB : doneA)) { S0 = G0 | t0; S1 = G1 | t1; }
    }
    s0_out = S0; s1_out = S1;
}
template <int NKS> __device__ __forceinline__ void dsa_bisect(const unsigned* SC, int q, int sl, int hq, int nk, unsigned& thr_out, int& cgt_out) {
    constexpr int NP = NKS / 2;
    unsigned one = 0x00010001u; asm volatile("" : "+v"(one));
    unsigned P[NP];
    const unsigned* kq = SC + q * 2048; const int rot = sl + 4 * q;
#pragma unroll
    for (int p = 0; p < NP; ++p) { const unsigned k0 = (2 * p < nk) ? kq[(2 * p * 32 + rot) & 2047] : 0u, k1 = (2 * p + 1 < nk) ? kq[((2 * p + 1) * 32 + rot) & 2047] : 0u;
        P[p] = (k0 >> 16) | (k1 & 0xffff0000u); }
#define DSA_COUNT(cpk_, outA, outB) do { unsigned c2_ = 0u; _Pragma("unroll") for (int p = 0; p < NP; p += 8) c2_ = pk_gt_cnt8(c2_, &P[p], (cpk_), one); \
        int c_ = (int)((c2_ & 0xffffu) + (c2_ >> 16)); c_ = row16_sum(c_); \
        outA = __builtin_amdgcn_readlane(c_, 0) + __builtin_amdgcn_readlane(c_, 16); outB = __builtin_amdgcn_readlane(c_, 32) + __builtin_amdgcn_readlane(c_, 48); } while (0)
    unsigned thi = 0u; int atA = 1 << 30, atB = 1 << 30;
#pragma unroll 1
    for (int bit = 15; bit >= 0; --bit) { const unsigned cand = thi | (1u << bit), cm1 = cand - 1u; int cA, cB;
        DSA_COUNT(cm1 * 0x10001u, cA, cB);
        if (cA >= 256) atA = cA; if (cB >= 256) atB = cB;
        if ((hq ? cB : cA) >= 256) thi = cand;
        if (atA == 256 && atB == 256) break; }
    int gA, gB; DSA_COUNT(thi * 0x10001u, gA, gB);
    const int needA = 256 - gA, needB = 256 - gB;
    const unsigned tsh = thi << 16;
#pragma unroll
    for (int p = 0; p < NP; ++p) { const unsigned k0 = (2 * p < nk) ? kq[(2 * p * 32 + rot) & 2047] : 0u, k1 = (2 * p + 1 < nk) ? kq[((2 * p + 1) * 32 + rot) & 2047] : 0u;
        const unsigned l0 = ((k0 ^ tsh) < 0x10000u && 2 * p < nk) ? (k0 & 0xffffu) : 0u, l1 = ((k1 ^ tsh) < 0x10000u && 2 * p + 1 < nk) ? (k1 << 16) : 0u;
        P[p] = l0 | l1; }
    unsigned tlo = 0u; int eA = 1 << 30, eB = 1 << 30;
#pragma unroll 1
    for (int bit = 15; bit >= 0; --bit) { const unsigned cand = tlo | (1u << bit), cm1 = cand - 1u; int cA, cB;
        DSA_COUNT(cm1 * 0x10001u, cA, cB);
        if (cA >= needA) eA = cA - needA; if (cB >= needB) eB = cB - needB;
        if ((hq ? (cB >= needB) : (cA >= needA))) tlo = cand;
        if (eA == 0 && eB == 0) break; }
    int hA, hB; DSA_COUNT(tlo * 0x10001u, hA, hB);
#undef DSA_COUNT
    thr_out = tsh | tlo; cgt_out = hq ? (gB + hB) : (gA + hA);
}
__device__ __forceinline__ bf16x8 lane_t16x4(const bf16x8 x, int srcaddr) {
    const u32x4 v = __builtin_bit_cast(u32x4, x); u32x4 r;
    r.x = (unsigned)__builtin_amdgcn_ds_bpermute(srcaddr, (int)v.x); r.y = (unsigned)__builtin_amdgcn_ds_bpermute(srcaddr, (int)v.y);
    r.z = (unsigned)__builtin_amdgcn_ds_bpermute(srcaddr, (int)v.z); r.w = (unsigned)__builtin_amdgcn_ds_bpermute(srcaddr, (int)v.w);
    return __builtin_bit_cast(bf16x8, r);
}
__device__ __forceinline__ void dsa_mfma_unit(Frame& F, const bf16_t* Z, const bf16_t* KV, const bf16_t* IKT, bf16_t* OB, int tok0) {
    const int lane = F.lane, w = F.wave;
    const int b = tok0 / SEQ, t0 = tok0 % SEQ, c = t0 >> 6, nadm = 64 * (c + 1); const size_t row0 = (size_t)b * SEQ;
    unsigned* SC = (unsigned*)F.lds;
    unsigned short* LST = (unsigned short*)(F.lds + RING_BYTES);
    int* NS = (int*)(F.lds + RING_BYTES + 8192);
    const int n16 = lane & 15, quad = lane >> 4;
    const int lrow = lane >> 2, lpc = lane & 3, tsrc = (n16 * 4 + quad) * 4;
    if (nadm > 256) {
        bf16x8 bq[4][2]; float wq[4];
        { const bf16_t* qrow = Z + (size_t)(tok0 + n16) * ZP + C_IQ + quad * 8;
#pragma unroll
          for (int h = 0; h < 4; ++h) { bq[h][0] = *(const bf16x8*)(qrow + h * 64); bq[h][1] = *(const bf16x8*)(qrow + h * 64 + 32); wq[h] = bf2f(Z[(size_t)(tok0 + n16) * ZP + C_IW + h]) * 0.5f; } }
        const int ntile = nadm >> 4, nks = nadm >> 5; const unsigned nkmagic = 0xFFFFFFFFu / (unsigned)nks + 1u;
#pragma unroll 1
        for (int tl0 = w; tl0 < ntile; tl0 += 32) {
            bf16x8 a0[4], a1[4];
#pragma unroll
            for (int u = 0; u < 4; ++u) { const int tl = tl0 + 8 * u; if (tl < ntile) { const bf16_t* kt_ = IKT + ((row0 >> 4) + tl) * 1024 + lane * 8; a0[u] = *(const bf16x8*)(kt_); a1[u] = *(const bf16x8*)(kt_ + 512); } }
#pragma unroll
            for (int u = 0; u < 4; ++u) { const int tl = tl0 + 8 * u; if (tl < ntile) {
                f32x4 isc = (f32x4){0.f, 0.f, 0.f, 0.f};
                const bf16x8 p0 = a0[u], p1 = a1[u];
#pragma unroll
                for (int h = 0; h < 4; ++h) { f32x4 acc = (f32x4){0.f, 0.f, 0.f, 0.f};
                    acc = __builtin_amdgcn_mfma_f32_16x16x32_bf16(p0, bq[h][0], acc, 0, 0, 0); acc = __builtin_amdgcn_mfma_f32_16x16x32_bf16(p1, bq[h][1], acc, 0, 0, 0);
#pragma unroll
                    for (int i = 0; i < 4; ++i) isc[i] += fmaxf(acc[i], 0.f) * wq[h]; }
                u32x4 keys;
#pragma unroll
                for (int i = 0; i < 4; ++i) { const float v = isc[i] + 0.0f; unsigned u_ = __builtin_bit_cast(unsigned, v); u_ ^= (u_ >> 31) ? 0xffffffffu : 0x80000000u; keys[i] = u_; }
                unsigned lp_ = __umulhi((unsigned)(tl * 16 + 4 * quad), nkmagic), ii_ = (unsigned)(tl * 16 + 4 * quad) - lp_ * (unsigned)nks;
#pragma unroll
                for (int i = 0; i < 4; ++i) { SC[n16 * 2048 + ((ii_ * 32u + lp_ + 4u * n16) & 2047u)] = keys[i]; ++ii_; if (ii_ == (unsigned)nks) { ii_ = 0u; ++lp_; } } } }
        }
    }
    __syncthreads();
    {
        const int hq = lane >> 5, sl = lane & 31, q = 2 * w + hq; int nsel = 0;
        if (nadm <= 256) { for (int i = sl; i < nadm; i += 32) LST[q * 256 + i] = (unsigned short)i; nsel = nadm; }
        else {
            const int nk = nadm >> 5; unsigned s0 = 0u, s1 = 0u;
            if (nk <= 32) dsa_select_bs<1>(SC, q, sl, hq, nk, s0, s1); else dsa_select_bs<2>(SC, q, sl, hq, nk, s0, s1);
            const int nl = __builtin_popcount(s0) + __builtin_popcount(s1); int pos = half_incl_scan(nl) - nl;
            unsigned short* lqw = LST + q * 256; const int kb = sl * nk;
            while (s0) { const int i = __builtin_clz(s0); lqw[pos++] = (unsigned short)(kb + i); s0 &= ~(0x80000000u >> i); }
            while (s1) { const int i = __builtin_clz(s1); lqw[pos++] = (unsigned short)(kb + 32 + i); s1 &= ~(0x80000000u >> i); }
            nsel = 256;
        }
        if (sl == 0) NS[q] = nsel;
    }
    __syncthreads();
    unsigned char* wl = F.lds + w * 10240;
    const unsigned wl3 = (unsigned)(uintptr_t)(LAS unsigned char*)wl;
    const int q4 = (lane >> 2) & 3, p4 = lane & 3;
    const unsigned trb = wl3 + (unsigned)((4 * quad + q4) * 144 + (4 * p4) * 2);
    const int vr = lane >> 3, vc = lane & 7;
    const char* kvb = (const char*)(KV + row0 * 128);
    bf16x8 ka0[8], ka1[8];
#define DSA_KLOADQ(LQ, NSEL, t0) do { _Pragma("unroll") for (int u = 0; u < 8; ++u) if (((t0) + u) * 16 < (NSEL)) { const unsigned ko = (unsigned)(LQ)[((t0) + u) * 16 + lrow] * 256u + (unsigned)lpc * 16u; ka0[u] = *(const bf16x8*)(kvb + ko); ka1[u] = *(const bf16x8*)(kvb + ko + 64u); } } while (0)
    DSA_KLOADQ(LST + (2 * w) * 256, NS[2 * w], 0);
#pragma unroll 1
    for (int qi = 0; qi < 2; ++qi) {
        const int qq = 2 * w + qi, tok = tok0 + qq, nsel = NS[qq];
        const unsigned short* lq = LST + qq * 256;
#define DSA_VLOAD(ch, R) do { const unsigned short* lp = lq + (ch) * 32 + vr; \
            R[0] = *(const u32x4*)(kvb + ((unsigned)lp[0] * 256u + 128u + (unsigned)vc * 16u)); R[1] = *(const u32x4*)(kvb + ((unsigned)lp[8] * 256u + 128u + (unsigned)vc * 16u)); \
            R[2] = *(const u32x4*)(kvb + ((unsigned)lp[16] * 256u + 128u + (unsigned)vc * 16u)); R[3] = *(const u32x4*)(kvb + ((unsigned)lp[24] * 256u + 128u + (unsigned)vc * 16u)); } while (0)
        bf16x8 qf0, qf1;
        { const bf16_t* qp = Z + (size_t)tok * ZP + C_SQ + (n16 & 7) * 64 + quad * 8; qf0 = *(const bf16x8*)(qp); qf1 = *(const bf16x8*)(qp + 32);
          if (n16 >= 8) { qf0 = (bf16x8){0, 0, 0, 0, 0, 0, 0, 0}; qf1 = qf0; } }
        float lg[16][4]; float mx = -INFINITY;
#define DSA_QK(t0) do { _Pragma("unroll") for (int u = 0; u < 8; ++u) { \
            if (((t0) + u) * 16 < nsel) { f32x4 acc = (f32x4){0.f, 0.f, 0.f, 0.f}; \
                acc = __builtin_amdgcn_mfma_f32_16x16x32_bf16(lane_t16x4(ka0[u], tsrc), qf0, acc, 0, 0, 0); acc = __builtin_amdgcn_mfma_f32_16x16x32_bf16(lane_t16x4(ka1[u], tsrc), qf1, acc, 0, 0, 0); \
                _Pragma("unroll") for (int i = 0; i < 4; ++i) { lg[(t0) + u][i] = acc[i] * 0.125f; mx = fmaxf(mx, lg[(t0) + u][i]); } } \
            else { _Pragma("unroll") for (int i = 0; i < 4; ++i) lg[(t0) + u][i] = -INFINITY; } } } while (0)
        DSA_QK(0);
        if (128 < nsel) DSA_KLOADQ(lq, nsel, 8);
        u32x4 vv[4][4];
        DSA_QK(8);
#undef DSA_QK
        if (qi == 0) DSA_KLOADQ(LST + (2 * w + 1) * 256, NS[2 * w + 1], 0);
#pragma unroll
        for (int ch = 0; ch < 4; ++ch) if (ch * 32 < nsel) DSA_VLOAD(ch, vv[ch]);
        mx = fmaxf(mx, __shfl_xor(mx, 16)); mx = fmaxf(mx, __shfl_xor(mx, 32));
        float sm = 0.f;
#pragma unroll
        for (int tl = 0; tl < 16; ++tl)
#pragma unroll
            for (int i = 0; i < 4; ++i) { lg[tl][i] = __expf(lg[tl][i] - mx); sm += lg[tl][i]; }
        sm += __shfl_xor(sm, 16); sm += __shfl_xor(sm, 32);
        const float inv = 1.f / sm;
        f32x4 o[4];
#pragma unroll
        for (int nb = 0; nb < 4; ++nb) o[nb] = (f32x4){0.f, 0.f, 0.f, 0.f};
#pragma unroll
        for (int ch = 0; ch < 8; ++ch) {
            if (ch * 32 < nsel) {
                { LAS unsigned char* w3 = (LAS unsigned char*)wl + (ch & 1) * 4608 + vr * 144 + vc * 16;
                  *(LAS u32x4*)(w3) = vv[ch & 3][0]; *(LAS u32x4*)(w3 + 8 * 144) = vv[ch & 3][1]; *(LAS u32x4*)(w3 + 16 * 144) = vv[ch & 3][2]; *(LAS u32x4*)(w3 + 24 * 144) = vv[ch & 3][3]; }
                if (ch + 4 < 8 && (ch + 4) * 32 < nsel) DSA_VLOAD(ch + 4, vv[ch & 3]);
                u32x4 pw;
                pw.x = pg8::cvt_pk_bf16(lg[2 * ch][0] * inv, lg[2 * ch][1] * inv); pw.y = pg8::cvt_pk_bf16(lg[2 * ch][2] * inv, lg[2 * ch][3] * inv);
                pw.z = pg8::cvt_pk_bf16(lg[2 * ch + 1][0] * inv, lg[2 * ch + 1][1] * inv); pw.w = pg8::cvt_pk_bf16(lg[2 * ch + 1][2] * inv, lg[2 * ch + 1][3] * inv);
                asm volatile("s_waitcnt lgkmcnt(0)" ::: "memory");
                const unsigned tb = trb + (ch & 1) * 4608;
#pragma unroll
                for (int nb = 0; nb < 4; ++nb) { const s16x4 va = tr_read(tb + nb * 32), vb = tr_read(tb + 16 * 144 + nb * 32);
                    o[nb] = __builtin_amdgcn_mfma_f32_16x16x32_bf16(__builtin_bit_cast(bf16x8, pw), (bf16x8){va[0], va[1], va[2], va[3], vb[0], vb[1], vb[2], vb[3]}, o[nb], 0, 0, 0); }
            }
        }
#undef DSA_VLOAD
        asm volatile("s_waitcnt lgkmcnt(0)" ::: "memory");
        if (quad < 2) { bf16_t* op = OB + (size_t)tok * 512 + n16;
#pragma unroll
            for (int nb = 0; nb < 4; ++nb)
#pragma unroll
                for (int i = 0; i < 4; ++i) op[(4 * quad + i) * 64 + nb * 16] = (bf16_t)f2bf(o[nb][i]); }
    }
#undef DSA_KLOADQ
}
__device__ __forceinline__ void phase_mixers(Frame& F, const bf16_t* Z, const bf16_t* KV, bf16_t* MIX, const float* lbl, const float* onorm, unsigned* wq, const float* p, bf16_t* PB, int Ts) {
    F.retid();
    const int NBq = Ts / SEQ; const int NH = NBq * 4, NDSA = Ts / 16, NSBU = NBq * 8 * 8, NPBU = Ts * (PLE / 8) / 4096, NU = NH + NDSA + NSBU + NPBU;
    bf16_t* OA = MIX; bf16_t* OB = MIX + (size_t)Ts * 512; bf16_t* OC = MIX + (size_t)2 * Ts * 512;
    for (;;) {
        __syncthreads();
        if (F.tid == 0) F.lctl[4] = atomicAdd(wq, 1u);
        __syncthreads();
        const int u = (int)F.lctl[4];
        if (u >= NU) break;
        F.retid();
        if (u < NH) { hgrn_mfma_unit(F, Z, OA, onorm, u >> 2, u & 3); }
        else if (u < NH + NDSA) { dsa_mfma_unit(F, Z, KV, KV + (size_t)Ts * 128, OB, (NDSA - 1 - (u - NH)) * 16); }
        else if (u < NH + NDSA + NSBU) { const int idx = u - NH - NDSA; const int qblk = 7 - (idx / (NBq * 8)), bh = idx % (NBq * 8); sb_mfma_wave(Z, OC, bh >> 3, bh & 7, qblk * 256 + F.wave * 32, F.lds + F.wave * 12288, F.lane); }
        else { const size_t i0 = (size_t)(u - NH - NDSA - NSBU) * 4096 + F.tid; f32x4 a[8], b[8];
#pragma unroll
            for (int k = 0; k < 8; ++k) { a[k] = *(const f32x4*)(p + (i0 + k * 512) * 8); b[k] = *(const f32x4*)(p + (i0 + k * 512) * 8 + 4); }
#pragma unroll
            for (int k = 0; k < 8; ++k) { uint4 o; o.x = pk2(a[k][0], a[k][1]); o.y = pk2(a[k][2], a[k][3]); o.z = pk2(b[k][0], b[k][1]); o.w = pk2(b[k][2], b[k][3]); *(uint4*)(PB + (i0 + k * 512) * 8) = o; } }
    }
}

struct MoeTab { int start[17]; };
__device__ __forceinline__ void moe_tab(MoeTab& T, const unsigned* cnt) {
    int s = 0;
#pragma unroll
    for (int g = 0; g < 16; ++g) { T.start[g] = s; s += ((int)__hip_atomic_load(cnt + g, __ATOMIC_RELAXED, __HIP_MEMORY_SCOPE_AGENT) + 255) >> 8; }
    T.start[16] = s;
}
__device__ __forceinline__ int moe_group_of(const MoeTab& T, int r) { int g = 0;
#pragma unroll
    for (int j = 1; j < 16; ++j) g += (r >= T.start[j]) ? 1 : 0;
    return g; }
struct MoeGuOrder { MoeTab T; int G, c; const int* rowtok;
    __device__ __forceinline__ int rowmap(int slot) const { return rowtok[slot]; }
    __device__ __forceinline__ bool next(int i, Unit& u) const { const int R = T.start[16]; const long L = (long)i * G + c; if (L >= (long)R * 22) return false;
        int r, pn; pg8::tile_of((int)L, R, 22, r, pn); const int e = moe_group_of(T, r) & 7; u.pm = r; u.pn = pn; u.ta = r; u.tb = e * 22 + pn; return true; } };
struct MoeDownOrder { MoeTab T; int G, c, rank;
    __device__ __forceinline__ bool next(int i, Unit& u) const { const int r0 = T.start[rank * 8], nr = T.start[rank * 8 + 8] - r0; const long L = (long)i * G + c; if (L >= (long)nr * 4) return false;
        int rr, pn; pg8::tile_of((int)L, nr, 4, rr, pn); const int r = r0 + rr, e = moe_group_of(T, r) & 7; u.pm = r; u.pn = pn; u.ta = r; u.tb = e * 4 + pn; return true; } };
struct MoeDownAllOrder { MoeTab T; int G, c;
    __device__ __forceinline__ bool next(int i, Unit& u) const { const int nr = T.start[16]; const long L = (long)i * G + c; if (L >= (long)nr * 4) return false;
        int r, pn; pg8::tile_of((int)L, nr, 4, r, pn); const int e = moe_group_of(T, r) & 7; u.pm = r; u.pn = pn; u.ta = r; u.tb = e * 4 + pn; return true; } };
struct MergeOrder { int nM, G, c;
    __device__ __forceinline__ bool next(int i, Unit& u) const { const int ib = i / 3, br = i % 3; const long L = (long)ib * G + c; if (L >= (long)nM * 4) return false;
        int pm, pn; pg8::tile_of((int)L, nM, 4, pm, pn); u.pm = pm; u.pn = br * 4 + pn; u.ta = br * nM + pm; u.tb = br * 4 + pn; return true; } };

__device__ __forceinline__ void phase_route(Frame& F, const bf16_t* H, const float* gffn, const float* router, int* tok_e, float* tok_w, float* tok_rstd, int* rowtok, unsigned* cnt, int Ts) {
    F.retid();
    const int gt = F.bid * NTHR + F.tid, NGT = F.og() * NTHR;
    for (int i = gt; i < 2 * Ts + 4096; i += NGT) rowtok[i] = -1;
    volatile LAS unsigned* lc = F.lctl + 16;
    if (F.tid < 16) lc[F.tid] = 0u;
    __syncthreads();
    float* rl = (float*)F.lds;
    for (int i = F.tid; i < D * NE; i += NTHR) rl[i] = router[i] * gffn[i >> 3];
    __syncthreads();
    const int lo = (int)((long)Ts * F.bid / F.G), hi = (int)((long)Ts * (F.bid + 1) / F.G);
    for (int tok = lo + F.wave; tok < hi; tok += NWAVES) {
        const u32x2* hr = (const u32x2*)(H + (size_t)tok * D) + F.lane; f32x4 v[4]; float ss = 0.f;
#pragma unroll
        for (int j = 0; j < 4; ++j) { const u32x2 w_ = hr[64 * j]; v[j] = (f32x4){bflo(w_.x), bfhi(w_.x), bflo(w_.y), bfhi(w_.y)}; ss += (v[j][0] * v[j][0] + v[j][1] * v[j][1]) + (v[j][2] * v[j][2] + v[j][3] * v[j][3]); }
        const float rs = rsqrtf(wave_sum(ss) * (1.f / D) + EPS);
        float lgt[8];
#pragma unroll
        for (int e = 0; e < 8; ++e) lgt[e] = 0.f;
#pragma unroll
        for (int j = 0; j < 4; ++j)
#pragma unroll
            for (int q = 0; q < 4; ++q) { const int k = 256 * j + 4 * F.lane + q; const float x = v[j][q] * rs; const f32x4 r0 = *(const f32x4*)(rl + k * 8), r1 = *(const f32x4*)(rl + k * 8 + 4);
                lgt[0] += x * r0[0]; lgt[1] += x * r0[1]; lgt[2] += x * r0[2]; lgt[3] += x * r0[3]; lgt[4] += x * r1[0]; lgt[5] += x * r1[1]; lgt[6] += x * r1[2]; lgt[7] += x * r1[3]; }
#pragma unroll
        for (int e = 0; e < 8; ++e) lgt[e] = wave_sum(lgt[e]);
        int e0 = 0; float l0 = lgt[0];
#pragma unroll
        for (int e = 1; e < 8; ++e) if (lgt[e] > l0) { l0 = lgt[e]; e0 = e; }
        int e1 = -1; float l1 = -INFINITY;
#pragma unroll
        for (int e = 0; e < 8; ++e) if (e != e0 && lgt[e] > l1) { l1 = lgt[e]; e1 = e; }
        const float wa = 1.f / (1.f + __expf(l1 - l0));
        if (F.lane == 0) { tok_e[tok * 2] = e0; tok_e[tok * 2 + 1] = e1; tok_w[tok * 2] = wa; tok_w[tok * 2 + 1] = 1.f - wa; tok_rstd[tok] = rs;
            __hip_atomic_fetch_add((LAS unsigned*)(lc + e0), 1u, __ATOMIC_RELAXED, __HIP_MEMORY_SCOPE_WORKGROUP); __hip_atomic_fetch_add((LAS unsigned*)(lc + 8 + e1), 1u, __ATOMIC_RELAXED, __HIP_MEMORY_SCOPE_WORKGROUP); }
    }
    __syncthreads();
    if (F.tid < 16) { const unsigned n = lc[F.tid]; if (n) atomicAdd(cnt + F.tid, n); }
    __syncthreads();
}
__device__ __forceinline__ void phase_scatter(Frame& F, const bf16_t* HB, bf16_t* VP, const int* tok_e, const float* tok_w, const float* tok_rstd, int* rowtok, float* roww, float* rowrstd, unsigned* cnt, int Ts) {
    F.retid();
    MoeTab T; moe_tab(T, cnt);
    volatile LAS unsigned* lc = F.lctl + 16; volatile LAS unsigned* lb = F.lctl + 32;
    int* posl = (int*)F.lds;
    if (F.tid < 16) lc[F.tid] = 0u;
    __syncthreads();
    const int lo = (int)((long)Ts * F.bid / F.G), hi = (int)((long)Ts * (F.bid + 1) / F.G), n = hi - lo;
    int e0 = 0, e1 = 0, li0 = 0, li1 = 0;
    if (F.tid < n) { const int tok = lo + F.tid; e0 = tok_e[tok * 2]; e1 = tok_e[tok * 2 + 1];
        li0 = (int)__hip_atomic_fetch_add((LAS unsigned*)(lc + e0), 1u, __ATOMIC_RELAXED, __HIP_MEMORY_SCOPE_WORKGROUP); li1 = (int)__hip_atomic_fetch_add((LAS unsigned*)(lc + 8 + e1), 1u, __ATOMIC_RELAXED, __HIP_MEMORY_SCOPE_WORKGROUP); }
    __syncthreads();
    if (F.tid < 16) { const unsigned c = lc[F.tid]; int st = 0;
#pragma unroll
        for (int g = 0; g < 16; ++g) st = (F.tid == g) ? T.start[g] : st;
        lb[F.tid] = (unsigned)st * 256u + (c ? atomicAdd(cnt + 64 + F.tid, c) : 0u); }
    __syncthreads();
    if (F.tid < n) { const int tok = lo + F.tid; const int p0 = (int)lb[e0] + li0, p1 = (int)lb[8 + e1] + li1; const float rs = tok_rstd[tok];
        rowtok[p0] = tok; roww[p0] = tok_w[tok * 2]; rowrstd[p0] = rs; rowtok[p1] = tok; roww[p1] = tok_w[tok * 2 + 1]; rowrstd[p1] = rs; }
    __syncthreads();
    __syncthreads();
}

constexpr int WGM_INPROJ = 4, WGM_GU = 4;
constexpr int NPHL = 13;
__host__ __device__ inline bool phase_active(int k, int l) {
    if (k == 0) return l == 0;
    if (k >= 8 && k <= 10) return (l & 1) == 1;
    if (k == 12) return l == DEPTH - 1;
    return true;
}
struct Args { const float* in[23]; float* out; unsigned char* ws; int ph_lo, ph_hi, single, Ts; };

typedef const __attribute__((address_space(4))) Args* KArgs;
struct Ctx { unsigned char* ws; float* out; int Ts, nM; ActMap M; KArgs ap;
    __device__ __forceinline__ const float* in(int i) const { return ap->in[i]; } };
#define CTX() Ctx C; { KArgs ap_ = (KArgs)__builtin_amdgcn_kernarg_segment_ptr(); asm volatile("" : "+s"(ap_)); C.ap = ap_; C.ws = ap_->ws; C.out = ap_->out; C.Ts = ap_->Ts; C.nM = C.Ts / 256; C.M.init((size_t)C.Ts); }
#define WSP(T, off) ((T*)(C.ws + (off)))

__global__ void __launch_bounds__(NTHR, 2) fwd(Args a) {
    extern __shared__ __attribute__((aligned(16))) unsigned char lds_raw[];
    Frame F;
    F.lds = lds_raw; F.lds3 = (LAS unsigned char*)lds_raw; F.lctl = (volatile LAS unsigned*)(F.lds3 + LDSCTL_OFF);
    F.tid = threadIdx.x; F.lane = F.tid & 63; F.wave = __builtin_amdgcn_readfirstlane(F.tid >> 6); F.wave0 = F.wave; F.G = gridDim.x; F.bid = blockIdx.x;
    F.ws = a.ws; F.ctl = (unsigned*)(a.ws + WS_CTL);
    for (int u = F.tid; u < (LDS_BYTES - LDSCTL_OFF) / 4; u += NTHR) F.lctl[u] = 0u;
    __syncthreads();
    XcdBarrier bar; bar.bar = F.ctl + CW_BAR; bar.x = 0; bar.st = nullptr;
    if (a.single) bar = xcd_barrier_post(F.ctl + CW_BAR, F.lctl);
    const int lo = a.ph_lo, hi = a.ph_hi, single = a.single;
#define RUN(p) (lo <= (p) && (p) < hi)
#define SEAM(p) do { if (single && (p) + 1 < hi) xcd_barrier(bar, F.wave0); } while (0)
    const int NSB = BATCH * SEQ / a.Ts;

    if (RUN(0)) { phase_prologue(F, a.in); SEAM(0); }

    for (int sb = 0; sb < NSB; ++sb) {
        for (int l = 0; l < DEPTH; ++l) {
            const int pbase = 1 + (sb * DEPTH + l) * NPHL; const int sl = sb * DEPTH + l;
            if (pbase + NPHL <= lo || pbase >= hi) continue;
#define HPTR (C.out + (size_t)sb * C.Ts * D)
            if (l == 0 && RUN(pbase + 0)) { CTX(); phase_init(F, C.in(0) + (size_t)sb * C.Ts * D, WSP(bf16_t, C.M.hbn), WSP(float, C.M.ssq1), C.Ts); SEAM(pbase + 0); }
            if (RUN(pbase + 1)) { CTX();
                pg8::Gemm g{WSP(bf16_t, C.M.hbn), WSP(const bf16_t, WS_WIN + l * SZ_WIN), D}; pg8::PlainOrder S{C.nM, ZW / 256, F.G, F.bid, WGM_INPROJ}; EpiZ E{WSP(bf16_t, C.M.z), WSP(float, C.M.ssq1), WSP(float, WS_LB) + l * 512, WSP(bf16_t, C.M.z) + (size_t)C.Ts * ZP, WSP(bf16_t, C.M.kv) + (size_t)C.Ts * 128};
                pg8::gemm_phase(F.lds3, g, S, E, F.wave0); SEAM(pbase + 1); }
            if (RUN(pbase + 2)) { CTX(); phase_prep(F, WSP(bf16_t, C.M.z), WSP(bf16_t, C.M.kv), WSP(bf16_t, WS_WKV + l * SZ_WKV), C.in(1) + ((size_t)l * BATCH * SEQ + (size_t)sb * C.Ts) * PLE, WSP(bf16_t, C.M.pb), C.Ts); SEAM(pbase + 2); }
            if (RUN(pbase + 3)) { CTX(); phase_mixers(F, WSP(bf16_t, C.M.z), WSP(bf16_t, C.M.kv), WSP(bf16_t, C.M.mix), WSP(float, WS_LB) + l * 512, C.in(5) + l * 128, WSP(unsigned, WS_CTL) + CW_WQ + 64 * sl, C.in(1) + ((size_t)l * BATCH * SEQ + (size_t)sb * C.Ts) * PLE, WSP(bf16_t, C.M.pb), C.Ts); SEAM(pbase + 3); }
            if (RUN(pbase + 4)) { CTX();
                pg8::Gemm g{WSP(bf16_t, C.M.mix), WSP(const bf16_t, WS_WBR + l * SZ_WBR), 512}; MergeOrder S{C.nM, F.G, F.bid}; EpiMerge E{WSP(bf16_t, C.M.mg), WSP(bf16_t, C.M.z) + (size_t)C.Ts * ZP, WSP(bf16_t, C.M.hb)};
                pg8::gemm_phase(F.lds3, g, S, E, F.wave0); SEAM(pbase + 4); }
            if (RUN(pbase + 5)) { CTX();
                pg8::Gemm g{WSP(bf16_t, C.M.mg), WSP(const bf16_t, WS_WOUT + l * SZ_WOUT), D}; pg8::PlainOrder S{C.nM, 4, F.G, F.bid}; EpiRes E{WSP(bf16_t, C.M.hbn), WSP(bf16_t, C.M.hb), WSP(float, C.M.ssq)};
                pg8::gemm_phase(F.lds3, g, S, E, F.wave0); SEAM(pbase + 5); }
            if ((l & 1) == 0) {
                if (RUN(pbase + 6)) { CTX();
                    pg8::Gemm g{WSP(bf16_t, C.M.hb), WSP(const bf16_t, WS_WDGU + (l >> 1) * SZ_WGU), D}; pg8::PlainOrder S{C.nM, 22, F.G, F.bid, WGM_GU}; EpiGU E{WSP(bf16_t, C.M.z), WSP(float, C.M.ssq), nullptr};
                    pg8::gemm_phase(F.lds3, g, S, E, F.wave0); SEAM(pbase + 6); }
                if (RUN(pbase + 7)) { CTX();
                    pg8::Gemm g{WSP(bf16_t, C.M.z), WSP(const bf16_t, WS_WDD + (l >> 1) * SZ_WD), DFF}; pg8::PlainOrder S{C.nM, 4, F.G, F.bid}; EpiRes E{WSP(bf16_t, C.M.hb), WSP(bf16_t, C.M.hb), WSP(float, C.M.ssq)};
                    pg8::gemm_phase(F.lds3, g, S, E, F.wave0); SEAM(pbase + 7); }
            } else {
#define MCNT (WSP(unsigned, WS_CTL) + CW_MOE + 256 * sl)
                if (RUN(pbase + 6)) { CTX(); phase_route(F, WSP(bf16_t, C.M.hb), C.in(11) + l * D, C.in(15) + (size_t)(l >> 1) * D * NE, WSP(int, C.M.tok_e), WSP(float, C.M.tok_w), WSP(float, C.M.tok_rstd), WSP(int, C.M.rowtok), MCNT, C.Ts); SEAM(pbase + 6); }
                if (RUN(pbase + 7)) { CTX(); phase_scatter(F, WSP(bf16_t, C.M.hb), WSP(bf16_t, C.M.mix), WSP(int, C.M.tok_e), WSP(float, C.M.tok_w), WSP(float, C.M.tok_rstd), WSP(int, C.M.rowtok), WSP(float, C.M.roww), WSP(float, C.M.rowrstd), MCNT, C.Ts); SEAM(pbase + 7); }
                if (RUN(pbase + 8)) { CTX();
                    pg8::Gemm g{WSP(bf16_t, C.M.hb), WSP(const bf16_t, WS_WMGU + (size_t)(l >> 1) * 8 * SZ_WGU), D}; MoeGuOrder S; moe_tab(S.T, MCNT); S.G = F.G; S.c = F.bid; S.rowtok = WSP(int, C.M.rowtok); EpiGU E{WSP(bf16_t, C.M.z), nullptr, WSP(float, C.M.rowrstd)};
                    pg8::gemm_phase<EpiGU, MoeGuOrder, true, true, true>(F.lds3, g, S, E, F.wave0); SEAM(pbase + 8); }
                if (RUN(pbase + 9)) { CTX();
                    pg8::Gemm g{WSP(bf16_t, C.M.z), WSP(const bf16_t, WS_WMD + (size_t)(l >> 1) * 8 * SZ_WD), DFF}; MoeDownAllOrder S; moe_tab(S.T, MCNT); S.G = F.G; S.c = F.bid;
                    EpiMoeDownM E{WSP(bf16_t, C.M.hb), WSP(bf16_t, C.M.mg), WSP(int, C.M.rowtok), WSP(float, C.M.roww), S.T.start[8]};
                    pg8::gemm_phase(F.lds3, g, S, E, F.wave0); SEAM(pbase + 9); }
            }
            if ((l & 1) == 1) {
                if (RUN(pbase + 10)) { CTX(); pg8::Gemm g{WSP(bf16_t, C.M.pb), WSP(const bf16_t, WS_WPP + l * SZ_WPP), PLE}; pg8::PlainOrder S{C.nM, 4, F.G, F.bid};
                    EpiPpComb E{WSP(bf16_t, C.M.mix), WSP(bf16_t, C.M.hb), WSP(bf16_t, C.M.mg), WSP(float, C.M.ssq)}; pg8::gemm_phase(F.lds3, g, S, E, F.wave0); SEAM(pbase + 10); }
            }
            if (RUN(pbase + 11)) {
                if ((l & 1) == 0) { CTX(); pg8::Gemm g{WSP(bf16_t, C.M.pb), WSP(const bf16_t, WS_WPP + l * SZ_WPP), PLE}; pg8::PlainOrder S{C.nM, 4, F.G, F.bid}; EpiBf E{WSP(bf16_t, C.M.mix)}; pg8::gemm_phase(F.lds3, g, S, E, F.wave0); }
                { CTX(); pg8::Gemm g{WSP(bf16_t, C.M.hb), WSP(const bf16_t, WS_WPG + l * SZ_WOUT), D}; pg8::PlainOrder S{C.nM, 4, F.G, F.bid};
                  EpiPle E{WSP(bf16_t, C.M.hb), WSP(bf16_t, C.M.hbn), WSP(float, C.M.ssq1), WSP(float, C.M.ssq), WSP(bf16_t, C.M.mix)}; pg8::gemm_phase(F.lds3, g, S, E, F.wave0); }
                SEAM(pbase + 11); }
            if (l == DEPTH - 1 && RUN(pbase + 12)) { CTX(); phase_final(F, WSP(bf16_t, C.M.hbn), HPTR, C.in(22), C.Ts); SEAM(pbase + 12); }
        }
    }
#undef RUN
#undef SEAM
}

#ifndef MK_SINGLE
#define MK_SINGLE 1
#endif
extern "C" void kernel_launch(void* const* d_in, const int* in_sizes, int n_in, void* d_out, int out_size, void* d_ws, size_t ws_size, hipStream_t stream) {
    static int grid = 0, Ts = 0;
    if (grid == 0) {
        int dev = 0, cus = 0;
        if (hipGetDevice(&dev) != hipSuccess || hipDeviceGetAttribute(&cus, hipDeviceAttributeMultiprocessorCount, dev) != hipSuccess) { fprintf(stderr, "kernel_launch: device query failed\n"); grid = -1; return; }
        if (hipFuncSetAttribute((const void*)fwd, hipFuncAttributeMaxDynamicSharedMemorySize, LDS_BYTES) != hipSuccess) { fprintf(stderr, "kernel_launch: hipFuncSetAttribute failed\n"); grid = -1; return; }
        int per_cu = 0; (void)hipOccupancyMaxActiveBlocksPerMultiprocessor(&per_cu, (const void*)fwd, NTHR, LDS_BYTES); (void)hipGetLastError();
        const int nbs[3] = {16, 8, 4};
        for (int i = 0; i < 3 && !Ts; ++i) { ActMap M; M.init((size_t)nbs[i] * SEQ); if (M.end <= ws_size) Ts = nbs[i] * SEQ; }
        if (!Ts || n_in != 23 || per_cu < 1) { fprintf(stderr, "kernel_launch: unsupported (ws %zu, n_in %d, occupancy %d)\n", ws_size, n_in, per_cu); grid = -1; return; }
        grid = cus;
    }
    if (grid < 0) return;
    (void)hipMemsetAsync((char*)d_ws + WS_CTL, 0, CTL_BYTES, stream);
    Args a{};
    for (int i = 0; i < 23; ++i) a.in[i] = (const float*)d_in[i];
    a.out = (float*)d_out; a.ws = (unsigned char*)d_ws; a.Ts = Ts;
    const int NSB = BATCH * SEQ / Ts, NPH = 1 + NSB * DEPTH * NPHL;
#if MK_SINGLE
    a.ph_lo = 0; a.ph_hi = NPH; a.single = 1;
    hipLaunchKernelGGL(fwd, dim3(grid), dim3(NTHR), LDS_BYTES, stream, a);
#else
    a.single = 0;
    for (int ph = 0; ph < NPH; ++ph) {
        if (ph > 0) { const int r = (ph - 1) % (DEPTH * NPHL); if (!phase_active(r % NPHL, r / NPHL)) continue; }
        a.ph_lo = ph; a.ph_hi = ph + 1;
        hipLaunchKernelGGL(fwd, dim3(grid), dim3(NTHR), LDS_BYTES, stream, a);
    }
#endif
}
```

```cpp
#include <hip/hip_runtime.h>
#include <cstdio>
#include <cstdint>

#define LAS __attribute__((address_space(3)))
#define GAS __attribute__((address_space(1)))
typedef unsigned short bf16_t;
typedef short bf16x8 __attribute__((ext_vector_type(8)));
typedef float f32x4 __attribute__((ext_vector_type(4)));
typedef unsigned u32x4 __attribute__((ext_vector_type(4)));
typedef unsigned u32x2 __attribute__((ext_vector_type(2)));

constexpr int D = 1024, SEQ = 2048, BATCH = 32, DEPTH = 4;
constexpr int ZW = 7680, ZP = 4608;
constexpr int C_HQ = 0, C_HF = 512, C_HI = 1024, C_HG = 1536, C_SQ = 2048, C_SC = 2560, C_IQ = 2688, C_IK = 2944, C_BQ = 3008, C_BK = 3520, C_BV = 4032, C_IW = 4544, C_GZ = 4608;
constexpr int GZ_PN0 = C_GZ / 256;
constexpr int IN_W = 7620, DFF = 2816, NE = 8, PLE = 256;
constexpr float EPS = 1e-6f;
constexpr int NWAVES = 8, NTHR = 512;

constexpr size_t MiB = 1u << 20;
constexpr size_t WS_CTL = 0, CTL_BYTES = 1 * MiB;
constexpr int CW_BAR = 4096;
constexpr int CW_WQ = 8192;
constexpr int CW_MOE = 16384;
constexpr size_t SZ_WIN = (size_t)ZW * D * 2, SZ_WBR = (size_t)3 * D * 512 * 2, SZ_WOUT = (size_t)D * D * 2, SZ_WGU = (size_t)2 * DFF * D * 2, SZ_WD = (size_t)D * DFF * 2,
                 SZ_WPP = (size_t)D * PLE * 2, SZ_WKV = (size_t)128 * 128 * 2;
constexpr size_t WS_WIN = 1 * MiB;
constexpr size_t WS_WBR = WS_WIN + 4 * SZ_WIN;
constexpr size_t WS_WOUT = WS_WBR + 4 * SZ_WBR;
constexpr size_t WS_WDGU = WS_WOUT + 4 * SZ_WOUT;
constexpr size_t WS_WDD = WS_WDGU + 2 * SZ_WGU;
constexpr size_t WS_WMGU = WS_WDD + 2 * SZ_WD;
constexpr size_t WS_WMD = WS_WMGU + 16 * SZ_WGU;
constexpr size_t WS_WPG = WS_WMD + 16 * SZ_WD;
constexpr size_t WS_WPP = WS_WPG + 4 * SZ_WOUT;
constexpr size_t WS_WKV = WS_WPP + 4 * SZ_WPP;
constexpr size_t WS_LB = WS_WKV + 4 * SZ_WKV;
constexpr size_t WS_ACT = ((WS_LB + 4 * 512 * 4 + 4095) / 4096) * 4096;
struct ActMap {
    size_t hb, hbn, ssq, ssq1, z, kv, mix, mg, pb, tok_e, tok_w, tok_rstd, rowtok, roww, rowrstd, end;
    __host__ __device__ void init(size_t Ts) {
        size_t o = WS_ACT;
        hb = o; o += Ts * D * 2;
        hbn = o; o += Ts * D * 2;
        ssq = o; o += Ts * 16 * 4;
        ssq1 = o; o += Ts * 16 * 4;
        z = o; o += Ts * ZW * 2;
        kv = o; o += Ts * (128 + 64) * 2;
        mix = o; o += 3 * Ts * 512 * 2;
        mg = o; o += Ts * D * 2;
        pb = o; o += Ts * PLE * 2;
        tok_e = o; o += Ts * 2 * 4;
        tok_w = o; o += Ts * 2 * 4;
        tok_rstd = o; o += Ts * 4;
        rowtok = o; o += (2 * Ts + 4096) * 4;
        roww = o; o += (2 * Ts + 4096) * 4;
        rowrstd = o; o += (2 * Ts + 4096) * 4;
        end = o;
    }
};

__device__ __forceinline__ int lane_id() { return (int)__builtin_amdgcn_mbcnt_hi(~0u, __builtin_amdgcn_mbcnt_lo(~0u, 0u)); }
__device__ __forceinline__ unsigned f2bf(float f) { unsigned u = __builtin_bit_cast(unsigned, f); return (u + 0x7fffu + ((u >> 16) & 1u)) >> 16; }
__device__ __forceinline__ unsigned pk2(float lo, float hi) { return f2bf(lo) | (f2bf(hi) << 16); }
__device__ __forceinline__ float bflo(unsigned u) { return __builtin_bit_cast(float, u << 16); }
__device__ __forceinline__ float bfhi(unsigned u) { return __builtin_bit_cast(float, u & 0xffff0000u); }
__device__ __forceinline__ float bf2f(bf16_t b) { return __builtin_bit_cast(float, ((unsigned)b) << 16); }
__device__ __forceinline__ float xhalf_other(float x) {
    float a = x, b = x; asm volatile("s_nop 1\n\tv_permlane32_swap_b32 %0, %1\n\ts_nop 1" : "+v"(a), "+v"(b));
    return (lane_id() < 32) ? b : a; }
__device__ __forceinline__ float xrow_sum(float x) {
    float a = x, b = x; asm volatile("s_nop 1\n\tv_permlane32_swap_b32 %0, %1\n\ts_nop 1" : "+v"(a), "+v"(b));
    float s_ = a + b; a = s_; b = s_; asm volatile("s_nop 1\n\tv_permlane16_swap_b32 %0, %1\n\ts_nop 1" : "+v"(a), "+v"(b));
    return a + b; }
__device__ __forceinline__ float xrow_max(float x) {
    float a = x, b = x; asm volatile("s_nop 1\n\tv_permlane32_swap_b32 %0, %1\n\ts_nop 1" : "+v"(a), "+v"(b));
    float s_ = fmaxf(a, b); a = s_; b = s_; asm volatile("s_nop 1\n\tv_permlane16_swap_b32 %0, %1\n\ts_nop 1" : "+v"(a), "+v"(b));
    return fmaxf(a, b); }
__device__ __forceinline__ float wave_sum(float v) {
    v += __builtin_bit_cast(float, __builtin_amdgcn_update_dpp(0, __builtin_bit_cast(int, v), 0xB1, 0xf, 0xf, true));
    v += __builtin_bit_cast(float, __builtin_amdgcn_update_dpp(0, __builtin_bit_cast(int, v), 0x4E, 0xf, 0xf, true));
    v += __builtin_bit_cast(float, __builtin_amdgcn_update_dpp(0, __builtin_bit_cast(int, v), 0x141, 0xf, 0xf, true));
    v += __builtin_bit_cast(float, __builtin_amdgcn_update_dpp(0, __builtin_bit_cast(int, v), 0x140, 0xf, 0xf, true));
    const int iv = __builtin_bit_cast(int, v);
    const float r0 = __builtin_bit_cast(float, __builtin_amdgcn_readlane(iv, 0)), r1 = __builtin_bit_cast(float, __builtin_amdgcn_readlane(iv, 16));
    const float r2 = __builtin_bit_cast(float, __builtin_amdgcn_readlane(iv, 32)), r3 = __builtin_bit_cast(float, __builtin_amdgcn_readlane(iv, 48));
    return (r0 + r1) + (r2 + r3);
}
__device__ __forceinline__ float wave_max(float v) {
    int l = lane_id(); asm volatile("" : "+v"(l));
#pragma unroll
    for (int o = 1; o < 64; o <<= 1) v = fmaxf(v, __builtin_bit_cast(float, __builtin_amdgcn_ds_bpermute((l ^ o) << 2, __builtin_bit_cast(int, v))));
    return v;
}
__device__ __forceinline__ float sigmoidf_(float x) { return __builtin_amdgcn_rcpf(1.f + __expf(-x)); }
__device__ __forceinline__ float siluf_(float x) { return x * __builtin_amdgcn_rcpf(1.f + __expf(-x)); }
__device__ __forceinline__ void unpack8(const uint4 u, float* f) {
    f[0] = bflo(u.x); f[1] = bfhi(u.x); f[2] = bflo(u.y); f[3] = bfhi(u.y); f[4] = bflo(u.z); f[5] = bfhi(u.z); f[6] = bflo(u.w); f[7] = bfhi(u.w);
}

namespace pg8 {
constexpr int BM = 256, BK = 64, HALF = 128, HTB = HALF * BK * 2, STAGE_BYTES = 8 * HTB, NXCD = 8, WGM = 4;
__host__ __device__ __forceinline__ int lds_byte(int r, int c) { const int st = (r >> 4) * 2 + (c >> 5), rr = r & 15, cc = c & 31, ob = rr * 64 + cc * 2; return st * 1024 + (ob ^ (((ob >> 9) & 1) << 5)); }
__host__ __device__ __forceinline__ void stage_rc(int b, int& R, int& C) { const int st = b / 1024, sb = b % 1024, swz = sb ^ (((sb >> 9) & 1) << 5); R = (st >> 1) * 16 + swz / 64; C = (st & 1) * 32 + (swz % 64) / 2; }
__host__ __device__ __forceinline__ int perm32(int rho) { const int n = rho >> 4, i = rho & 15; return 8 * (i >> 2) + 4 * n + (i & 3); }

struct Unit { int pm, pn, ta, tb; };
struct Gemm { const bf16_t* A; const bf16_t* Bt; int K; };

__device__ __forceinline__ void tile_of(int L, int nM, int nN, int& pm, int& pn, int wgm = WGM) {
    const int nwg = nM * nN; int wgid = L;
    { const int q = nwg / NXCD, r = nwg % NXCD, xcd = wgid % NXCD, off = wgid / NXCD; wgid = (xcd < r ? xcd * (q + 1) : r * (q + 1) + (xcd - r) * q) + off; }
    const int nig = wgm * nN, gid = wgid / nig, fm = gid * wgm, gsz = (nM - fm) < wgm ? (nM - fm) : wgm;
    pm = fm + ((wgid % nig) % gsz); pn = (wgid % nig) / gsz;
}
struct PlainOrder {
    int nM, nN, G, c, wgm = WGM;
    __device__ __forceinline__ bool next(int i, Unit& u) const {
        const long L = (long)i * G + c; if (L >= (long)nM * nN) return false;
        tile_of((int)L, nM, nN, u.pm, u.pn, wgm); u.ta = u.pm; u.tb = u.pn; return true;
    }
};

typedef float f32x2_cv __attribute__((ext_vector_type(2))); typedef __bf16 bf16x2_cv __attribute__((ext_vector_type(2)));
__device__ __forceinline__ unsigned cvt_pk_bf16(float lo, float hi) { const f32x2_cv v = {lo, hi}; const bf16x2_cv b = __builtin_convertvector(v, bf16x2_cv); return __builtin_bit_cast(unsigned, b); }

template <class Epi, class Sched, bool ALIGN_EPI = true, bool SP2 = true, bool GATHER = false>
__device__ __forceinline__ void gemm_phase(LAS unsigned char* lds, const Gemm g, const Sched& S, const Epi& E, int wave_) {
    int tid_ = wave_ * 64 + lane_id(); asm volatile("" : "+v"(tid_));
    const int tid = tid_, wid = __builtin_amdgcn_readfirstlane(tid >> 6), lane = tid & 63, wr = wid >> 2, wc = wid & 3, fr = lane & 15, fq = lane >> 4;
    int K_ = g.K; asm volatile("" : "+s"(K_));
    const int K = K_, nt = K / BK;
    unsigned voffA[2], voffB[2];
#pragma unroll
    for (int i = 0; i < 2; ++i) { int R, C; stage_rc(tid * 16 + i * 8192, R, C); const int Rb = Epi::PERM ? ((R & ~31) + perm32(R & 31)) : R;
        voffA[i] = (unsigned)(R * K + C) * 2u; voffB[i] = (unsigned)(Rb * K + C) * 2u; }
    const size_t kstep = (size_t)(BK * 2);
    const size_t hstep = (size_t)HALF * K * 2;
    const size_t tstep = 2 * hstep;
    const unsigned ldsw = (unsigned)wid * 1024u;
    const int aoff = lds_byte(wr * 64 + fr, fq * 8), boff = lds_byte(wc * 32 + fr, fq * 8);
#define PG8_SA(b, h) (((b) * 2 + (h)) * HTB)
#define PG8_SB(b, h) ((4 + (b) * 2 + (h)) * HTB)
#define PG8_STAGE(bufoff, gbase, voff) do { _Pragma("unroll") for (int _i = 0; _i < 2; ++_i) \
        __builtin_amdgcn_global_load_lds((const unsigned*)((const char*)(gbase) + (voff)[_i]), (LAS unsigned*)(lds + (bufoff) + ldsw + _i * 8192), 16, 0, 0); } while (0)
#define PG8_LDA(dst, b, h) do { _Pragma("unroll") for (int m = 0; m < 4; ++m) _Pragma("unroll") for (int k = 0; k < 2; ++k) dst[m][k] = *(const LAS bf16x8*)(lds + PG8_SA(b, h) + aoff + m * 2048 + k * 1024); } while (0)
#define PG8_LDB(dst, b, h) do { _Pragma("unroll") for (int n = 0; n < 2; ++n) _Pragma("unroll") for (int k = 0; k < 2; ++k) dst[n][k] = *(const LAS bf16x8*)(lds + PG8_SB(b, h) + boff + n * 2048 + k * 1024); } while (0)
#define PG8_MMA(ai, bj, At, Bt) do { __builtin_amdgcn_s_setprio(1); _Pragma("unroll") for (int m = 0; m < 4; ++m) _Pragma("unroll") for (int n = 0; n < 2; ++n) _Pragma("unroll") for (int k = 0; k < 2; ++k) \
        acc[ai][bj][m][n] = __builtin_amdgcn_mfma_f32_16x16x32_bf16(Bt[n][k], At[m][k], acc[ai][bj][m][n], 0, 0, 0); __builtin_amdgcn_s_setprio(0); } while (0)
#define PG8_WAIT_V(n) asm volatile("s_waitcnt vmcnt(" #n ")" ::: "memory")
#define PG8_WAIT_L(n) asm volatile("s_waitcnt lgkmcnt(" #n ")" ::: "memory")
#define PG8_BAR __builtin_amdgcn_s_barrier()
#define PG8_SCHED __builtin_amdgcn_sched_barrier(0)
    static_assert(!GATHER || SP2, "row-gathered A staging is written for the two-super-phase loop");
    unsigned gc[2][2], gn[2][2];
#define PG8_GOFF(dst, U) do { if constexpr (GATHER) { _Pragma("unroll") for (int _h = 0; _h < 2; ++_h) _Pragma("unroll") for (int _i = 0; _i < 2; ++_i) { int R_, C_; stage_rc(tid * 16 + _i * 8192, R_, C_); \
        int rw_ = S.rowmap((U).ta * 256 + _h * 128 + R_); rw_ = rw_ < 0 ? 0 : rw_; dst[_h][_i] = (unsigned)(rw_ * K + C_) * 2u; } } } while (0)
#define PG8_STAGE_A(bufoff, gbase, half, usenext) do { if constexpr (GATHER) { unsigned vt_[2]; vt_[0] = (usenext) ? gn[half][0] : gc[half][0]; vt_[1] = (usenext) ? gn[half][1] : gc[half][1]; PG8_STAGE(bufoff, gbase, vt_); } \
        else { PG8_STAGE(bufoff, (gbase) + (half) * hstep, voffA); } } while (0)
    Unit cur, nxt; int ui = 0;
    if (!S.next(0, cur)) return;
    PG8_GOFF(gc, cur);
    f32x4 acc[2][2][4][2];
#pragma unroll
    for (int a = 0; a < 2; ++a)
#pragma unroll
        for (int b = 0; b < 2; ++b)
#pragma unroll
            for (int m = 0; m < 4; ++m)
#pragma unroll
                for (int n = 0; n < 2; ++n) acc[a][b][m][n] = (f32x4){0.f, 0.f, 0.f, 0.f};
    bf16x8 At[4][2], B0[2][2], B1[2][2];
    const char* cA = (const char*)g.A + (GATHER ? (size_t)0 : (size_t)cur.ta * tstep); const char* cB = (const char*)g.Bt + (size_t)cur.tb * tstep;
    if constexpr (SP2) {
        PG8_STAGE(PG8_SB(0, 0), cB, voffB); PG8_STAGE(PG8_SB(0, 1), cB + hstep, voffB); PG8_STAGE_A(PG8_SA(0, 0), cA, 0, false); PG8_STAGE_A(PG8_SA(0, 1), cA, 1, false);
        if (wr == 1) PG8_BAR;
        PG8_WAIT_V(2); PG8_BAR;
        PG8_STAGE(PG8_SB(1, 0), cB + kstep, voffB); PG8_STAGE_A(PG8_SA(1, 0), cA + kstep, 0, false); PG8_STAGE(PG8_SB(1, 1), cB + hstep + kstep, voffB);
        PG8_WAIT_V(6); PG8_BAR;
    } else {
        PG8_STAGE(PG8_SB(0, 0), cB, voffB); PG8_STAGE(PG8_SA(0, 0), cA, voffA); PG8_STAGE(PG8_SB(0, 1), cB + hstep, voffB); PG8_STAGE(PG8_SA(0, 1), cA + hstep, voffA);
        if (wr == 1) PG8_BAR;
        PG8_WAIT_V(4); PG8_BAR;
        PG8_STAGE(PG8_SB(1, 0), cB + kstep, voffB); PG8_STAGE(PG8_SA(1, 0), cA + kstep, voffA); PG8_STAGE(PG8_SB(1, 1), cB + hstep + kstep, voffB);
        PG8_WAIT_V(6); PG8_BAR;
    }
    for (;;) {
        const bool has_next = S.next(ui + 1, nxt);
        const char* nA = (has_next && !GATHER) ? (const char*)g.A + (size_t)nxt.ta * tstep : cA; const char* nB = has_next ? (const char*)g.Bt + (size_t)nxt.tb * tstep : cB;
        if (has_next) PG8_GOFF(gn, nxt);
        for (int t = 0; t < nt; t += 2) {
            const bool last = (t == nt - 2);
            const char* a1 = cA + (size_t)(t + 1) * kstep;
            const char* a2 = last ? nA : cA + (size_t)(t + 2) * kstep; const char* b2 = last ? nB : cB + (size_t)(t + 2) * kstep;
            const char* a3 = a2 + kstep; const char* b3 = b2 + kstep;
            if constexpr (SP2) {
            const bool un_ = last && has_next;
            PG8_LDB(B0, 0, 0); PG8_LDB(B1, 0, 1); PG8_SCHED; PG8_LDA(At, 0, 0); PG8_STAGE_A(PG8_SA(1, 1), a1, 1, false);
            PG8_WAIT_V(8); PG8_WAIT_L(0); PG8_BAR; PG8_MMA(0, 0, At, B0); PG8_MMA(0, 1, At, B1); PG8_BAR; PG8_SCHED;
            PG8_LDA(At, 0, 1); PG8_STAGE(PG8_SB(0, 0), b2, voffB); PG8_STAGE(PG8_SB(0, 1), b2 + hstep, voffB); PG8_STAGE_A(PG8_SA(0, 0), a2, 0, un_);
            PG8_WAIT_V(8); PG8_WAIT_L(0); PG8_BAR; PG8_MMA(1, 0, At, B0); PG8_MMA(1, 1, At, B1); PG8_BAR; PG8_SCHED;
            PG8_LDB(B0, 1, 0); PG8_LDB(B1, 1, 1); PG8_SCHED; PG8_LDA(At, 1, 0); PG8_STAGE_A(PG8_SA(0, 1), a2, 1, un_);
            PG8_WAIT_V(8); PG8_WAIT_L(0); PG8_BAR; PG8_MMA(0, 0, At, B0); PG8_MMA(0, 1, At, B1); PG8_BAR; PG8_SCHED;
            PG8_LDA(At, 1, 1); PG8_STAGE(PG8_SB(1, 0), b3, voffB); PG8_STAGE(PG8_SB(1, 1), b3 + hstep, voffB); PG8_STAGE_A(PG8_SA(1, 0), a3, 0, un_);
            PG8_WAIT_V(8); PG8_WAIT_L(0); PG8_BAR; PG8_MMA(1, 0, At, B0); PG8_MMA(1, 1, At, B1); PG8_BAR; PG8_SCHED;
            } else {
            PG8_LDB(B0, 0, 0); PG8_SCHED; PG8_LDA(At, 0, 0); PG8_STAGE(PG8_SA(1, 1), a1 + hstep, voffA);
            PG8_WAIT_L(8); PG8_BAR; PG8_WAIT_L(0); PG8_MMA(0, 0, At, B0); PG8_BAR; PG8_SCHED;
            PG8_LDB(B1, 0, 1); PG8_STAGE(PG8_SB(0, 0), b2, voffB);
            PG8_BAR; PG8_WAIT_L(0); PG8_MMA(0, 1, At, B1); PG8_BAR;
            PG8_LDA(At, 0, 1); PG8_STAGE(PG8_SA(0, 0), a2, voffA);
            PG8_BAR; PG8_WAIT_L(0); PG8_MMA(1, 0, At, B0); PG8_BAR; PG8_SCHED;
            PG8_STAGE(PG8_SB(0, 1), b2 + hstep, voffB);
            PG8_WAIT_V(6); PG8_BAR; PG8_MMA(1, 1, At, B1); PG8_BAR;
            PG8_LDB(B0, 1, 0); PG8_SCHED; PG8_LDA(At, 1, 0); PG8_STAGE(PG8_SA(0, 1), a2 + hstep, voffA);
            PG8_WAIT_L(8); PG8_BAR; PG8_WAIT_L(0); PG8_MMA(0, 0, At, B0); PG8_BAR; PG8_SCHED;
            PG8_LDB(B1, 1, 1); PG8_STAGE(PG8_SB(1, 0), b3, voffB);
            PG8_BAR; PG8_WAIT_L(0); PG8_MMA(0, 1, At, B1); PG8_BAR;
            PG8_LDA(At, 1, 1); PG8_STAGE(PG8_SA(1, 0), a3, voffA);
            PG8_BAR; PG8_WAIT_L(0); PG8_MMA(1, 0, At, B0); PG8_BAR; PG8_SCHED;
            PG8_STAGE(PG8_SB(1, 1), b3 + hstep, voffB);
            PG8_WAIT_V(6); PG8_BAR; PG8_MMA(1, 1, At, B1); PG8_BAR;
            }
        }
        if constexpr (ALIGN_EPI) { if (wr == 0) PG8_BAR; }
        E(acc, cur, wr, wc, fr, fq);
        if (!has_next) break;
#pragma unroll
        for (int a = 0; a < 2; ++a)
#pragma unroll
            for (int b = 0; b < 2; ++b)
#pragma unroll
                for (int m = 0; m < 4; ++m)
#pragma unroll
                    for (int n = 0; n < 2; ++n) acc[a][b][m][n] = (f32x4){0.f, 0.f, 0.f, 0.f};
        cur = nxt; cA = nA; cB = nB; ++ui;
        if constexpr (GATHER) { _Pragma("unroll") for (int _h = 0; _h < 2; ++_h) _Pragma("unroll") for (int _i = 0; _i < 2; ++_i) gc[_h][_i] = gn[_h][_i]; }
        if constexpr (ALIGN_EPI) { if (wr == 1) PG8_BAR; }
    }
    PG8_WAIT_V(0);
    if constexpr (!ALIGN_EPI) { if (wr == 0) PG8_BAR; }
    PG8_BAR;
#undef PG8_SA
#undef PG8_SB
#undef PG8_STAGE
#undef PG8_STAGE_A
#undef PG8_GOFF
#undef PG8_LDA
#undef PG8_LDB
#undef PG8_MMA
#undef PG8_WAIT_V
#undef PG8_WAIT_L
#undef PG8_BAR
#undef PG8_SCHED
}
}

struct LaneT { int r, c, to_acc; };
__device__ __forceinline__ LaneT lane_t() { const int l = lane_id(); LaneT t; t.r = l >> 2; t.c = l & 3; t.to_acc = ((l & 15) * 4 + (l >> 4)) * 4; return t; }
__device__ __forceinline__ u32x4 bperm4(const u32x4 v, int src) { u32x4 r;
    r.x = (unsigned)__builtin_amdgcn_ds_bpermute(src, (int)v.x); r.y = (unsigned)__builtin_amdgcn_ds_bpermute(src, (int)v.y);
    r.z = (unsigned)__builtin_amdgcn_ds_bpermute(src, (int)v.z); r.w = (unsigned)__builtin_amdgcn_ds_bpermute(src, (int)v.w); return r; }
using pg8::Unit; using pg8::cvt_pk_bf16;
__device__ __forceinline__ float rstd_from4(const f32x4 a) { return rsqrtf(((a[0] + a[1]) + (a[2] + a[3])) * (1.0f / 1024.0f) + EPS); }
constexpr int SSQ_TAB_OFF = 131072 + 9216;
__device__ __forceinline__ u32x4 pack8(const f32x4 v0, const f32x4 v1) { u32x4 w; w.x = cvt_pk_bf16(v0[0], v0[1]); w.y = cvt_pk_bf16(v0[2], v0[3]); w.z = cvt_pk_bf16(v1[0], v1[1]); w.w = cvt_pk_bf16(v1[2], v1[3]); return w; }
__device__ __forceinline__ void unpack8v(const u32x4 w, f32x4& v0, f32x4& v1) { v0 = (f32x4){bflo(w.x), bfhi(w.x), bflo(w.y), bfhi(w.y)}; v1 = (f32x4){bflo(w.z), bfhi(w.z), bflo(w.w), bfhi(w.w)}; }
__device__ __forceinline__ f32x4 sig4(const f32x4 x) { return (f32x4){sigmoidf_(x[0]), sigmoidf_(x[1]), sigmoidf_(x[2]), sigmoidf_(x[3])}; }


__device__ __forceinline__ void ssq_tile_reduce(const float (&ss)[2][4], float* ssq_out, const int* rowtok, int pm, int pn, int wr, int wc, int fr, int fq) {
    LAS float* tab = (LAS float*)(uintptr_t)SSQ_TAB_OFF;
    if (fq == 0) {
#pragma unroll
        for (int ai = 0; ai < 2; ++ai)
#pragma unroll
            for (int m = 0; m < 4; ++m) tab[(ai * 128 + wr * 64 + m * 16 + fr) * 4 + wc] = ss[ai][m]; }
    asm volatile("s_waitcnt lgkmcnt(0)" ::: "memory"); __builtin_amdgcn_s_barrier(); asm volatile("" ::: "memory");
    const int r = (wr * 4 + wc) * 64 + fq * 16 + fr;
    if (r < 256) { const f32x4 p = *(const LAS f32x4*)(tab + r * 4); const float t = (p[0] + p[1]) + (p[2] + p[3]);
        if (rowtok) { const int tok = rowtok[pm * 256 + r]; if (tok >= 0) ssq_out[(size_t)tok * 4 + pn] = t; }
        else ssq_out[(size_t)(pm * 256 + r) * 4 + pn] = t; }
}
struct EpiZ {
    static constexpr bool PERM = true;
    bf16_t* Z; const float* ssq; const float* lbl; bf16_t* GZT; bf16_t* IKT;
    __device__ __forceinline__ void operator()(const f32x4 (&acc)[2][2][4][2], const Unit& u, int wr, int wc, int fr, int fq) const {
        const int row0 = u.pm * 256 + wr * 64 + fr, col0 = u.pn * 256 + wc * 32 + 8 * fq;
        const int kind = (u.pn < 2 || u.pn == 6 || u.pn == 7) ? 1 : ((u.pn == 2 || u.pn == 3) ? 2 : 0);
        const bool tiled = u.pn >= GZ_PN0;
        bf16_t* tb = GZT + ((size_t)(u.pm * 12 + (u.pn - GZ_PN0)) << 16) + ((wr * 4 + wc) * 64 + fq * 16 + fr) * 8;
        f32x4 lbv[2][2];
        if (kind == 2) {
#pragma unroll
            for (int bj = 0; bj < 2; ++bj) { lbv[bj][0] = *(const f32x4*)(lbl + col0 - 512 + bj * 128); lbv[bj][1] = *(const f32x4*)(lbl + col0 - 512 + bj * 128 + 4); } }
        f32x4 part[2][4];
#pragma unroll
        for (int ai = 0; ai < 2; ++ai)
#pragma unroll
            for (int m = 0; m < 4; ++m) part[ai][m] = *(const f32x4*)(ssq + (size_t)(row0 + ai * 128 + m * 16) * 4);
#pragma unroll
        for (int ai = 0; ai < 2; ++ai)
#pragma unroll
            for (int m = 0; m < 4; ++m) { const int row = row0 + ai * 128 + m * 16; const float rs = rstd_from4(part[ai][m]); bf16_t* rowp = Z + (size_t)row * ZP + col0;
#pragma unroll
                for (int bj = 0; bj < 2; ++bj) { f32x4 v0 = acc[ai][bj][m][0] * rs, v1 = acc[ai][bj][m][1] * rs;
                    if (kind == 1) {
#pragma unroll
                        for (int j = 0; j < 4; ++j) { v0[j] = v0[j] * __builtin_amdgcn_rcpf(1.f + __expf(-v0[j])); v1[j] = v1[j] * __builtin_amdgcn_rcpf(1.f + __expf(-v1[j])); } }
                    else if (kind == 2) {
#pragma unroll
                        for (int j = 0; j < 4; ++j) { const float l0 = lbv[bj][0][j], l1 = lbv[bj][1][j];
                            v0[j] = __logf(l0 + (1.f - l0) * __builtin_amdgcn_rcpf(1.f + __expf(-v0[j]))); v1[j] = __logf(l1 + (1.f - l1) * __builtin_amdgcn_rcpf(1.f + __expf(-v1[j]))); } }
                    bf16_t* dst = tiled ? tb + ((ai * 4 + m) * 2 + bj) * 4096 : rowp + bj * 128;
                    if (u.pn == C_IK / 256 && bj == 1 && wc < 2) dst = IKT + ((size_t)((u.pm * 16 + ai * 8 + wr * 4 + m) * 2 + wc) * 64 + fq * 16 + fr) * 8;
                    *(u32x4*)dst = pack8(v0, v1); } }
    }
};
struct EpiRes {
    static constexpr bool PERM = true;
    const bf16_t* HIN; bf16_t* HOUT; float* ssq;
    __device__ __forceinline__ void operator()(const f32x4 (&acc)[2][2][4][2], const Unit& u, int wr, int wc, int fr, int fq) const {
        const int row0 = u.pm * 256 + wr * 64 + fr, col0 = u.pn * 256 + wc * 32 + 8 * fq;
        const LaneT LT = lane_t(); float ssv[2][4];
#pragma unroll
        for (int ai = 0; ai < 2; ++ai) {
            u32x4 hv[4][2];
#pragma unroll
            for (int m = 0; m < 4; ++m)
#pragma unroll
                for (int bj = 0; bj < 2; ++bj) hv[m][bj] = *(const u32x4*)(HIN + (size_t)(row0 - fr + LT.r + ai * 128 + m * 16) * D + (col0 - 8 * fq + 8 * LT.c) + bj * 128);
#pragma unroll
            for (int m = 0; m < 4; ++m) { const int row = row0 + ai * 128 + m * 16; bf16_t* bp = HOUT + (size_t)row * D + col0; float ss = 0.f;
#pragma unroll
                for (int bj = 0; bj < 2; ++bj) { f32x4 v0, v1; unpack8v(bperm4(hv[m][bj], LT.to_acc), v0, v1); v0 += acc[ai][bj][m][0]; v1 += acc[ai][bj][m][1];
                    *(u32x4*)(bp + bj * 128) = pack8(v0, v1);
                    ss += (v0[0] * v0[0] + v0[1] * v0[1]) + (v0[2] * v0[2] + v0[3] * v0[3]) + (v1[0] * v1[0] + v1[1] * v1[1]) + (v1[2] * v1[2] + v1[3] * v1[3]); }
                ss += __shfl_xor(ss, 16); ss += __shfl_xor(ss, 32); ssv[ai][m] = ss; } }
        ssq_tile_reduce(ssv, ssq, nullptr, u.pm, u.pn, wr, wc, fr, fq);
    }
};
struct EpiGU {
    static constexpr bool PERM = true;
    bf16_t* HM; const float* ssq; const float* rowrstd;
    __device__ __forceinline__ void operator()(const f32x4 (&acc)[2][2][4][2], const Unit& u, int wr, int wc, int fr, int fq) const {
        const int row0 = u.pm * 256 + wr * 64 + fr, col0 = u.pn * 128 + wc * 32 + 8 * fq;
        float rsv[2][4];
        if (rowrstd) {
#pragma unroll
            for (int ai = 0; ai < 2; ++ai)
#pragma unroll
                for (int m = 0; m < 4; ++m) rsv[ai][m] = rowrstd[row0 + ai * 128 + m * 16];
        } else { f32x4 part[2][4];
#pragma unroll
            for (int ai = 0; ai < 2; ++ai)
#pragma unroll
                for (int m = 0; m < 4; ++m) part[ai][m] = *(const f32x4*)(ssq + (size_t)(row0 + ai * 128 + m * 16) * 4);
#pragma unroll
            for (int ai = 0; ai < 2; ++ai)
#pragma unroll
                for (int m = 0; m < 4; ++m) rsv[ai][m] = rstd_from4(part[ai][m]); }
#pragma unroll
        for (int ai = 0; ai < 2; ++ai)
#pragma unroll
            for (int m = 0; m < 4; ++m) { const int row = row0 + ai * 128 + m * 16; const float rs = rsv[ai][m];
                f32x4 o0, o1;
#pragma unroll
                for (int j = 0; j < 4; ++j) { const float g0 = acc[ai][0][m][0][j] * rs, g1 = acc[ai][0][m][1][j] * rs; o0[j] = siluf_(g0) * (acc[ai][1][m][0][j] * rs); o1[j] = siluf_(g1) * (acc[ai][1][m][1][j] * rs); }
                *(u32x4*)(HM + (size_t)row * DFF + col0) = pack8(o0, o1); }
    }
};
struct EpiMerge {
    static constexpr bool PERM = true;
    bf16_t* MG; const bf16_t* GZT; bf16_t* PT;
    __device__ __forceinline__ void operator()(const f32x4 (&acc)[2][2][4][2], const Unit& u, int wr, int wc, int fr, int fq) const {
        const int br = u.pn >> 2, pn = u.pn & 3;
        const int row0 = u.pm * 256 + wr * 64 + fr, col0 = pn * 256 + wc * 32 + 8 * fq, lo = ((wr * 4 + wc) * 64 + fq * 16 + fr) * 8;
        const bf16_t* gt = GZT + ((size_t)(u.pm * 12 + u.pn) << 16) + lo; bf16_t* pt = PT + ((size_t)(u.pm * 4 + pn) << 16) + lo;
#pragma unroll
        for (int ai = 0; ai < 2; ++ai) {
            u32x4 gv[4][2], pv[4][2];
#pragma unroll
            for (int m = 0; m < 4; ++m)
#pragma unroll
                for (int bj = 0; bj < 2; ++bj) gv[m][bj] = *(const u32x4*)(gt + ((ai * 4 + m) * 2 + bj) * 4096);
            if (br > 0) {
#pragma unroll
                for (int m = 0; m < 4; ++m)
#pragma unroll
                    for (int bj = 0; bj < 2; ++bj) pv[m][bj] = *(const u32x4*)(pt + ((ai * 4 + m) * 2 + bj) * 4096); }
#pragma unroll
            for (int m = 0; m < 4; ++m) { const int row = row0 + ai * 128 + m * 16; bf16_t* mp = MG + (size_t)row * D + col0;
#pragma unroll
                for (int bj = 0; bj < 2; ++bj) { f32x4 g0, g1; unpack8v(gv[m][bj], g0, g1);
                    f32x4 v0 = sig4(g0) * acc[ai][bj][m][0], v1 = sig4(g1) * acc[ai][bj][m][1];
                    if (br > 0) { f32x4 p0, p1; unpack8v(pv[m][bj], p0, p1); v0 += p0; v1 += p1; }
                    *(u32x4*)(br < 2 ? pt + ((ai * 4 + m) * 2 + bj) * 4096 : mp + bj * 128) = pack8(v0, v1); } } }
    }
};
struct EpiBf {
    static constexpr bool PERM = true;
    bf16_t* O;
    __device__ __forceinline__ void operator()(const f32x4 (&acc)[2][2][4][2], const Unit& u, int wr, int wc, int fr, int fq) const {
        bf16_t* ot = O + ((size_t)(u.pm * 4 + u.pn) << 16) + ((wr * 4 + wc) * 64 + fq * 16 + fr) * 8;
#pragma unroll
        for (int ai = 0; ai < 2; ++ai)
#pragma unroll
            for (int m = 0; m < 4; ++m)
#pragma unroll
                for (int bj = 0; bj < 2; ++bj) *(u32x4*)(ot + ((ai * 4 + m) * 2 + bj) * 4096) = pack8(acc[ai][bj][m][0], acc[ai][bj][m][1]);
    }
};
struct EpiPle {
    static constexpr bool PERM = true;
    const bf16_t* HIN; bf16_t* HOUT; float* ssq_out; const float* ssq_in; const bf16_t* PP;
    __device__ __forceinline__ void operator()(const f32x4 (&acc)[2][2][4][2], const Unit& u, int wr, int wc, int fr, int fq) const {
        const int row0 = u.pm * 256 + wr * 64 + fr, col0 = u.pn * 256 + wc * 32 + 8 * fq;
        const LaneT LT = lane_t(); const bf16_t* ppt = PP + ((size_t)(u.pm * 4 + u.pn) << 16) + ((wr * 4 + wc) * 64 + fq * 16 + fr) * 8;
        float rsv[2][4], ssv[2][4];
        { f32x4 part[2][4];
#pragma unroll
        for (int ai = 0; ai < 2; ++ai)
#pragma unroll
            for (int m = 0; m < 4; ++m) part[ai][m] = *(const f32x4*)(ssq_in + (size_t)(row0 + ai * 128 + m * 16) * 4);
#pragma unroll
        for (int ai = 0; ai < 2; ++ai)
#pragma unroll
            for (int m = 0; m < 4; ++m) rsv[ai][m] = rstd_from4(part[ai][m]); }
#pragma unroll
        for (int aim = 0; aim < 4; ++aim) { const int ai = aim >> 1, mb = (aim & 1) * 2;
            u32x4 qv[4][2], hv[4][2];
#pragma unroll
            for (int m = mb; m < mb + 2; ++m)
#pragma unroll
                for (int bj = 0; bj < 2; ++bj) { const size_t o = (size_t)(row0 + ai * 128 + m * 16) * D + col0 + bj * 128, ot_ = (size_t)(row0 - fr + LT.r + ai * 128 + m * 16) * D + (col0 - 8 * fq + 8 * LT.c) + bj * 128; qv[m][bj] = *(const u32x4*)(ppt + ((ai * 4 + m) * 2 + bj) * 4096); hv[m][bj] = *(const u32x4*)(HIN + ot_); (void)o; }
#pragma unroll
            for (int m = mb; m < mb + 2; ++m) { const int row = row0 + ai * 128 + m * 16; const float rs = rsv[ai][m];
                bf16_t* bp = HOUT + (size_t)row * D + col0; float ss = 0.f;
#pragma unroll
                for (int bj = 0; bj < 2; ++bj) { f32x4 p0, p1, v0, v1; unpack8v(qv[m][bj], p0, p1); unpack8v(bperm4(hv[m][bj], LT.to_acc), v0, v1);
                    v0 += sig4(acc[ai][bj][m][0] * rs) * p0; v1 += sig4(acc[ai][bj][m][1] * rs) * p1;
                    *(u32x4*)(bp + bj * 128) = pack8(v0, v1);
                    ss += (v0[0] * v0[0] + v0[1] * v0[1]) + (v0[2] * v0[2] + v0[3] * v0[3]) + (v1[0] * v1[0] + v1[1] * v1[1]) + (v1[2] * v1[2] + v1[3] * v1[3]); }
                ss += __shfl_xor(ss, 16); ss += __shfl_xor(ss, 32); ssv[ai][m] = ss; } }
        ssq_tile_reduce(ssv, ssq_out, nullptr, u.pm, u.pn, wr, wc, fr, fq);
    }
};
template <int RANK> struct EpiMoeDown {
    static constexpr bool PERM = true;
    bf16_t* HB; float* ssq; const int* rowtok; const float* roww;
    __device__ __forceinline__ void operator()(const f32x4 (&acc)[2][2][4][2], const Unit& u, int wr, int wc, int fr, int fq) const {
        const int row0 = u.pm * 256 + wr * 64 + fr, col0 = u.pn * 256 + wc * 32 + 8 * fq;
        int tk[2][4]; float ssv[2][4];
#pragma unroll
        for (int ai = 0; ai < 2; ++ai)
#pragma unroll
            for (int m = 0; m < 4; ++m) tk[ai][m] = rowtok[row0 + ai * 128 + m * 16];
#pragma unroll
        for (int ai = 0; ai < 2; ++ai) {
            u32x4 hv[4][2]; float wv[4];
#pragma unroll
            for (int m = 0; m < 4; ++m) { const int tok = tk[ai][m] < 0 ? 0 : tk[ai][m]; wv[m] = roww[row0 + ai * 128 + m * 16];
#pragma unroll
                for (int bj = 0; bj < 2; ++bj) hv[m][bj] = *(const u32x4*)(HB + (size_t)tok * D + col0 + bj * 128); }
#pragma unroll
            for (int m = 0; m < 4; ++m) { const int tok = tk[ai][m]; const float w = wv[m];
                float ss = 0.f;
                if (tok >= 0) { bf16_t* bp = HB + (size_t)tok * D + col0;
#pragma unroll
                    for (int bj = 0; bj < 2; ++bj) { f32x4 v0, v1; unpack8v(hv[m][bj], v0, v1); v0 += acc[ai][bj][m][0] * w; v1 += acc[ai][bj][m][1] * w;
                        *(u32x4*)(bp + bj * 128) = pack8(v0, v1);
                        if (RANK == 1) ss += (v0[0] * v0[0] + v0[1] * v0[1]) + (v0[2] * v0[2] + v0[3] * v0[3]) + (v1[0] * v1[0] + v1[1] * v1[1]) + (v1[2] * v1[2] + v1[3] * v1[3]); } }
                if (RANK == 1) { ss += __shfl_xor(ss, 16); ss += __shfl_xor(ss, 32); ssv[ai][m] = ss; } } }
        if (RANK == 1) ssq_tile_reduce(ssv, ssq, rowtok, u.pm, u.pn, wr, wc, fr, fq);
    }
};

struct EpiMoeDownM {
    static constexpr bool PERM = true;
    bf16_t* HB; bf16_t* Y1; const int* rowtok; const float* roww; int rsplit;
    __device__ __forceinline__ void operator()(const f32x4 (&acc)[2][2][4][2], const Unit& u, int wr, int wc, int fr, int fq) const {
        const int row0 = u.pm * 256 + wr * 64 + fr, col0 = u.pn * 256 + wc * 32 + 8 * fq;
        int tk[2][4];
#pragma unroll
        for (int ai = 0; ai < 2; ++ai)
#pragma unroll
            for (int m = 0; m < 4; ++m) tk[ai][m] = rowtok[row0 + ai * 128 + m * 16];
        if (u.pm < rsplit) { const LaneT LT = lane_t();
#pragma unroll
            for (int ai = 0; ai < 2; ++ai) {
                u32x4 hv[4][2]; float wv[4];
#pragma unroll
                for (int m = 0; m < 4; ++m) { int tok = rowtok[row0 - fr + LT.r + ai * 128 + m * 16]; tok = tok < 0 ? 0 : tok; wv[m] = roww[row0 + ai * 128 + m * 16];
#pragma unroll
                    for (int bj = 0; bj < 2; ++bj) hv[m][bj] = *(const u32x4*)(HB + (size_t)tok * D + (col0 - 8 * fq + 8 * LT.c) + bj * 128); }
#pragma unroll
                for (int m = 0; m < 4; ++m) { const int tok = tk[ai][m]; const float w = wv[m];
                    const u32x4 hvt[2] = {bperm4(hv[m][0], LT.to_acc), bperm4(hv[m][1], LT.to_acc)};
                    if (tok >= 0) { bf16_t* bp = HB + (size_t)tok * D + col0;
#pragma unroll
                        for (int bj = 0; bj < 2; ++bj) { f32x4 v0, v1; unpack8v(hvt[bj], v0, v1); v0 += acc[ai][bj][m][0] * w; v1 += acc[ai][bj][m][1] * w; *(u32x4*)(bp + bj * 128) = pack8(v0, v1); } } } }
        } else {
#pragma unroll
            for (int ai = 0; ai < 2; ++ai)
#pragma unroll
                for (int m = 0; m < 4; ++m) { const int tok = tk[ai][m]; const float w = roww[row0 + ai * 128 + m * 16];
                    if (tok >= 0) { bf16_t* yp = Y1 + (size_t)tok * D + col0;
#pragma unroll
                        for (int bj = 0; bj < 2; ++bj) *(u32x4*)(yp + bj * 128) = pack8(acc[ai][bj][m][0] * w, acc[ai][bj][m][1] * w); } }
        }
    }
};
struct EpiPpComb {
    static constexpr bool PERM = true;
    bf16_t* PP; bf16_t* HB; const bf16_t* Y1; float* ssq;
    __device__ __forceinline__ void operator()(const f32x4 (&acc)[2][2][4][2], const Unit& u, int wr, int wc, int fr, int fq) const {
        const int row0 = u.pm * 256 + wr * 64 + fr, col0 = u.pn * 256 + wc * 32 + 8 * fq;
        const LaneT LT = lane_t(); bf16_t* ot = PP + ((size_t)(u.pm * 4 + u.pn) << 16) + ((wr * 4 + wc) * 64 + fq * 16 + fr) * 8;
        float ssv[2][4];
#pragma unroll
        for (int ai = 0; ai < 2; ++ai) {
            u32x4 hv[4][2], yv[4][2];
#pragma unroll
            for (int m = 0; m < 4; ++m)
#pragma unroll
                for (int bj = 0; bj < 2; ++bj) { const size_t o = (size_t)(row0 - fr + LT.r + ai * 128 + m * 16) * D + (col0 - 8 * fq + 8 * LT.c) + bj * 128; hv[m][bj] = *(const u32x4*)(HB + o); yv[m][bj] = *(const u32x4*)(Y1 + o); }
#pragma unroll
            for (int m = 0; m < 4; ++m) { const int row = row0 + ai * 128 + m * 16; float ss = 0.f;
#pragma unroll
                for (int bj = 0; bj < 2; ++bj) { *(u32x4*)(ot + ((ai * 4 + m) * 2 + bj) * 4096) = pack8(acc[ai][bj][m][0], acc[ai][bj][m][1]);
                    f32x4 v0, v1, y0, y1; unpack8v(bperm4(hv[m][bj], LT.to_acc), v0, v1); unpack8v(bperm4(yv[m][bj], LT.to_acc), y0, y1); v0 += y0; v1 += y1;
                    *(u32x4*)(HB + (size_t)row * D + col0 + bj * 128) = pack8(v0, v1);
                    ss += (v0[0] * v0[0] + v0[1] * v0[1]) + (v0[2] * v0[2] + v0[3] * v0[3]) + (v1[0] * v1[0] + v1[1] * v1[1]) + (v1[2] * v1[2] + v1[3] * v1[3]); }
                ss += __shfl_xor(ss, 16); ss += __shfl_xor(ss, 32); ssv[ai][m] = ss; } }
        ssq_tile_reduce(ssv, ssq, nullptr, u.pm, u.pn, wr, wc, fr, fq);
    }
};

#define XB_TMO      128
#define XB_XCNT(j)  (256  + 64 * (j))
#define XB_XSUB(j)  (1280 + 64 * (j))
#define XB_XGEN(j)  (2304 + 64 * (j))
#define XB_TOP      3328
#define XB_TOPGEN   3392
#define XCD_BAR_WORDS 3456
#define XB_SPIN_CAP (1u << 20)

__device__ __forceinline__ unsigned xb_ld(unsigned* p)              { return __hip_atomic_load(p, __ATOMIC_RELAXED, __HIP_MEMORY_SCOPE_AGENT); }
__device__ __forceinline__ unsigned xb_add(unsigned* p, unsigned v) { return __hip_atomic_fetch_add(p, v, __ATOMIC_RELAXED, __HIP_MEMORY_SCOPE_AGENT); }
__device__ __forceinline__ unsigned xb_xcc_id() { return (unsigned)__builtin_amdgcn_s_getreg((3 << 11) | 20) & 0xFu; }
#define XB_SPIN(cond, bar) do { unsigned _sp = 0; while (cond) { __builtin_amdgcn_s_sleep(1); \
    if ((++_sp & 255u) == 0u) { if (xb_ld(&(bar)[XB_TMO])) break; if (_sp > XB_SPIN_CAP) { atomicAdd(&(bar)[XB_TMO], 1u); break; } } } } while (0)

struct XcdBarrier { unsigned* bar; unsigned x; volatile LAS unsigned* st; };

__device__ __forceinline__ XcdBarrier xcd_barrier_post(unsigned* bar, volatile LAS unsigned* st) {
    XcdBarrier b; b.bar = bar; b.x = xb_xcc_id(); b.st = st;
    if (threadIdx.x == 0) (void)xb_add(&bar[XB_XCNT(b.x)], 1u);
    return b;
}
__device__ __forceinline__ void xcd_barrier_complete(unsigned* bar, unsigned x, unsigned& nloc, unsigned& nx) {
    const unsigned G = gridDim.x * gridDim.y * gridDim.z;
    unsigned sum, cnt, mine, sp = 0u;
    for (;;) {
        sum = 0u; cnt = 0u; mine = 0u;
#pragma unroll
        for (unsigned j = 0; j < 16; ++j) { const unsigned c = xb_ld(&bar[XB_XCNT(j)]); sum += c; cnt += (c > 0u) ? 1u : 0u; mine = (j == x) ? c : mine; }
        if (sum == G) break;
        __builtin_amdgcn_s_sleep(1);
        if ((++sp & 255u) == 0u) { if (xb_ld(&bar[XB_TMO])) break; if (sp > XB_SPIN_CAP) { atomicAdd(&bar[XB_TMO], 1u); break; } }
    }
    nloc = mine > 0u ? mine : 1u; nx = cnt > 0u ? cnt : 1u;
}
__device__ __forceinline__ void xcd_barrier(const XcdBarrier& b, int wave_) {
    asm volatile("s_waitcnt vmcnt(0)" ::: "memory");
    __syncthreads();
    if (wave_ == 0 && lane_id() == 0) {
        unsigned* bar = b.bar;
        __builtin_amdgcn_s_waitcnt(0);
        unsigned nloc = b.st[0], nx = b.st[1];
        if (nloc == 0u) { xcd_barrier_complete(bar, b.x, nloc, nx); b.st[0] = nloc; b.st[1] = nx; }
        const unsigned old = xb_add(&bar[XB_XSUB(b.x)], 1u);
        const unsigned gen = old / nloc;
        if (old + 1u == (gen + 1u) * nloc) {
            __builtin_amdgcn_fence(__ATOMIC_RELEASE, "agent");
            asm volatile("s_waitcnt vmcnt(0)" ::: "memory");
            const unsigned og = xb_add(&bar[XB_TOP], 1u);
            const unsigned tg = og / nx;
            if (og + 1u == (tg + 1u) * nx) xb_add(&bar[XB_TOPGEN], 1u);
            else XB_SPIN(xb_ld(&bar[XB_TOPGEN]) == tg, bar);
            __builtin_amdgcn_fence(__ATOMIC_ACQUIRE, "agent");
            xb_add(&bar[XB_XGEN(b.x)], 1u);
            asm volatile("s_waitcnt vmcnt(0)" ::: "memory");
        } else {
            XB_SPIN(xb_ld(&bar[XB_XGEN(b.x)]) == gen, bar);
            __builtin_amdgcn_fence(__ATOMIC_ACQUIRE, "agent");
            asm volatile("s_waitcnt vmcnt(0)" ::: "memory");
        }
    }
    __syncthreads();
}

constexpr int RING_BYTES = 131072;
constexpr int LDS_BYTES = 147456;
constexpr int LDSCTL_OFF = LDS_BYTES - 1024;

struct Frame {
    unsigned char* lds; LAS unsigned char* lds3; volatile LAS unsigned* lctl;
    unsigned* ctl; unsigned char* ws;
    int tid, lane, wave, G, bid, wave0;
    __device__ __forceinline__ int og() const { int g = G; asm volatile("" : "+s"(g)); return g; }
    __device__ __forceinline__ void retid() { int t = wave0 * 64 + lane_id(); asm volatile("" : "+v"(t)); tid = t; lane = t & 63; wave = __builtin_amdgcn_readfirstlane(t >> 6); }
};
#define LDS_WAIT() asm volatile("s_waitcnt lgkmcnt(0)" ::: "memory")

__device__ __forceinline__ int conv_rowmap(int mode, int n) {
    if (mode == 1) return n < 3008 ? n : (n < 3012 ? C_IW + (n - 3008) : (n < 4548 ? n - 4 : n + 60));
    if (mode == 2) return 256 * (n >> 7) + (n & 127);
    if (mode == 3) return 256 * (n >> 7) + 128 + (n & 127);
    return n;
}
__device__ __forceinline__ void conv_item(const float* W, int K, int N, const float* ksc, bf16_t* WT, int mode, float* scr, int item, int lane) {
    const int nblk = (N + 31) / 32, kb = item / nblk, nb = item % nblk, k0 = 64 * kb, n0 = 32 * nb;
    const int c4 = (lane & 7) * 4, nl = n0 + c4; const bool nv = nl < N;
#pragma unroll
    for (int i = 0; i < 8; ++i) { const int kk = 8 * i + (lane >> 3); f32x4 v = (f32x4){0.f, 0.f, 0.f, 0.f};
        if (nv) { v = *(const f32x4*)(W + (size_t)(k0 + kk) * N + nl); if (ksc) v = v * ksc[k0 + kk]; }
        float* sp = scr + kk * 33 + c4; sp[0] = v[0]; sp[1] = v[1]; sp[2] = v[2]; sp[3] = v[3]; }
    LDS_WAIT(); __builtin_amdgcn_wave_barrier();
    const int c = lane & 7;
#pragma unroll
    for (int j = 0; j < 4; ++j) { const int n = (lane >> 3) + 8 * j; const int ng = n0 + n;
        if (ng < N) { const float* s = scr + (8 * c) * 33 + n; uint4 o; o.x = pk2(s[0 * 33], s[1 * 33]); o.y = pk2(s[2 * 33], s[3 * 33]); o.z = pk2(s[4 * 33], s[5 * 33]); o.w = pk2(s[6 * 33], s[7 * 33]);
            *(uint4*)(WT + (size_t)conv_rowmap(mode, ng) * K + k0 + 8 * c) = o; } }
    LDS_WAIT(); __builtin_amdgcn_wave_barrier();
}
template <class IN> __device__ __forceinline__ void phase_prologue(Frame& F, const IN in) {
    F.retid();
    float* scr = (float*)(F.lds + F.wave * 16384);
    const int gw = F.bid * NWAVES + F.wave, NGW = F.og() * NWAVES;
    constexpr int NT = 11;
    const int tcount[NT] = {4, 12, 4, 2, 2, 2, 16, 16, 16, 4, 4};
    const int titems[NT] = {16 * 239, 8 * 32, 16 * 32, 16 * 88, 16 * 88, 44 * 32, 16 * 88, 16 * 88, 44 * 32, 16 * 32, 4 * 32};
    int total = 0;
#pragma unroll
    for (int t = 0; t < NT; ++t) total += tcount[t] * titems[t];
    for (int it = gw; it < total; it += NGW) {
        int r = it, t = 0;
#pragma unroll
        for (int q = 0; q < NT - 1; ++q) { if (t == q && r >= tcount[q] * titems[q]) { r -= tcount[q] * titems[q]; t = q + 1; } }
        const int mi = r / titems[t], item = r % titems[t];
        const float* W; int K, N, mode = 0; const float* ksc = nullptr; bf16_t* WT;
        switch (t) {
        case 0: W = in[4] + (size_t)mi * D * IN_W; K = D; N = IN_W; ksc = in[3] + mi * D; WT = (bf16_t*)(F.ws + WS_WIN + mi * SZ_WIN); mode = 1; break;
        case 1: W = in[9] + (size_t)mi * 512 * D; K = 512; N = D; WT = (bf16_t*)(F.ws + WS_WBR + (size_t)mi * D * 512 * 2); break;
        case 2: W = in[10] + (size_t)mi * D * D; K = D; N = D; WT = (bf16_t*)(F.ws + WS_WOUT + mi * SZ_WOUT); break;
        case 3: W = in[12] + (size_t)mi * D * DFF; K = D; N = DFF; ksc = in[11] + (2 * mi) * D; WT = (bf16_t*)(F.ws + WS_WDGU + mi * SZ_WGU); mode = 2; break;
        case 4: W = in[13] + (size_t)mi * D * DFF; K = D; N = DFF; ksc = in[11] + (2 * mi) * D; WT = (bf16_t*)(F.ws + WS_WDGU + mi * SZ_WGU); mode = 3; break;
        case 5: W = in[14] + (size_t)mi * DFF * D; K = DFF; N = D; WT = (bf16_t*)(F.ws + WS_WDD + mi * SZ_WD); break;
        case 6: W = in[16] + (size_t)mi * D * DFF; K = D; N = DFF; ksc = in[11] + (2 * (mi >> 3) + 1) * D; WT = (bf16_t*)(F.ws + WS_WMGU + mi * SZ_WGU); mode = 2; break;
        case 7: W = in[17] + (size_t)mi * D * DFF; K = D; N = DFF; ksc = in[11] + (2 * (mi >> 3) + 1) * D; WT = (bf16_t*)(F.ws + WS_WMGU + mi * SZ_WGU); mode = 3; break;
        case 8: W = in[18] + (size_t)mi * DFF * D; K = DFF; N = D; WT = (bf16_t*)(F.ws + WS_WMD + mi * SZ_WD); break;
        case 9: W = in[20] + (size_t)mi * D * D; K = D; N = D; ksc = in[19] + mi * D; WT = (bf16_t*)(F.ws + WS_WPG + mi * SZ_WOUT); break;
        default: W = in[21] + (size_t)mi * PLE * D; K = PLE; N = D; WT = (bf16_t*)(F.ws + WS_WPP + mi * SZ_WPP); break;
        }
        conv_item(W, K, N, ksc, WT, mode, scr, item, F.lane);
    }
    const int gt = F.bid * NTHR + F.tid, NGT = F.og() * NTHR;
    bf16_t* wkv = (bf16_t*)(F.ws + WS_WKV);
    for (int i = gt; i < 4 * 128 * 128; i += NGT) { const int l = i >> 14, n = (i >> 7) & 127, j = i & 127;
        const float w = n < 64 ? in[7][((size_t)l * 128 + j) * 64 + n] : in[8][((size_t)l * 128 + j) * 64 + (n - 64)];
        wkv[i] = (bf16_t)f2bf(in[6][l * 128 + j] * w); }
    float* lb = (float*)(F.ws + WS_LB);
    for (int ch = gt; ch < 512; ch += NGT) { float v[4], mx = -1e30f;
#pragma unroll
        for (int l = 0; l < 4; ++l) { v[l] = in[2][l * 512 + ch]; mx = fmaxf(mx, v[l]); }
        float s = 0.f;
#pragma unroll
        for (int l = 0; l < 4; ++l) { v[l] = __expf(v[l] - mx); s += v[l]; }
        float c = 0.f; lb[ch] = 0.f;
#pragma unroll
        for (int l = 1; l < 4; ++l) { c += v[l] / s; lb[l * 512 + ch] = c; } }
}

__device__ __forceinline__ void phase_init(Frame& F, const float* x, bf16_t* HBN, float* ssq1, int Ts) {
    F.retid();
    const int gw = F.bid * NWAVES + F.wave, NGW = F.og() * NWAVES;
    for (int r = gw; r < Ts; r += NGW) {
        const f32x4* xr = (const f32x4*)(x + (size_t)r * D) + F.lane; u32x2* br = (u32x2*)(HBN + (size_t)r * D) + F.lane;
        float ss = 0.f;
#pragma unroll
        for (int j = 0; j < 4; ++j) { const f32x4 v = xr[64 * j]; u32x2 w; w.x = pk2(v[0], v[1]); w.y = pk2(v[2], v[3]); br[64 * j] = w; ss += (v[0] * v[0] + v[1] * v[1]) + (v[2] * v[2] + v[3] * v[3]); }
        ss = wave_sum(ss);
        if (F.lane < 4) ssq1[(size_t)r * 4 + F.lane] = F.lane == 0 ? ss : 0.f;
    }
}
__device__ __forceinline__ void phase_final(Frame& F, const bf16_t* HBN, float* OUT, const float* g, int Ts) {
    F.retid();
    const int gw = F.bid * NWAVES + F.wave, NGW = F.og() * NWAVES;
    for (int r = gw; r < Ts; r += NGW) {
        const u32x2* hr = (const u32x2*)(HBN + (size_t)r * D) + F.lane; f32x4* orow = (f32x4*)(OUT + (size_t)r * D) + F.lane; const f32x4* gr = (const f32x4*)g + F.lane; f32x4 v[4]; float ss = 0.f;
#pragma unroll
        for (int j = 0; j < 4; ++j) { const u32x2 w = hr[64 * j]; v[j] = (f32x4){bflo(w.x), bfhi(w.x), bflo(w.y), bfhi(w.y)}; ss += (v[j][0] * v[j][0] + v[j][1] * v[j][1]) + (v[j][2] * v[j][2] + v[j][3] * v[j][3]); }
        const float rs = rsqrtf(wave_sum(ss) * (1.f / D) + EPS);
#pragma unroll
        for (int j = 0; j < 4; ++j) orow[64 * j] = v[j] * rs * gr[64 * j];
    }
}
__device__ __forceinline__ void phase_prep(Frame& F, const bf16_t* Z, bf16_t* KV, const bf16_t* wkvt, const float* p, bf16_t* PB, int Ts) {
    F.retid();
    const int gw = F.bid * NWAVES + F.wave, NGW = F.og() * NWAVES; const int n16 = F.lane & 15, quad = F.lane >> 4;
    for (int tile = gw; tile < Ts / 16; tile += NGW) {
        const int tok = tile * 16 + n16;
        const bf16_t* zr = Z + (size_t)tok * ZP + C_SC + quad * 8;
        bf16x8 bf[4]; float ss = 0.f;
#pragma unroll
        for (int ks = 0; ks < 4; ++ks) { const u32x4 raw = *(const u32x4*)(zr + ks * 32); bf[ks] = __builtin_bit_cast(bf16x8, raw);
            const float a0 = bflo(raw.x), a1 = bfhi(raw.x), a2 = bflo(raw.y), a3 = bfhi(raw.y), a4 = bflo(raw.z), a5 = bfhi(raw.z), a6 = bflo(raw.w), a7 = bfhi(raw.w);
            ss += (a0 * a0 + a1 * a1) + (a2 * a2 + a3 * a3) + (a4 * a4 + a5 * a5) + (a6 * a6 + a7 * a7); }
        ss += __shfl_xor(ss, 16); ss += __shfl_xor(ss, 32);
        const float rs = rsqrtf(ss * (1.f / 128.f) + EPS);
#pragma unroll
        for (int nb = 0; nb < 8; ++nb) { f32x4 acc = (f32x4){0.f, 0.f, 0.f, 0.f};
            const bf16_t* wr_ = wkvt + (size_t)(16 * nb + n16) * 128 + quad * 8;
#pragma unroll
            for (int ks = 0; ks < 4; ++ks) acc = __builtin_amdgcn_mfma_f32_16x16x32_bf16(*(const bf16x8*)(wr_ + ks * 32), bf[ks], acc, 0, 0, 0);
            u32x2 pk; pk.x = pk2(acc[0] * rs, acc[1] * rs); pk.y = pk2(acc[2] * rs, acc[3] * rs);
            *(u32x2*)(KV + (size_t)tok * 128 + 16 * nb + 4 * quad) = pk; }
    }
    (void)p; (void)PB;
}

typedef float f32x16 __attribute__((ext_vector_type(16)));
typedef short s16x4 __attribute__((ext_vector_type(4)));
__device__ __forceinline__ s16x4 tr_read(unsigned addr) { return __builtin_bit_cast(s16x4, __builtin_amdgcn_ds_read_tr16_b64_v4i16((LAS s16x4*)(uintptr_t)addr)); }
__device__ __forceinline__ void hgrn_naive_unit(Frame& F, const bf16_t* Z, bf16_t* OA, const float* lbl, const float* onorm, int b, int h) {
    float* Qs = (float*)F.lds; float* Fs = Qs + 16 * 128; float* Vs = Fs + 16 * 128; float* OP = Vs + 16 * 128;
    const int dv = F.tid & 127, dkg = F.tid >> 7;
    float S[32];
#pragma unroll
    for (int i = 0; i < 32; ++i) S[i] = 0.f;
    const size_t row0 = (size_t)b * SEQ;
    for (int t0 = 0; t0 < SEQ; t0 += 16) {
        __syncthreads();
        for (int i = F.tid; i < 16 * 128; i += NTHR) { const int tt = i >> 7, ch = i & 127; const bf16_t* zr = Z + (row0 + t0 + tt) * ZP + h * 128 + ch;
            const float q = bf2f(zr[C_HQ]), fp = bf2f(zr[C_HF]), v = bf2f(zr[C_HI]); const float lb = lbl[h * 128 + ch];
            Qs[i] = siluf_(q); Fs[i] = lb + (1.f - lb) * sigmoidf_(fp); Vs[i] = v; }
        __syncthreads();
        for (int tt = 0; tt < 16; ++tt) {
            const float vv = Vs[tt * 128 + dv]; float po = 0.f;
            const float* fr_ = Fs + tt * 128 + dkg * 32; const float* qr_ = Qs + tt * 128 + dkg * 32;
#pragma unroll
            for (int i = 0; i < 32; ++i) { const float fi = fr_[i]; S[i] = fi * S[i] + (1.f - fi) * vv; po += S[i] * qr_[i]; }
            OP[(tt * 4 + dkg) * 128 + dv] = po;
        }
        __syncthreads();
#pragma unroll
        for (int k = 0; k < 2; ++k) { const int tt = 2 * F.wave + k;
            float o0 = 0.f, o1 = 0.f;
#pragma unroll
            for (int g = 0; g < 4; ++g) { o0 += OP[(tt * 4 + g) * 128 + F.lane]; o1 += OP[(tt * 4 + g) * 128 + 64 + F.lane]; }
            const float rs = rsqrtf(wave_sum(o0 * o0 + o1 * o1) * (1.f / 128.f) + EPS);
            const bf16_t* zg = Z + (row0 + t0 + tt) * ZP + C_HG + h * 128;
            bf16_t* oa = OA + (row0 + t0 + tt) * 512 + h * 128;
            oa[F.lane] = (bf16_t)f2bf(o0 * rs * onorm[F.lane] * siluf_(bf2f(zg[F.lane])));
            oa[64 + F.lane] = (bf16_t)f2bf(o1 * rs * onorm[64 + F.lane] * siluf_(bf2f(zg[64 + F.lane]))); }
    }
    __syncthreads();
}
__device__ __forceinline__ float row16_sumf(float v) {
    v += __builtin_bit_cast(float, __builtin_amdgcn_update_dpp(0, __builtin_bit_cast(int, v), 0xB1, 0xf, 0xf, true));
    v += __builtin_bit_cast(float, __builtin_amdgcn_update_dpp(0, __builtin_bit_cast(int, v), 0x4E, 0xf, 0xf, true));
    v += __builtin_bit_cast(float, __builtin_amdgcn_update_dpp(0, __builtin_bit_cast(int, v), 0x141, 0xf, 0xf, true));
    v += __builtin_bit_cast(float, __builtin_amdgcn_update_dpp(0, __builtin_bit_cast(int, v), 0x140, 0xf, 0xf, true));
    return v;
}
typedef short s16x4b __attribute__((ext_vector_type(4)));
__device__ __forceinline__ void hgrn_mfma_unit(Frame& F, const bf16_t* Z, bf16_t* OA, const float* onorm, int b, int h) {
    constexpr int RP = 272, PP = 144;
    constexpr int O_QT = 0, O_KT = 17408, O_KD = 34816, O_V = 53248, O_DEC = 70656, O_SSQ = 72704, O_OUT = 74752;
    LAS unsigned char* L = (LAS unsigned char*)F.lds;
    const int tid = F.tid, lane = F.lane, w = F.wave, n16 = lane & 15, quad = lane >> 4, q4 = (lane >> 2) & 3, p4 = lane & 3;
    const int d = tid & 127, I = tid >> 7;
    f32x4 S[8];
#pragma unroll
    for (int k = 0; k < 8; ++k) S[k] = (f32x4){0.f, 0.f, 0.f, 0.f};
    const size_t seq0 = (size_t)b * SEQ;
    const unsigned Lb = (unsigned)(uintptr_t)L;
    const float on = onorm[16 * w + n16];
    bf16_t rq[16], rf[16], rg[16]; u32x4 rv0, rv1;
    const bf16_t* zq = Z + (seq0 + 16 * I) * ZP + h * 128 + d;
    const bf16_t* zg = Z + (seq0 + 4 * quad) * ZP + C_HG + h * 128 + 16 * w + n16;
    const int vr0 = tid >> 4, vc0 = tid & 15;
    const bf16_t* zv = Z + (seq0 + vr0) * ZP + C_HI + h * 128 + vc0 * 8;
#define HG_PREFETCH(c) do { const size_t ro = (size_t)(c) * 64 * ZP; \
        _Pragma("unroll") for (int tt = 0; tt < 16; ++tt) { rq[tt] = zq[ro + (size_t)tt * ZP + C_HQ]; rf[tt] = zq[ro + (size_t)tt * ZP + C_HF]; } \
        _Pragma("unroll") for (int bi = 0; bi < 4; ++bi) _Pragma("unroll") for (int i = 0; i < 4; ++i) rg[bi * 4 + i] = zg[ro + (size_t)(16 * bi + i) * ZP]; \
        rv0 = *(const u32x4*)(zv + ro); rv1 = *(const u32x4*)(zv + ro + (size_t)32 * ZP); } while (0)
    HG_PREFETCH(0);
    for (int c = 0; c < SEQ / 64; ++c) {
        const size_t row = seq0 + (size_t)c * 64;
        __syncthreads();
        *(LAS u32x4*)(L + O_V + vr0 * RP + vc0 * 16) = rv0; *(LAS u32x4*)(L + O_V + (vr0 + 32) * RP + vc0 * 16) = rv1;
        float cl[16], qv[16], kv[16], gv[16]; float run = 0.f;
#pragma unroll
        for (int tt = 0; tt < 16; ++tt) { const float lf = bf2f(rf[tt]); run += lf; cl[tt] = run; kv[tt] = 1.f - __expf(lf); qv[tt] = bf2f(rq[tt]); gv[tt] = bf2f(rg[tt]); }
        const float eB = __expf(run);
        *(LAS float*)(L + O_DEC + (I * 128 + d) * 4) = eB;
        if (c + 1 < SEQ / 64) HG_PREFETCH(c + 1);
#pragma unroll
        for (int tt = 0; tt < 16; ++tt) { const int t = 16 * I + tt;
            *(LAS bf16_t*)(L + O_QT + t * RP + d * 2) = (bf16_t)f2bf(qv[tt] * __expf(cl[tt]));
            const float kk = kv[tt] * __expf(fminf(-cl[tt], 80.f));
            *(LAS bf16_t*)(L + O_KT + t * RP + d * 2) = (bf16_t)f2bf(kk);
            kv[tt] = kk * eB; }
#pragma unroll
        for (int g = 0; g < 4; ++g) { u32x2 pk; pk.x = pk2(kv[4 * g], kv[4 * g + 1]); pk.y = pk2(kv[4 * g + 2], kv[4 * g + 3]); *(LAS u32x2*)(L + O_KD + d * PP + (16 * I + 4 * g) * 2) = pk; }
        __syncthreads();
#pragma unroll 1
        for (int bi = 0; bi < 4; ++bi) {
            const LAS unsigned char* ap = L + O_KT + (16 * bi + n16) * RP + quad * 16;
            const LAS unsigned char* bp = L + O_QT + (16 * bi + n16) * RP + quad * 16;
            f32x4 acc = (f32x4){0.f, 0.f, 0.f, 0.f};
#pragma unroll
            for (int ks = 0; ks < 4; ++ks) acc = __builtin_amdgcn_mfma_f32_16x16x32_bf16(*(const LAS bf16x8*)(ap + ks * 64), *(const LAS bf16x8*)(bp + ks * 64), acc, 0, 0, 0);
#pragma unroll
            for (int i = 0; i < 4; ++i) if (4 * quad + i > n16) acc[i] = 0.f;
            u32x2 pk; pk.x = pg8::cvt_pk_bf16(acc[0], acc[1]); pk.y = pg8::cvt_pk_bf16(acc[2], acc[3]);
            const s16x4b pa = __builtin_bit_cast(s16x4b, pk);
            const s16x4b vfr = __builtin_bit_cast(s16x4b, tr_read(Lb + O_V + (unsigned)((16 * bi + 4 * quad + q4) * RP + (16 * w + 4 * p4) * 2)));
            const bf16x8 pa8 = (bf16x8){pa[0], pa[1], pa[2], pa[3], 0, 0, 0, 0}, vf8 = (bf16x8){vfr[0], vfr[1], vfr[2], vfr[3], vfr[0], vfr[1], vfr[2], vfr[3]};
            f32x4 oo = __builtin_amdgcn_mfma_f32_16x16x32_bf16(pa8, vf8, (f32x4){0.f, 0.f, 0.f, 0.f}, 0, 0, 0);
            const LAS unsigned char* qp = L + O_QT + (16 * bi + n16) * RP + quad * 8;
#pragma unroll
            for (int ks = 0; ks < 4; ++ks) { u32x4 pw; pw.x = pg8::cvt_pk_bf16(S[2 * ks][0], S[2 * ks][1]); pw.y = pg8::cvt_pk_bf16(S[2 * ks][2], S[2 * ks][3]);
                pw.z = pg8::cvt_pk_bf16(S[2 * ks + 1][0], S[2 * ks + 1][1]); pw.w = pg8::cvt_pk_bf16(S[2 * ks + 1][2], S[2 * ks + 1][3]);
                const u32x2 lo = *(const LAS u32x2*)(qp + ks * 64), hi = *(const LAS u32x2*)(qp + ks * 64 + 32);
                u32x4 av; av.x = lo.x; av.y = lo.y; av.z = hi.x; av.w = hi.y;
                oo = __builtin_amdgcn_mfma_f32_16x16x32_bf16(__builtin_bit_cast(bf16x8, av), __builtin_bit_cast(bf16x8, pw), oo, 0, 0, 0); }
            *(LAS f32x4*)(L + O_OUT + ((16 * w + n16) * 64 + 16 * bi + 4 * quad) * 4) = oo;
#pragma unroll
            for (int i = 0; i < 4; ++i) { const float ss = row16_sumf(oo[i] * oo[i]);
                if (n16 == 0) *(LAS float*)(L + O_SSQ + ((16 * bi + 4 * quad + i) * 8 + w) * 4) = ss; }
#pragma unroll
            for (int kb = 0; kb < 8; ++kb) {
                const f32x4 dec = *(const LAS f32x4*)(L + O_DEC + (bi * 128 + 16 * kb + 4 * quad) * 4);
                const s16x4b ka = *(const LAS s16x4b*)(L + O_KD + (16 * kb + n16) * PP + (16 * bi + 4 * quad) * 2);
                S[kb] = __builtin_amdgcn_mfma_f32_16x16x32_bf16((bf16x8){ka[0], ka[1], ka[2], ka[3], 0, 0, 0, 0}, vf8, S[kb] * dec, 0, 0, 0);
            }
        }
        __syncthreads();
#pragma unroll
        for (int bi = 0; bi < 4; ++bi) {
            const f32x4 oo = *(const LAS f32x4*)(L + O_OUT + ((16 * w + n16) * 64 + 16 * bi + 4 * quad) * 4);
#pragma unroll
            for (int i = 0; i < 4; ++i) { const int t = 16 * bi + 4 * quad + i;
                const f32x4 pa = *(const LAS f32x4*)(L + O_SSQ + t * 32), pb = *(const LAS f32x4*)(L + O_SSQ + t * 32 + 16);
                const float rs = rsqrtf((((pa[0] + pa[1]) + (pa[2] + pa[3])) + ((pb[0] + pb[1]) + (pb[2] + pb[3]))) * (1.f / 128.f) + EPS);
                OA[(row + t) * 512 + h * 128 + 16 * w + n16] = (bf16_t)f2bf(oo[i] * rs * on * gv[bi * 4 + i]); } }
    }
#undef HG_PREFETCH
    __syncthreads();
}
__device__ __forceinline__ void sb_naive_unit(Frame& F, const bf16_t* Z, bf16_t* OC, int b, int h, int qblk) {
    const int t = qblk * NTHR + F.tid; const size_t row0 = (size_t)b * SEQ;
    float q[64], o[64];
    { const uint4* qp = (const uint4*)(Z + (row0 + t) * ZP + C_BQ + h * 64);
#pragma unroll
      for (int c = 0; c < 8; ++c) { float f[8]; unpack8(qp[c], f);
#pragma unroll
          for (int e = 0; e < 8; ++e) { q[c * 8 + e] = f[e] * 0.125f; o[c * 8 + e] = 0.f; } } }
    float P = 1.f;
    for (int s = t - 1; s >= 0; --s) {
        if (P < 1e-30f) break;
        const uint4* kp = (const uint4*)(Z + (row0 + s) * ZP + C_BK + h * 64); const uint4* vp = (const uint4*)(Z + (row0 + s) * ZP + C_BV + h * 64);
        float dot = 0.f;
#pragma unroll
        for (int c = 0; c < 8; ++c) { float f[8]; unpack8(kp[c], f);
#pragma unroll
            for (int e = 0; e < 8; ++e) dot += q[c * 8 + e] * f[e]; }
        const float zc = fmaxf(dot, -80.f), ex = __expf(-zc), beta = 1.f / (1.f + ex), A = beta * P;
        P *= ex * beta;
#pragma unroll
        for (int c = 0; c < 8; ++c) { float f[8]; unpack8(vp[c], f);
#pragma unroll
            for (int e = 0; e < 8; ++e) o[c * 8 + e] += A * f[e]; }
    }
    uint4* op = (uint4*)(OC + (row0 + t) * 512 + h * 64);
#pragma unroll
    for (int c = 0; c < 8; ++c) { uint4 w; w.x = pk2(o[c * 8], o[c * 8 + 1]); w.y = pk2(o[c * 8 + 2], o[c * 8 + 3]); w.z = pk2(o[c * 8 + 4], o[c * 8 + 5]); w.w = pk2(o[c * 8 + 6], o[c * 8 + 7]); op[c] = w; }
}
__device__ __forceinline__ void sb_mfma_wave(const bf16_t* Z, bf16_t* OC, int b, int h, int t0, unsigned char* wl, int lane) {
    const int r32 = lane & 31, hi = lane >> 5; const size_t row0 = (size_t)b * SEQ;
    bf16x8 qr[4];
    { const bf16_t* qp = Z + (row0 + t0 + r32) * ZP + C_BQ + h * 64 + hi * 8;
#pragma unroll
      for (int d0 = 0; d0 < 4; ++d0) qr[d0] = *(const bf16x8*)(qp + d0 * 16); }
    const int kappa = 16 * ((r32 >> 2) & 1) + (r32 & 3) + 4 * (r32 >> 3);
    f32x16 o0, o1;
#pragma unroll
    for (int r = 0; r < 16; ++r) { o0[r] = 0.f; o1[r] = 0.f; }
    float C = 1.f; const float cneg = -0.125f * 1.4426950408889634f;
    const int vrow = lane >> 3, vcc = lane & 7;
    const int g = lane >> 4, q4 = (lane >> 2) & 3, p4 = lane & 3;
    const unsigned wl3 = (unsigned)(uintptr_t)(LAS unsigned char*)wl;
    const unsigned trbase = wl3 + (unsigned)((16 * (g >> 1) + q4) * 144 + (16 * (g & 1) + 4 * p4) * 2);
    const int ktd = t0 >> 5;
    for (int kt = ktd; kt >= 0; --kt) {
        const int s0 = kt * 32;
        const bf16_t* kp = Z + (row0 + s0 + kappa) * ZP + C_BK + h * 64 + hi * 8;
        bf16x8 kf[4];
#pragma unroll
        for (int d0 = 0; d0 < 4; ++d0) kf[d0] = *(const bf16x8*)(kp + d0 * 16);
        const bf16_t* vp = Z + (row0 + s0 + vrow) * ZP + C_BV + h * 64 + vcc * 8;
        const u32x4 vv0 = *(const u32x4*)(vp), vv1 = *(const u32x4*)(vp + (size_t)8 * ZP), vv2 = *(const u32x4*)(vp + (size_t)16 * ZP), vv3 = *(const u32x4*)(vp + (size_t)24 * ZP);
        { LAS unsigned char* w3 = (LAS unsigned char*)wl + vrow * 144 + vcc * 16;
          *(LAS u32x4*)(w3) = vv0; *(LAS u32x4*)(w3 + 8 * 144) = vv1; *(LAS u32x4*)(w3 + 16 * 144) = vv2; *(LAS u32x4*)(w3 + 24 * 144) = vv3; }
        f32x16 p;
#pragma unroll
        for (int r = 0; r < 16; ++r) p[r] = 0.f;
#pragma unroll
        for (int d0 = 0; d0 < 4; ++d0) p = __builtin_amdgcn_mfma_f32_32x32x16_bf16(kf[d0], qr[d0], p, 0, 0, 0);
        float A[16]; float run = 1.f;
#pragma unroll
        for (int r = 15; r >= 0; --r) {
            const float zz = fminf(p[r] * cneg, 115.f), e = __builtin_amdgcn_exp2f(zz); float bt = __builtin_amdgcn_rcpf(1.f + e), kp_ = e * bt;
            if (kt == ktd && (16 * hi + r >= r32)) { bt = 0.f; kp_ = 1.f; }
            A[r] = bt * run; run *= kp_;
        }
        const float other = xhalf_other(run);
        const float cin = hi ? C : C * other;
        u32x4 pw0, pw1;
        pw0.x = pg8::cvt_pk_bf16(A[0] * cin, A[1] * cin); pw0.y = pg8::cvt_pk_bf16(A[2] * cin, A[3] * cin); pw0.z = pg8::cvt_pk_bf16(A[4] * cin, A[5] * cin); pw0.w = pg8::cvt_pk_bf16(A[6] * cin, A[7] * cin);
        pw1.x = pg8::cvt_pk_bf16(A[8] * cin, A[9] * cin); pw1.y = pg8::cvt_pk_bf16(A[10] * cin, A[11] * cin); pw1.z = pg8::cvt_pk_bf16(A[12] * cin, A[13] * cin); pw1.w = pg8::cvt_pk_bf16(A[14] * cin, A[15] * cin);
        C = C * run * other;
        asm volatile("s_waitcnt lgkmcnt(0)" ::: "memory");
        s16x4 v0a = tr_read(trbase), v0b = tr_read(trbase + 4 * 144), v1a = tr_read(trbase + 64), v1b = tr_read(trbase + 4 * 144 + 64);
        s16x4 v2a = tr_read(trbase + 8 * 144), v2b = tr_read(trbase + 12 * 144), v3a = tr_read(trbase + 8 * 144 + 64), v3b = tr_read(trbase + 12 * 144 + 64);
#define VF(a, b) (bf16x8){a[0], a[1], a[2], a[3], b[0], b[1], b[2], b[3]}
        o0 = __builtin_amdgcn_mfma_f32_32x32x16_bf16(__builtin_bit_cast(bf16x8, pw0), VF(v0a, v0b), o0, 0, 0, 0);
        o1 = __builtin_amdgcn_mfma_f32_32x32x16_bf16(__builtin_bit_cast(bf16x8, pw0), VF(v1a, v1b), o1, 0, 0, 0);
        o0 = __builtin_amdgcn_mfma_f32_32x32x16_bf16(__builtin_bit_cast(bf16x8, pw1), VF(v2a, v2b), o0, 0, 0, 0);
        o1 = __builtin_amdgcn_mfma_f32_32x32x16_bf16(__builtin_bit_cast(bf16x8, pw1), VF(v3a, v3b), o1, 0, 0, 0);
#undef VF
        asm volatile("s_waitcnt lgkmcnt(0)" ::: "memory");
        if (__all(C < 1e-30f)) break;
    }
    bf16_t* op = OC + (row0 + t0) * 512 + h * 64 + r32;
#pragma unroll
    for (int r = 0; r < 16; ++r) { const int q = (r & 3) + 8 * (r >> 2) + 4 * hi; op[(size_t)q * 512] = (bf16_t)f2bf(o0[r]); op[(size_t)q * 512 + 32] = (bf16_t)f2bf(o1[r]); }
}
__device__ __forceinline__ void dsa_naive_query(const bf16_t* Z, const bf16_t* KV, bf16_t* OB, int tokl, float* wl, int lane) {
    const int b = tokl / SEQ, t = tokl % SEQ, c = t >> 6, nj = c + 1; const size_t row0 = (size_t)b * SEQ;
    float* iq_s = wl; float* q_s = wl + 256; int* list = (int*)(wl + 768); float* Pm = wl + 1024;
    const bf16_t* zr = Z + (size_t)tokl * ZP;
    LDS_WAIT(); __builtin_amdgcn_wave_barrier();
#pragma unroll
    for (int i = 0; i < 4; ++i) iq_s[lane + 64 * i] = bf2f(zr[C_IQ + lane + 64 * i]);
#pragma unroll
    for (int i = 0; i < 8; ++i) q_s[lane + 64 * i] = bf2f(zr[C_SQ + lane + 64 * i]) * 0.125f;
    const float w0 = bf2f(zr[C_IW + 0]) * 0.5f, w1 = bf2f(zr[C_IW + 1]) * 0.5f, w2 = bf2f(zr[C_IW + 2]) * 0.5f, w3 = bf2f(zr[C_IW + 3]) * 0.5f;
    LDS_WAIT(); __builtin_amdgcn_wave_barrier();
    unsigned* keyl = (unsigned*)Pm;
    for (int j = 0; j < nj; ++j) {
        const uint4* kp = (const uint4*)(Z + (row0 + j * 64 + lane) * ZP + C_IK);
        float d0 = 0.f, d1 = 0.f, d2 = 0.f, d3 = 0.f;
#pragma unroll 1
        for (int ch = 0; ch < 8; ++ch) { float f[8]; unpack8(kp[ch], f);
#pragma unroll
            for (int e = 0; e < 8; ++e) { const int dd = ch * 8 + e; d0 += iq_s[dd] * f[e]; d1 += iq_s[64 + dd] * f[e]; d2 += iq_s[128 + dd] * f[e]; d3 += iq_s[192 + dd] * f[e]; } }
        float isc = fmaxf(d0, 0.f) * w0 + fmaxf(d1, 0.f) * w1 + fmaxf(d2, 0.f) * w2 + fmaxf(d3, 0.f) * w3; isc += 0.0f;
        unsigned u = __builtin_bit_cast(unsigned, isc); u ^= (u >> 31) ? 0xffffffffu : 0x80000000u; keyl[j * 64 + lane] = u;
    }
    LDS_WAIT(); __builtin_amdgcn_wave_barrier();
    const unsigned long long lt = (1ull << lane) - 1ull;
    int nsel = 0;
    if (nj <= 4) {
        for (int j = 0; j < nj; ++j) list[j * 64 + lane] = j * 64 + lane;
        nsel = nj * 64;
    } else {
        unsigned thr = 0u;
        for (int bit = 31; bit >= 0; --bit) { const unsigned cand = thr | (1u << bit); int cnt = 0;
            for (int j = 0; j < nj; ++j) cnt += __popcll(__ballot(keyl[j * 64 + lane] >= cand));
            if (cnt >= 256) thr = cand; }
        int cgt = 0;
        for (int j = 0; j < nj; ++j) cgt += __popcll(__ballot(keyl[j * 64 + lane] > thr));
        const int need = 256 - cgt; int beq = 0;
        for (int j = 0; j < nj; ++j) {
            const unsigned kj = keyl[j * 64 + lane];
            const bool gt = kj > thr, eq = kj == thr;
            const unsigned long long meq = __ballot(eq); const int rank = beq + __popcll(meq & lt); beq += __popcll(meq);
            const bool sel = gt || (eq && rank < need);
            const unsigned long long ms = __ballot(sel); if (sel) list[nsel + __popcll(ms & lt)] = j * 64 + lane; nsel += __popcll(ms);
        }
    }
    LDS_WAIT(); __builtin_amdgcn_wave_barrier();
#pragma unroll 1
    for (int i = 0; i < 4; ++i) { const int e = lane + 64 * i; const bool valid = e < nsel; const int s = valid ? list[e] : 0;
        const uint4* kp = (const uint4*)(KV + (row0 + s) * 128);
        float kf[64];
#pragma unroll
        for (int ch = 0; ch < 8; ++ch) unpack8(kp[ch], kf + ch * 8);
#pragma unroll 1
        for (int hh = 0; hh < 8; ++hh) { float d = 0.f;
#pragma unroll
            for (int dd = 0; dd < 64; ++dd) d += q_s[hh * 64 + dd] * kf[dd];
            Pm[e * 8 + hh] = valid ? d : -INFINITY; } }
    LDS_WAIT(); __builtin_amdgcn_wave_barrier();
#pragma unroll 1
    for (int hh = 0; hh < 8; ++hh) { float p[4]; float m = -INFINITY;
#pragma unroll
        for (int i = 0; i < 4; ++i) { p[i] = Pm[(lane + 64 * i) * 8 + hh]; m = fmaxf(m, p[i]); }
        m = wave_max(m); float sm = 0.f;
#pragma unroll
        for (int i = 0; i < 4; ++i) { p[i] = __expf(p[i] - m); sm += p[i]; }
        sm = wave_sum(sm); const float inv = 1.f / sm;
#pragma unroll
        for (int i = 0; i < 4; ++i) Pm[(lane + 64 * i) * 8 + hh] = p[i] * inv; }
    LDS_WAIT(); __builtin_amdgcn_wave_barrier();
    const int hh = lane >> 3, db = (lane & 7) * 8; float o[8];
#pragma unroll
    for (int e = 0; e < 8; ++e) o[e] = 0.f;
    for (int e = 0; e < nsel; ++e) { const int s = list[e]; const float p = Pm[e * 8 + hh]; float f[8]; unpack8(*(const uint4*)(KV + (row0 + s) * 128 + 64 + db), f);
#pragma unroll
        for (int k = 0; k < 8; ++k) o[k] += p * f[k]; }
    uint4 w; w.x = pk2(o[0], o[1]); w.y = pk2(o[2], o[3]); w.z = pk2(o[4], o[5]); w.w = pk2(o[6], o[7]);
    *(uint4*)(OB + (size_t)tokl * 512 + hh * 64 + db) = w;
}
__device__ __forceinline__ int row16_sum(int v) {
    v += __builtin_amdgcn_update_dpp(0, v, 0xB1, 0xf, 0xf, true);
    v += __builtin_amdgcn_update_dpp(0, v, 0x4E, 0xf, 0xf, true);
    v += __builtin_amdgcn_update_dpp(0, v, 0x141, 0xf, 0xf, true);
    v += __builtin_amdgcn_update_dpp(0, v, 0x140, 0xf, 0xf, true);
    return v;
}
__device__ __forceinline__ unsigned pk_gt_cnt8(unsigned cnt, const unsigned* h, unsigned cpk, unsigned onepk) {
    unsigned d0, d1, c1 = 0u;
    asm("v_pk_sub_u16 %1, %4, %12 clamp\n\tv_pk_sub_u16 %2, %5, %12 clamp\n\tv_pk_min_u16 %1, %1, %13\n\tv_pk_min_u16 %2, %2, %13\n\tv_pk_add_u16 %0, %0, %1\n\tv_pk_add_u16 %3, %3, %2\n\t"
        "v_pk_sub_u16 %1, %6, %12 clamp\n\tv_pk_sub_u16 %2, %7, %12 clamp\n\tv_pk_min_u16 %1, %1, %13\n\tv_pk_min_u16 %2, %2, %13\n\tv_pk_add_u16 %0, %0, %1\n\tv_pk_add_u16 %3, %3, %2\n\t"
        "v_pk_sub_u16 %1, %8, %12 clamp\n\tv_pk_sub_u16 %2, %9, %12 clamp\n\tv_pk_min_u16 %1, %1, %13\n\tv_pk_min_u16 %2, %2, %13\n\tv_pk_add_u16 %0, %0, %1\n\tv_pk_add_u16 %3, %3, %2\n\t"
        "v_pk_sub_u16 %1, %10, %12 clamp\n\tv_pk_sub_u16 %2, %11, %12 clamp\n\tv_pk_min_u16 %1, %1, %13\n\tv_pk_min_u16 %2, %2, %13\n\tv_pk_add_u16 %0, %0, %1\n\tv_pk_add_u16 %3, %3, %2"
        : "+v"(cnt), "=&v"(d0), "=&v"(d1), "+v"(c1)
        : "v"(h[0]), "v"(h[1]), "v"(h[2]), "v"(h[3]), "v"(h[4]), "v"(h[5]), "v"(h[6]), "v"(h[7]), "v"(cpk), "v"(onepk));
    unsigned r;
    asm("v_pk_add_u16 %0, %1, %2" : "=v"(r) : "v"(cnt), "v"(c1));
    return r;
}
__device__ __forceinline__ unsigned bfi_(unsigned m, unsigned x, unsigned y) { return (m & x) | (~m & y); }
__device__ __forceinline__ void bt32(unsigned (&A)[32]) {
#pragma unroll
    for (int k = 0; k < 32; ++k) if (!(k & 16)) { const unsigned a = A[k], b = A[k + 16]; A[k] = __builtin_amdgcn_perm(a, b, 0x07060302u); A[k + 16] = __builtin_amdgcn_perm(a, b, 0x05040100u); }
#pragma unroll
    for (int k = 0; k < 32; ++k) if (!(k & 8)) { const unsigned a = A[k], b = A[k + 8]; A[k] = __builtin_amdgcn_perm(a, b, 0x07030501u); A[k + 8] = __builtin_amdgcn_perm(a, b, 0x06020400u); }
#pragma unroll
    for (int k = 0; k < 32; ++k) if (!(k & 4)) { const unsigned a = A[k], b = A[k + 4]; A[k] = bfi_(0x0F0F0F0Fu, b >> 4, a); A[k + 4] = bfi_(0x0F0F0F0Fu, b, a << 4); }
#pragma unroll
    for (int k = 0; k < 32; ++k) if (!(k & 2)) { const unsigned a = A[k], b = A[k + 2]; A[k] = bfi_(0x33333333u, b >> 2, a); A[k + 2] = bfi_(0x33333333u, b, a << 2); }
#pragma unroll
    for (int k = 0; k < 32; ++k) if (!(k & 1)) { const unsigned a = A[k], b = A[k + 1]; A[k] = bfi_(0x55555555u, b >> 1, a); A[k + 1] = bfi_(0x55555555u, b, a << 1); }
}
template <int NW> __device__ __forceinline__ void dsa_bisect_bs(const unsigned* SC, int q, int sl, int hq, int nk, unsigned& thr_out, int& cgt_out) {
    unsigned T0[32], T1[32];
    const unsigned* kq = SC + q * 2048; const int rot = sl + 4 * q;
#pragma unroll
    for (int i = 0; i < 32; ++i) { T0[i] = (i < nk) ? kq[(i * 32 + rot) & 2047] : 0u; if (NW == 2) T1[i] = (32 + i < nk) ? kq[((32 + i) * 32 + rot) & 2047] : 0u; }
    bt32(T0); if (NW == 2) bt32(T1);
    unsigned M0 = ~0u, M1 = ~0u; int G = 0;
    unsigned thrA = 0u, thrB = 0u, tfA = 0u, tfB = 0u; bool doneA = false, doneB = false;
#pragma unroll
    for (int r = 0; r < 32; ++r) {
        const unsigned o0 = M0 & T0[r], o1 = (NW == 2) ? (M1 & T1[r]) : 0u;
        int c = __builtin_popcount(o0) + G; if (NW == 2) c += __builtin_popcount(o1);
        const int cs = row16_sum(c);
        const int cA = __builtin_amdgcn_readlane(cs, 0) + __builtin_amdgcn_readlane(cs, 16), cB = __builtin_amdgcn_readlane(cs, 32) + __builtin_amdgcn_readlane(cs, 48);
        const unsigned bit = 1u << (31 - r);
        const bool dA = cA >= 256, dB = cB >= 256;
        if (!doneA && cA == 256) { doneA = true; tfA = (thrA | bit) - 1u; }
        if (!doneB && cB == 256) { doneB = true; tfB = (thrB | bit) - 1u; }
        if (dA) thrA |= bit;
        if (dB) thrB |= bit;
        const bool dec = hq ? dB : dA;
        M0 = dec ? o0 : (M0 & ~T0[r]); if (NW == 2) M1 = dec ? o1 : (M1 & ~T1[r]);
        G = dec ? G : c;
        if (doneA && doneB) break;
    }
    const int gs = row16_sum(G);
    const int gA = __builtin_amdgcn_readlane(gs, 0) + __builtin_amdgcn_readlane(gs, 16), gB = __builtin_amdgcn_readlane(gs, 32) + __builtin_amdgcn_readlane(gs, 48);
    thr_out = hq ? (doneB ? tfB : thrB) : (doneA ? tfA : thrA);
    cgt_out = hq ? (doneB ? 256 : gB) : (doneA ? 256 : gA);
}
__device__ __forceinline__ int half_incl_scan(int v) {
    v += __builtin_amdgcn_update_dpp(0, v, 0x111, 0xf, 0xf, true);
    v += __builtin_amdgcn_update_dpp(0, v, 0x112, 0xf, 0xf, true);
    v += __builtin_amdgcn_update_dpp(0, v, 0x114, 0xf, 0xf, true);
    v += __builtin_amdgcn_update_dpp(0, v, 0x118, 0xf, 0xf, true);
    v += __builtin_amdgcn_update_dpp(0, v, 0x142, 0xa, 0xf, false);
    return v;
}
__device__ __forceinline__ unsigned top_bits(unsigned m, int k) { unsigned t = 0u; while (k > 0 && m) { const unsigned b = 0x80000000u >> __builtin_clz(m); t |= b; m &= ~b; --k; } return t; }
template <int NW> __device__ __forceinline__ void dsa_select_bs(const unsigned* SC, int q, int sl, int hq, int nk, unsigned& s0_out, unsigned& s1_out) {
    unsigned T0[32], T1[32];
    const unsigned* kq = SC + q * 2048; const int rot = sl + 4 * q;
#pragma unroll
    for (int i = 0; i < 32; ++i) { T0[i] = (i < nk) ? kq[(i * 32 + rot) & 2047] : 0u; if (NW == 2) T1[i] = (32 + i < nk) ? kq[((32 + i) * 32 + rot) & 2047] : 0u; }
    bt32(T0); if (NW == 2) bt32(T1);
    unsigned M0 = ~0u, M1 = (NW == 2) ? ~0u : 0u, G0 = 0u, G1 = 0u, S0 = 0u, S1 = 0u; int Gc = 0;
    bool doneA = false, doneB = false;
#pragma unroll
    for (int r = 0; r < 32; ++r) {
        const unsigned o0 = M0 & T0[r], o1 = (NW == 2) ? (M1 & T1[r]) : 0u;
        int c = __builtin_popcount(o0) + Gc; if (NW == 2) c += __builtin_popcount(o1);
        const int cs = row16_sum(c);
        const int cA = __builtin_amdgcn_readlane(cs, 0) + __builtin_amdgcn_readlane(cs, 16), cB = __builtin_amdgcn_readlane(cs, 32) + __builtin_amdgcn_readlane(cs, 48);
        const bool hitA = !doneA && cA == 256, hitB = !doneB && cB == 256;
        if (hitA || hitB) { if (hq ? hitB : hitA) { S0 = G0 | o0; S1 = G1 | o1; } }
        doneA = doneA || hitA; doneB = doneB || hitB;
        const unsigned X = (hq ? (cB >= 256) : (cA >= 256)) ? 0u : 0xFFFFFFFFu;
        G0 |= o0 & X; G1 |= o1 & X; Gc = X ? c : Gc;
        M0 &= T0[r] ^ X; if (NW == 2) M1 &= T1[r] ^ X;
        if (doneA && doneB) break;
    }
    if (!(doneA && doneB)) {
        const int gs = row16_sum(Gc);
        const int gA = __builtin_amdgcn_readlane(gs, 0) + __builtin_amdgcn_readlane(gs, 16), gB = __builtin_amdgcn_readlane(gs, 32) + __builtin_amdgcn_readlane(gs, 48);
        const int need = 256 - (hq ? gB : gA);
        const int m0 = __builtin_popcount(M0), m = m0 + __builtin_popcount(M1);
        const int before = half_incl_scan(m) - m;
        int k = need - before; k = k < 0 ? 0 : (k > m ? m : k);
        const int k0 = k < m0 ? k : m0;
        const unsigned t0 = top_bits(M0, k0), t1 = top_bits(M1, k - k0);
        if (!(hq ? doneB : doneA)) { S0 = G0 | t0; S1 = G1 | t1; }
    }
    s0_out = S0; s1_out = S1;
}
template <int NKS> __device__ __forceinline__ void dsa_bisect(const unsigned* SC, int q, int sl, int hq, int nk, unsigned& thr_out, int& cgt_out) {
    constexpr int NP = NKS / 2;
    unsigned one = 0x00010001u; asm volatile("" : "+v"(one));
    unsigned P[NP];
    const unsigned* kq = SC + q * 2048; const int rot = sl + 4 * q;
#pragma unroll
    for (int p = 0; p < NP; ++p) { const unsigned k0 = (2 * p < nk) ? kq[(2 * p * 32 + rot) & 2047] : 0u, k1 = (2 * p + 1 < nk) ? kq[((2 * p + 1) * 32 + rot) & 2047] : 0u;
        P[p] = (k0 >> 16) | (k1 & 0xffff0000u); }
#define DSA_COUNT(cpk_, outA, outB) do { unsigned c2_ = 0u; _Pragma("unroll") for (int p = 0; p < NP; p += 8) c2_ = pk_gt_cnt8(c2_, &P[p], (cpk_), one); \
        int c_ = (int)((c2_ & 0xffffu) + (c2_ >> 16)); c_ = row16_sum(c_); \
        outA = __builtin_amdgcn_readlane(c_, 0) + __builtin_amdgcn_readlane(c_, 16); outB = __builtin_amdgcn_readlane(c_, 32) + __builtin_amdgcn_readlane(c_, 48); } while (0)
    unsigned thi = 0u; int atA = 1 << 30, atB = 1 << 30;
#pragma unroll 1
    for (int bit = 15; bit >= 0; --bit) { const unsigned cand = thi | (1u << bit), cm1 = cand - 1u; int cA, cB;
        DSA_COUNT(cm1 * 0x10001u, cA, cB);
        if (cA >= 256) atA = cA; if (cB >= 256) atB = cB;
        if ((hq ? cB : cA) >= 256) thi = cand;
        if (atA == 256 && atB == 256) break; }
    int gA, gB; DSA_COUNT(thi * 0x10001u, gA, gB);
    const int needA = 256 - gA, needB = 256 - gB;
    const unsigned tsh = thi << 16;
#pragma unroll
    for (int p = 0; p < NP; ++p) { const unsigned k0 = (2 * p < nk) ? kq[(2 * p * 32 + rot) & 2047] : 0u, k1 = (2 * p + 1 < nk) ? kq[((2 * p + 1) * 32 + rot) & 2047] : 0u;
        const unsigned l0 = ((k0 ^ tsh) < 0x10000u && 2 * p < nk) ? (k0 & 0xffffu) : 0u, l1 = ((k1 ^ tsh) < 0x10000u && 2 * p + 1 < nk) ? (k1 << 16) : 0u;
        P[p] = l0 | l1; }
    unsigned tlo = 0u; int eA = 1 << 30, eB = 1 << 30;
#pragma unroll 1
    for (int bit = 15; bit >= 0; --bit) { const unsigned cand = tlo | (1u << bit), cm1 = cand - 1u; int cA, cB;
        DSA_COUNT(cm1 * 0x10001u, cA, cB);
        if (cA >= needA) eA = cA - needA; if (cB >= needB) eB = cB - needB;
        if ((hq ? (cB >= needB) : (cA >= needA))) tlo = cand;
        if (eA == 0 && eB == 0) break; }
    int hA, hB; DSA_COUNT(tlo * 0x10001u, hA, hB);
#undef DSA_COUNT
    thr_out = tsh | tlo; cgt_out = hq ? (gB + hB) : (gA + hA);
}
__device__ __forceinline__ bf16x8 lane_t16x4(const bf16x8 x, int srcaddr) {
    const u32x4 v = __builtin_bit_cast(u32x4, x); u32x4 r;
    r.x = (unsigned)__builtin_amdgcn_ds_bpermute(srcaddr, (int)v.x); r.y = (unsigned)__builtin_amdgcn_ds_bpermute(srcaddr, (int)v.y);
    r.z = (unsigned)__builtin_amdgcn_ds_bpermute(srcaddr, (int)v.z); r.w = (unsigned)__builtin_amdgcn_ds_bpermute(srcaddr, (int)v.w);
    return __builtin_bit_cast(bf16x8, r);
}
__device__ __forceinline__ void dsa_mfma_unit(Frame& F, const bf16_t* Z, const bf16_t* KV, const bf16_t* IKT, bf16_t* OB, int tok0) {
    const int lane = F.lane, w = F.wave;
    const int b = tok0 / SEQ, t0 = tok0 % SEQ, c = t0 >> 6, nadm = 64 * (c + 1); const size_t row0 = (size_t)b * SEQ;
    unsigned* SC = (unsigned*)F.lds;
    unsigned short* LST = (unsigned short*)(F.lds + RING_BYTES);
    int* NS = (int*)(F.lds + RING_BYTES + 8192);
    const int n16 = lane & 15, quad = lane >> 4;
    const int lrow = lane >> 2, lpc = lane & 3, tsrc = (n16 * 4 + quad) * 4;
    if (nadm > 256) {
        bf16x8 bq[4][2]; float wq[4];
        { const bf16_t* qrow = Z + (size_t)(tok0 + n16) * ZP + C_IQ + quad * 8;
#pragma unroll
          for (int h = 0; h < 4; ++h) { bq[h][0] = *(const bf16x8*)(qrow + h * 64); bq[h][1] = *(const bf16x8*)(qrow + h * 64 + 32); wq[h] = bf2f(Z[(size_t)(tok0 + n16) * ZP + C_IW + h]) * 0.5f; } }
        const int ntile = nadm >> 4, nks = nadm >> 5; const unsigned nkmagic = 0xFFFFFFFFu / (unsigned)nks + 1u;
#pragma unroll 1
        for (int tl0 = w; tl0 < ntile; tl0 += 32) {
            bf16x8 a0[4], a1[4];
#pragma unroll
            for (int u = 0; u < 4; ++u) { const int tl = tl0 + 8 * u; if (tl < ntile) { const bf16_t* kt_ = IKT + ((row0 >> 4) + tl) * 1024 + lane * 8; a0[u] = *(const bf16x8*)(kt_); a1[u] = *(const bf16x8*)(kt_ + 512); } }
#pragma unroll
            for (int u = 0; u < 4; ++u) { const int tl = tl0 + 8 * u; if (tl < ntile) {
                f32x4 isc = (f32x4){0.f, 0.f, 0.f, 0.f};
                const bf16x8 p0 = a0[u], p1 = a1[u];
#pragma unroll
                for (int h = 0; h < 4; ++h) { f32x4 acc = (f32x4){0.f, 0.f, 0.f, 0.f};
                    acc = __builtin_amdgcn_mfma_f32_16x16x32_bf16(p0, bq[h][0], acc, 0, 0, 0); acc = __builtin_amdgcn_mfma_f32_16x16x32_bf16(p1, bq[h][1], acc, 0, 0, 0);
#pragma unroll
                    for (int i = 0; i < 4; ++i) isc[i] += fmaxf(acc[i], 0.f) * wq[h]; }
                u32x4 keys;
#pragma unroll
                for (int i = 0; i < 4; ++i) { const float v = isc[i] + 0.0f; unsigned u_ = __builtin_bit_cast(unsigned, v); u_ ^= (u_ >> 31) ? 0xffffffffu : 0x80000000u; keys[i] = u_; }
                unsigned lp_ = __umulhi((unsigned)(tl * 16 + 4 * quad), nkmagic), ii_ = (unsigned)(tl * 16 + 4 * quad) - lp_ * (unsigned)nks;
#pragma unroll
                for (int i = 0; i < 4; ++i) { SC[n16 * 2048 + ((ii_ * 32u + lp_ + 4u * n16) & 2047u)] = keys[i]; ++ii_; if (ii_ == (unsigned)nks) { ii_ = 0u; ++lp_; } } } }
        }
    }
    __syncthreads();
    {
        const int hq = lane >> 5, sl = lane & 31, q = 2 * w + hq; int nsel = 0;
        if (nadm <= 256) { for (int i = sl; i < nadm; i += 32) LST[q * 256 + i] = (unsigned short)i; nsel = nadm; }
        else {
            const int nk = nadm >> 5; unsigned s0 = 0u, s1 = 0u;
            if (nk <= 32) dsa_select_bs<1>(SC, q, sl, hq, nk, s0, s1); else dsa_select_bs<2>(SC, q, sl, hq, nk, s0, s1);
            const int nl = __builtin_popcount(s0) + __builtin_popcount(s1); int pos = half_incl_scan(nl) - nl;
            unsigned short* lqw = LST + q * 256; const int kb = sl * nk;
            while (s0) { const int i = __builtin_clz(s0); lqw[pos++] = (unsigned short)(kb + i); s0 &= ~(0x80000000u >> i); }
            while (s1) { const int i = __builtin_clz(s1); lqw[pos++] = (unsigned short)(kb + 32 + i); s1 &= ~(0x80000000u >> i); }
            nsel = 256;
        }
        if (sl == 0) NS[q] = nsel;
    }
    __syncthreads();
    unsigned char* wl = F.lds + w * 10240;
    const unsigned wl3 = (unsigned)(uintptr_t)(LAS unsigned char*)wl;
    const int q4 = (lane >> 2) & 3, p4 = lane & 3;
    const unsigned trb = wl3 + (unsigned)((4 * quad + q4) * 144 + (4 * p4) * 2);
    const int vr = lane >> 3, vc = lane & 7;
    const char* kvb = (const char*)(KV + row0 * 128);
    bf16x8 ka0[8], ka1[8];
#define DSA_KLOADQ(LQ, NSEL, t0) do { _Pragma("unroll") for (int u = 0; u < 8; ++u) if (((t0) + u) * 16 < (NSEL)) { const unsigned ko = (unsigned)(LQ)[((t0) + u) * 16 + lrow] * 256u + (unsigned)lpc * 16u; ka0[u] = *(const bf16x8*)(kvb + ko); ka1[u] = *(const bf16x8*)(kvb + ko + 64u); } } while (0)
    DSA_KLOADQ(LST + (2 * w) * 256, NS[2 * w], 0);
#pragma unroll 1
    for (int qi = 0; qi < 2; ++qi) {
        const int qq = 2 * w + qi, tok = tok0 + qq, nsel = NS[qq];
        const unsigned short* lq = LST + qq * 256;
#define DSA_VLOAD(ch, R) do { const unsigned short* lp = lq + (ch) * 32 + vr; \
            R[0] = *(const u32x4*)(kvb + ((unsigned)lp[0] * 256u + 128u + (unsigned)vc * 16u)); R[1] = *(const u32x4*)(kvb + ((unsigned)lp[8] * 256u + 128u + (unsigned)vc * 16u)); \
            R[2] = *(const u32x4*)(kvb + ((unsigned)lp[16] * 256u + 128u + (unsigned)vc * 16u)); R[3] = *(const u32x4*)(kvb + ((unsigned)lp[24] * 256u + 128u + (unsigned)vc * 16u)); } while (0)
        bf16x8 qf0, qf1;
        { const bf16_t* qp = Z + (size_t)tok * ZP + C_SQ + (n16 & 7) * 64 + quad * 8; qf0 = *(const bf16x8*)(qp); qf1 = *(const bf16x8*)(qp + 32);
          if (n16 >= 8) { qf0 = (bf16x8){0, 0, 0, 0, 0, 0, 0, 0}; qf1 = qf0; } }
        float lg[16][4]; float mx = -INFINITY;
#define DSA_QK(t0) do { _Pragma("unroll") for (int u = 0; u < 8; ++u) { \
            if (((t0) + u) * 16 < nsel) { f32x4 acc = (f32x4){0.f, 0.f, 0.f, 0.f}; \
                acc = __builtin_amdgcn_mfma_f32_16x16x32_bf16(lane_t16x4(ka0[u], tsrc), qf0, acc, 0, 0, 0); acc = __builtin_amdgcn_mfma_f32_16x16x32_bf16(lane_t16x4(ka1[u], tsrc), qf1, acc, 0, 0, 0); \
                _Pragma("unroll") for (int i = 0; i < 4; ++i) { lg[(t0) + u][i] = acc[i] * 0.125f; mx = fmaxf(mx, lg[(t0) + u][i]); } } \
            else { _Pragma("unroll") for (int i = 0; i < 4; ++i) lg[(t0) + u][i] = -INFINITY; } } } while (0)
        DSA_QK(0);
        if (128 < nsel) DSA_KLOADQ(lq, nsel, 8);
        u32x4 vv[4][4];
        DSA_QK(8);
#undef DSA_QK
        if (qi == 0) DSA_KLOADQ(LST + (2 * w + 1) * 256, NS[2 * w + 1], 0);
#pragma unroll
        for (int ch = 0; ch < 4; ++ch) if (ch * 32 < nsel) DSA_VLOAD(ch, vv[ch]);
        mx = xrow_max(mx);
        float sm = 0.f;
#pragma unroll
        for (int tl = 0; tl < 16; ++tl)
#pragma unroll
            for (int i = 0; i < 4; ++i) { lg[tl][i] = __expf(lg[tl][i] - mx); sm += lg[tl][i]; }
        sm = xrow_sum(sm);
        const float inv = 1.f / sm;
        f32x4 o[4];
#pragma unroll
        for (int nb = 0; nb < 4; ++nb) o[nb] = (f32x4){0.f, 0.f, 0.f, 0.f};
#pragma unroll
        for (int ch = 0; ch < 8; ++ch) {
            if (ch * 32 < nsel) {
                { LAS unsigned char* w3 = (LAS unsigned char*)wl + (ch & 1) * 4608 + vr * 144 + vc * 16;
                  *(LAS u32x4*)(w3) = vv[ch & 3][0]; *(LAS u32x4*)(w3 + 8 * 144) = vv[ch & 3][1]; *(LAS u32x4*)(w3 + 16 * 144) = vv[ch & 3][2]; *(LAS u32x4*)(w3 + 24 * 144) = vv[ch & 3][3]; }
                if (ch + 4 < 8 && (ch + 4) * 32 < nsel) DSA_VLOAD(ch + 4, vv[ch & 3]);
                u32x4 pw;
                pw.x = pg8::cvt_pk_bf16(lg[2 * ch][0] * inv, lg[2 * ch][1] * inv); pw.y = pg8::cvt_pk_bf16(lg[2 * ch][2] * inv, lg[2 * ch][3] * inv);
                pw.z = pg8::cvt_pk_bf16(lg[2 * ch + 1][0] * inv, lg[2 * ch + 1][1] * inv); pw.w = pg8::cvt_pk_bf16(lg[2 * ch + 1][2] * inv, lg[2 * ch + 1][3] * inv);
                asm volatile("s_waitcnt lgkmcnt(0)" ::: "memory");
                const unsigned tb = trb + (ch & 1) * 4608;
#pragma unroll
                for (int nb = 0; nb < 4; ++nb) { const s16x4 va = tr_read(tb + nb * 32), vb = tr_read(tb + 16 * 144 + nb * 32);
                    o[nb] = __builtin_amdgcn_mfma_f32_16x16x32_bf16(__builtin_bit_cast(bf16x8, pw), (bf16x8){va[0], va[1], va[2], va[3], vb[0], vb[1], vb[2], vb[3]}, o[nb], 0, 0, 0); }
            }
        }
#undef DSA_VLOAD
        asm volatile("s_waitcnt lgkmcnt(0)" ::: "memory");
        if (quad < 2) { bf16_t* op = OB + (size_t)tok * 512 + n16;
#pragma unroll
            for (int nb = 0; nb < 4; ++nb)
#pragma unroll
                for (int i = 0; i < 4; ++i) op[(4 * quad + i) * 64 + nb * 16] = (bf16_t)f2bf(o[nb][i]); }
    }
#undef DSA_KLOADQ
}
__device__ __forceinline__ void phase_mixers(Frame& F, const bf16_t* Z, const bf16_t* KV, bf16_t* MIX, const float* lbl, const float* onorm, unsigned* wq, const float* p, bf16_t* PB, int Ts) {
    F.retid();
    const int NBq = Ts / SEQ; const int NH = NBq * 4, NDSA = Ts / 16, NSBU = NBq * 8 * 8, NPBU = Ts * (PLE / 8) / 4096, NU = NH + NDSA + NSBU + NPBU;
    bf16_t* OA = MIX; bf16_t* OB = MIX + (size_t)Ts * 512; bf16_t* OC = MIX + (size_t)2 * Ts * 512;
    for (;;) {
        __syncthreads();
        if (F.tid == 0) F.lctl[4] = atomicAdd(wq, 1u);
        __syncthreads();
        const int u = (int)F.lctl[4];
        if (u >= NU) break;
        F.retid();
        if (u < NH) { hgrn_mfma_unit(F, Z, OA, onorm, u >> 2, u & 3); }
        else if (u < NH + NDSA) { dsa_mfma_unit(F, Z, KV, KV + (size_t)Ts * 128, OB, (NDSA - 1 - (u - NH)) * 16); }
        else if (u < NH + NDSA + NSBU) { const int idx = u - NH - NDSA; const int qblk = 7 - (idx / (NBq * 8)), bh = idx % (NBq * 8); sb_mfma_wave(Z, OC, bh >> 3, bh & 7, qblk * 256 + F.wave * 32, F.lds + F.wave * 12288, F.lane); }
        else { const size_t i0 = (size_t)(u - NH - NDSA - NSBU) * 4096 + F.tid; f32x4 a[8], b[8];
#pragma unroll
            for (int k = 0; k < 8; ++k) { a[k] = *(const f32x4*)(p + (i0 + k * 512) * 8); b[k] = *(const f32x4*)(p + (i0 + k * 512) * 8 + 4); }
#pragma unroll
            for (int k = 0; k < 8; ++k) { uint4 o; o.x = pk2(a[k][0], a[k][1]); o.y = pk2(a[k][2], a[k][3]); o.z = pk2(b[k][0], b[k][1]); o.w = pk2(b[k][2], b[k][3]); *(uint4*)(PB + (i0 + k * 512) * 8) = o; } }
    }
}

struct MoeTab { int start[17]; };
__device__ __forceinline__ void moe_tab(MoeTab& T, const unsigned* cnt) {
    int s = 0;
#pragma unroll
    for (int g = 0; g < 16; ++g) { T.start[g] = s; s += ((int)__hip_atomic_load(cnt + g, __ATOMIC_RELAXED, __HIP_MEMORY_SCOPE_AGENT) + 255) >> 8; }
    T.start[16] = s;
}
__device__ __forceinline__ int moe_group_of(const MoeTab& T, int r) { int g = 0;
#pragma unroll
    for (int j = 1; j < 16; ++j) g += (r >= T.start[j]) ? 1 : 0;
    return g; }
struct MoeGuOrder { MoeTab T; int G, c; const int* rowtok;
    __device__ __forceinline__ int rowmap(int slot) const { return rowtok[slot]; }
    __device__ __forceinline__ bool next(int i, Unit& u) const { const int R = T.start[16]; const long L = (long)i * G + c; if (L >= (long)R * 22) return false;
        int r, pn; pg8::tile_of((int)L, R, 22, r, pn); const int e = moe_group_of(T, r) & 7; u.pm = r; u.pn = pn; u.ta = r; u.tb = e * 22 + pn; return true; } };
struct MoeDownOrder { MoeTab T; int G, c, rank;
    __device__ __forceinline__ bool next(int i, Unit& u) const { const int r0 = T.start[rank * 8], nr = T.start[rank * 8 + 8] - r0; const long L = (long)i * G + c; if (L >= (long)nr * 4) return false;
        int rr, pn; pg8::tile_of((int)L, nr, 4, rr, pn); const int r = r0 + rr, e = moe_group_of(T, r) & 7; u.pm = r; u.pn = pn; u.ta = r; u.tb = e * 4 + pn; return true; } };
struct MoeDownAllOrder { MoeTab T; int G, c;
    __device__ __forceinline__ bool next(int i, Unit& u) const { const int nr = T.start[16]; const long L = (long)i * G + c; if (L >= (long)nr * 4) return false;
        int r, pn; pg8::tile_of((int)L, nr, 4, r, pn); const int e = moe_group_of(T, r) & 7; u.pm = r; u.pn = pn; u.ta = r; u.tb = e * 4 + pn; return true; } };
struct MergeOrder { int nM, G, c;
    __device__ __forceinline__ bool next(int i, Unit& u) const { const int ib = i / 3, br = i % 3; const long L = (long)ib * G + c; if (L >= (long)nM * 4) return false;
        int pm, pn; pg8::tile_of((int)L, nM, 4, pm, pn); u.pm = pm; u.pn = br * 4 + pn; u.ta = br * nM + pm; u.tb = br * 4 + pn; return true; } };

__device__ __forceinline__ void phase_route(Frame& F, const bf16_t* H, const float* gffn, const float* router, int* tok_e, float* tok_w, float* tok_rstd, int* rowtok, unsigned* cnt, int Ts) {
    F.retid();
    const int gt = F.bid * NTHR + F.tid, NGT = F.og() * NTHR;
    for (int i = gt; i < 2 * Ts + 4096; i += NGT) rowtok[i] = -1;
    volatile LAS unsigned* lc = F.lctl + 16;
    if (F.tid < 16) lc[F.tid] = 0u;
    __syncthreads();
    float* rl = (float*)F.lds;
    for (int i = F.tid; i < D * NE; i += NTHR) rl[i] = router[i] * gffn[i >> 3];
    __syncthreads();
    const int lo = (int)((long)Ts * F.bid / F.G), hi = (int)((long)Ts * (F.bid + 1) / F.G);
    for (int tok = lo + F.wave; tok < hi; tok += NWAVES) {
        const u32x2* hr = (const u32x2*)(H + (size_t)tok * D) + F.lane; f32x4 v[4]; float ss = 0.f;
#pragma unroll
        for (int j = 0; j < 4; ++j) { const u32x2 w_ = hr[64 * j]; v[j] = (f32x4){bflo(w_.x), bfhi(w_.x), bflo(w_.y), bfhi(w_.y)}; ss += (v[j][0] * v[j][0] + v[j][1] * v[j][1]) + (v[j][2] * v[j][2] + v[j][3] * v[j][3]); }
        const float rs = rsqrtf(wave_sum(ss) * (1.f / D) + EPS);
        float lgt[8];
#pragma unroll
        for (int e = 0; e < 8; ++e) lgt[e] = 0.f;
#pragma unroll
        for (int j = 0; j < 4; ++j)
#pragma unroll
            for (int q = 0; q < 4; ++q) { const int k = 256 * j + 4 * F.lane + q; const float x = v[j][q] * rs; const f32x4 r0 = *(const f32x4*)(rl + k * 8), r1 = *(const f32x4*)(rl + k * 8 + 4);
                lgt[0] += x * r0[0]; lgt[1] += x * r0[1]; lgt[2] += x * r0[2]; lgt[3] += x * r0[3]; lgt[4] += x * r1[0]; lgt[5] += x * r1[1]; lgt[6] += x * r1[2]; lgt[7] += x * r1[3]; }
#pragma unroll
        for (int e = 0; e < 8; ++e) lgt[e] = wave_sum(lgt[e]);
        int e0 = 0; float l0 = lgt[0];
#pragma unroll
        for (int e = 1; e < 8; ++e) if (lgt[e] > l0) { l0 = lgt[e]; e0 = e; }
        int e1 = -1; float l1 = -INFINITY;
#pragma unroll
        for (int e = 0; e < 8; ++e) if (e != e0 && lgt[e] > l1) { l1 = lgt[e]; e1 = e; }
        const float wa = 1.f / (1.f + __expf(l1 - l0));
        if (F.lane == 0) { tok_e[tok * 2] = e0; tok_e[tok * 2 + 1] = e1; tok_w[tok * 2] = wa; tok_w[tok * 2 + 1] = 1.f - wa; tok_rstd[tok] = rs;
            __hip_atomic_fetch_add((LAS unsigned*)(lc + e0), 1u, __ATOMIC_RELAXED, __HIP_MEMORY_SCOPE_WORKGROUP); __hip_atomic_fetch_add((LAS unsigned*)(lc + 8 + e1), 1u, __ATOMIC_RELAXED, __HIP_MEMORY_SCOPE_WORKGROUP); }
    }
    __syncthreads();
    if (F.tid < 16) { const unsigned n = lc[F.tid]; if (n) atomicAdd(cnt + F.tid, n); }
    __syncthreads();
}
__device__ __forceinline__ void phase_scatter(Frame& F, const bf16_t* HB, bf16_t* VP, const int* tok_e, const float* tok_w, const float* tok_rstd, int* rowtok, float* roww, float* rowrstd, unsigned* cnt, int Ts) {
    F.retid();
    MoeTab T; moe_tab(T, cnt);
    volatile LAS unsigned* lc = F.lctl + 16; volatile LAS unsigned* lb = F.lctl + 32;
    int* posl = (int*)F.lds;
    if (F.tid < 16) lc[F.tid] = 0u;
    __syncthreads();
    const int lo = (int)((long)Ts * F.bid / F.G), hi = (int)((long)Ts * (F.bid + 1) / F.G), n = hi - lo;
    int e0 = 0, e1 = 0, li0 = 0, li1 = 0;
    if (F.tid < n) { const int tok = lo + F.tid; e0 = tok_e[tok * 2]; e1 = tok_e[tok * 2 + 1];
        li0 = (int)__hip_atomic_fetch_add((LAS unsigned*)(lc + e0), 1u, __ATOMIC_RELAXED, __HIP_MEMORY_SCOPE_WORKGROUP); li1 = (int)__hip_atomic_fetch_add((LAS unsigned*)(lc + 8 + e1), 1u, __ATOMIC_RELAXED, __HIP_MEMORY_SCOPE_WORKGROUP); }
    __syncthreads();
    if (F.tid < 16) { const unsigned c = lc[F.tid]; int st = 0;
#pragma unroll
        for (int g = 0; g < 16; ++g) st = (F.tid == g) ? T.start[g] : st;
        lb[F.tid] = (unsigned)st * 256u + (c ? atomicAdd(cnt + 64 + F.tid, c) : 0u); }
    __syncthreads();
    if (F.tid < n) { const int tok = lo + F.tid; const int p0 = (int)lb[e0] + li0, p1 = (int)lb[8 + e1] + li1; const float rs = tok_rstd[tok];
        rowtok[p0] = tok; roww[p0] = tok_w[tok * 2]; rowrstd[p0] = rs; rowtok[p1] = tok; roww[p1] = tok_w[tok * 2 + 1]; rowrstd[p1] = rs; }
    __syncthreads();
    __syncthreads();
}

constexpr int WGM_INPROJ = 4, WGM_GU = 4;
constexpr int NPHL = 13;
__host__ __device__ inline bool phase_active(int k, int l) {
    if (k == 0) return l == 0;
    if (k >= 8 && k <= 10) return (l & 1) == 1;
    if (k == 12) return l == DEPTH - 1;
    return true;
}
struct Args { const float* in[23]; float* out; unsigned char* ws; int ph_lo, ph_hi, single, Ts; };

typedef const __attribute__((address_space(4))) Args* KArgs;
struct Ctx { unsigned char* ws; float* out; int Ts, nM; ActMap M; KArgs ap;
    __device__ __forceinline__ const float* in(int i) const { return ap->in[i]; } };
#define CTX() Ctx C; { KArgs ap_ = (KArgs)__builtin_amdgcn_kernarg_segment_ptr(); asm volatile("" : "+s"(ap_)); C.ap = ap_; C.ws = ap_->ws; C.out = ap_->out; C.Ts = ap_->Ts; C.nM = C.Ts / 256; C.M.init((size_t)C.Ts); }
#define WSP(T, off) ((T*)(C.ws + (off)))

__global__ void __launch_bounds__(NTHR, 2) fwd(Args a) {
    extern __shared__ __attribute__((aligned(16))) unsigned char lds_raw[];
    Frame F;
    F.lds = lds_raw; F.lds3 = (LAS unsigned char*)lds_raw; F.lctl = (volatile LAS unsigned*)(F.lds3 + LDSCTL_OFF);
    F.tid = threadIdx.x; F.lane = F.tid & 63; F.wave = __builtin_amdgcn_readfirstlane(F.tid >> 6); F.wave0 = F.wave; F.G = gridDim.x; F.bid = blockIdx.x;
    F.ws = a.ws; F.ctl = (unsigned*)(a.ws + WS_CTL);
    for (int u = F.tid; u < (LDS_BYTES - LDSCTL_OFF) / 4; u += NTHR) F.lctl[u] = 0u;
    __syncthreads();
    XcdBarrier bar; bar.bar = F.ctl + CW_BAR; bar.x = 0; bar.st = nullptr;
    if (a.single) bar = xcd_barrier_post(F.ctl + CW_BAR, F.lctl);
    const int lo = a.ph_lo, hi = a.ph_hi, single = a.single;
#define RUN(p) (lo <= (p) && (p) < hi)
#define SEAM(p) do { if (single && (p) + 1 < hi) xcd_barrier(bar, F.wave0); } while (0)
    const int NSB = BATCH * SEQ / a.Ts;

    if (RUN(0)) { phase_prologue(F, a.in); if (!single) SEAM(0); }

    for (int sb = 0; sb < NSB; ++sb) {
        for (int l = 0; l < DEPTH; ++l) {
            const int pbase = 1 + (sb * DEPTH + l) * NPHL; const int sl = sb * DEPTH + l;
            if (pbase + NPHL <= lo || pbase >= hi) continue;
#define HPTR (C.out + (size_t)sb * C.Ts * D)
            if (l == 0 && RUN(pbase + 0)) { CTX(); phase_init(F, C.in(0) + (size_t)sb * C.Ts * D, WSP(bf16_t, C.M.hbn), WSP(float, C.M.ssq1), C.Ts); SEAM(pbase + 0); }
            if (RUN(pbase + 1)) { CTX();
                pg8::Gemm g{WSP(bf16_t, C.M.hbn), WSP(const bf16_t, WS_WIN + l * SZ_WIN), D}; pg8::PlainOrder S{C.nM, ZW / 256, F.G, F.bid, WGM_INPROJ}; EpiZ E{WSP(bf16_t, C.M.z), WSP(float, C.M.ssq1), WSP(float, WS_LB) + l * 512, WSP(bf16_t, C.M.z) + (size_t)C.Ts * ZP, WSP(bf16_t, C.M.kv) + (size_t)C.Ts * 128};
                pg8::gemm_phase(F.lds3, g, S, E, F.wave0); SEAM(pbase + 1); }
            if (RUN(pbase + 2)) { CTX(); phase_prep(F, WSP(bf16_t, C.M.z), WSP(bf16_t, C.M.kv), WSP(bf16_t, WS_WKV + l * SZ_WKV), C.in(1) + ((size_t)l * BATCH * SEQ + (size_t)sb * C.Ts) * PLE, WSP(bf16_t, C.M.pb), C.Ts); SEAM(pbase + 2); }
            if (RUN(pbase + 3)) { CTX(); phase_mixers(F, WSP(bf16_t, C.M.z), WSP(bf16_t, C.M.kv), WSP(bf16_t, C.M.mix), WSP(float, WS_LB) + l * 512, C.in(5) + l * 128, WSP(unsigned, WS_CTL) + CW_WQ + 64 * sl, C.in(1) + ((size_t)l * BATCH * SEQ + (size_t)sb * C.Ts) * PLE, WSP(bf16_t, C.M.pb), C.Ts); SEAM(pbase + 3); }
            if (RUN(pbase + 4)) { CTX();
                pg8::Gemm g{WSP(bf16_t, C.M.mix), WSP(const bf16_t, WS_WBR + l * SZ_WBR), 512}; MergeOrder S{C.nM, F.G, F.bid}; EpiMerge E{WSP(bf16_t, C.M.mg), WSP(bf16_t, C.M.z) + (size_t)C.Ts * ZP, WSP(bf16_t, C.M.hb)};
                pg8::gemm_phase(F.lds3, g, S, E, F.wave0); SEAM(pbase + 4); }
            if (RUN(pbase + 5)) { CTX();
                pg8::Gemm g{WSP(bf16_t, C.M.mg), WSP(const bf16_t, WS_WOUT + l * SZ_WOUT), D}; pg8::PlainOrder S{C.nM, 4, F.G, F.bid}; EpiRes E{WSP(bf16_t, C.M.hbn), WSP(bf16_t, C.M.hb), WSP(float, C.M.ssq)};
                pg8::gemm_phase(F.lds3, g, S, E, F.wave0); SEAM(pbase + 5); }
            if ((l & 1) == 0) {
                if (RUN(pbase + 6)) { CTX();
                    pg8::Gemm g{WSP(bf16_t, C.M.hb), WSP(const bf16_t, WS_WDGU + (l >> 1) * SZ_WGU), D}; pg8::PlainOrder S{C.nM, 22, F.G, F.bid, WGM_GU}; EpiGU E{WSP(bf16_t, C.M.z), WSP(float, C.M.ssq), nullptr};
                    pg8::gemm_phase(F.lds3, g, S, E, F.wave0); SEAM(pbase + 6); }
                if (RUN(pbase + 7)) { CTX();
                    pg8::Gemm g{WSP(bf16_t, C.M.z), WSP(const bf16_t, WS_WDD + (l >> 1) * SZ_WD), DFF}; pg8::PlainOrder S{C.nM, 4, F.G, F.bid}; EpiRes E{WSP(bf16_t, C.M.hb), WSP(bf16_t, C.M.hb), WSP(float, C.M.ssq)};
                    pg8::gemm_phase(F.lds3, g, S, E, F.wave0); SEAM(pbase + 7); }
            } else {
#define MCNT (WSP(unsigned, WS_CTL) + CW_MOE + 256 * sl)
                if (RUN(pbase + 6)) { CTX(); phase_route(F, WSP(bf16_t, C.M.hb), C.in(11) + l * D, C.in(15) + (size_t)(l >> 1) * D * NE, WSP(int, C.M.tok_e), WSP(float, C.M.tok_w), WSP(float, C.M.tok_rstd), WSP(int, C.M.rowtok), MCNT, C.Ts); SEAM(pbase + 6); }
                if (RUN(pbase + 7)) { CTX(); phase_scatter(F, WSP(bf16_t, C.M.hb), WSP(bf16_t, C.M.mix), WSP(int, C.M.tok_e), WSP(float, C.M.tok_w), WSP(float, C.M.tok_rstd), WSP(int, C.M.rowtok), WSP(float, C.M.roww), WSP(float, C.M.rowrstd), MCNT, C.Ts); SEAM(pbase + 7); }
                if (RUN(pbase + 8)) { CTX();
                    pg8::Gemm g{WSP(bf16_t, C.M.hb), WSP(const bf16_t, WS_WMGU + (size_t)(l >> 1) * 8 * SZ_WGU), D}; MoeGuOrder S; moe_tab(S.T, MCNT); S.G = F.G; S.c = F.bid; S.rowtok = WSP(int, C.M.rowtok); EpiGU E{WSP(bf16_t, C.M.z), nullptr, WSP(float, C.M.rowrstd)};
                    pg8::gemm_phase<EpiGU, MoeGuOrder, true, true, true>(F.lds3, g, S, E, F.wave0); SEAM(pbase + 8); }
                if (RUN(pbase + 9)) { CTX();
                    pg8::Gemm g{WSP(bf16_t, C.M.z), WSP(const bf16_t, WS_WMD + (size_t)(l >> 1) * 8 * SZ_WD), DFF}; MoeDownAllOrder S; moe_tab(S.T, MCNT); S.G = F.G; S.c = F.bid;
                    EpiMoeDownM E{WSP(bf16_t, C.M.hb), WSP(bf16_t, C.M.mg), WSP(int, C.M.rowtok), WSP(float, C.M.roww), S.T.start[8]};
                    pg8::gemm_phase(F.lds3, g, S, E, F.wave0); SEAM(pbase + 9); }
            }
            if ((l & 1) == 1) {
                if (RUN(pbase + 10)) { CTX(); pg8::Gemm g{WSP(bf16_t, C.M.pb), WSP(const bf16_t, WS_WPP + l * SZ_WPP), PLE}; pg8::PlainOrder S{C.nM, 4, F.G, F.bid};
                    EpiPpComb E{WSP(bf16_t, C.M.mix), WSP(bf16_t, C.M.hb), WSP(bf16_t, C.M.mg), WSP(float, C.M.ssq)}; pg8::gemm_phase(F.lds3, g, S, E, F.wave0); SEAM(pbase + 10); }
            }
            if (RUN(pbase + 11)) {
                if ((l & 1) == 0) { CTX(); pg8::Gemm g{WSP(bf16_t, C.M.pb), WSP(const bf16_t, WS_WPP + l * SZ_WPP), PLE}; pg8::PlainOrder S{C.nM, 4, F.G, F.bid}; EpiBf E{WSP(bf16_t, C.M.mix)}; pg8::gemm_phase(F.lds3, g, S, E, F.wave0); }
                { CTX(); pg8::Gemm g{WSP(bf16_t, C.M.hb), WSP(const bf16_t, WS_WPG + l * SZ_WOUT), D}; pg8::PlainOrder S{C.nM, 4, F.G, F.bid};
                  EpiPle E{WSP(bf16_t, C.M.hb), WSP(bf16_t, C.M.hbn), WSP(float, C.M.ssq1), WSP(float, C.M.ssq), WSP(bf16_t, C.M.mix)}; pg8::gemm_phase(F.lds3, g, S, E, F.wave0); }
                SEAM(pbase + 11); }
            if (l == DEPTH - 1 && RUN(pbase + 12)) { CTX(); phase_final(F, WSP(bf16_t, C.M.hbn), HPTR, C.in(22), C.Ts); SEAM(pbase + 12); }
        }
    }
#undef RUN
#undef SEAM
}

#ifndef MK_SINGLE
#define MK_SINGLE 1
#endif
extern "C" void kernel_launch(void* const* d_in, const int* in_sizes, int n_in, void* d_out, int out_size, void* d_ws, size_t ws_size, hipStream_t stream) {
    static int grid = 0, Ts = 0;
    if (grid == 0) {
        int dev = 0, cus = 0;
        if (hipGetDevice(&dev) != hipSuccess || hipDeviceGetAttribute(&cus, hipDeviceAttributeMultiprocessorCount, dev) != hipSuccess) { fprintf(stderr, "kernel_launch: device query failed\n"); grid = -1; return; }
        if (hipFuncSetAttribute((const void*)fwd, hipFuncAttributeMaxDynamicSharedMemorySize, LDS_BYTES) != hipSuccess) { fprintf(stderr, "kernel_launch: hipFuncSetAttribute failed\n"); grid = -1; return; }
        int per_cu = 0; (void)hipOccupancyMaxActiveBlocksPerMultiprocessor(&per_cu, (const void*)fwd, NTHR, LDS_BYTES); (void)hipGetLastError();
        const int nbs[3] = {16, 8, 4};
        for (int i = 0; i < 3 && !Ts; ++i) { ActMap M; M.init((size_t)nbs[i] * SEQ); if (M.end <= ws_size) Ts = nbs[i] * SEQ; }
        if (!Ts || n_in != 23 || per_cu < 1) { fprintf(stderr, "kernel_launch: unsupported (ws %zu, n_in %d, occupancy %d)\n", ws_size, n_in, per_cu); grid = -1; return; }
        grid = cus;
    }
    if (grid < 0) return;
    (void)hipMemsetAsync((char*)d_ws + WS_CTL, 0, CTL_BYTES, stream);
    Args a{};
    for (int i = 0; i < 23; ++i) a.in[i] = (const float*)d_in[i];
    a.out = (float*)d_out; a.ws = (unsigned char*)d_ws; a.Ts = Ts;
    const int NSB = BATCH * SEQ / Ts, NPH = 1 + NSB * DEPTH * NPHL;
#if MK_SINGLE
    a.ph_lo = 0; a.ph_hi = NPH; a.single = 1;
    hipLaunchKernelGGL(fwd, dim3(grid), dim3(NTHR), LDS_BYTES, stream, a);
#else
    a.single = 0;
    for (int ph = 0; ph < NPH; ++ph) {
        if (ph > 0) { const int r = (ph - 1) % (DEPTH * NPHL); if (!phase_active(r % NPHL, r / NPHL)) continue; }
        a.ph_lo = ph; a.ph_hi = ph + 1;
        hipLaunchKernelGGL(fwd, dim3(grid), dim3(NTHR), LDS_BYTES, stream, a);
    }
#endif
}
```
